# Optimizing an MI355X kernel written in HIP

```python
import jax, jax.numpy as jnp
from jax import lax
import numpy as np

D_MODEL = 1024
BATCH = 8
SEQ = 4096
DEPTH = 1

POOL_WINDOWS = (2, 4, 8, 16)
POOL_WIDTH = D_MODEL // 4
POOL_GROUP = POOL_WIDTH // len(POOL_WINDOWS)
HEAD_DIM = 64
FOX_WIDTH = D_MODEL // 2
FOX_HEADS = FOX_WIDTH // HEAD_DIM
MEM_WIDTH = D_MODEL // 4
MEM_HEADS = 4
MEM_HEAD_DIM = MEM_WIDTH // MEM_HEADS
MEM_LEN = 256
MIX_WIDTH = POOL_WIDTH + FOX_WIDTH + MEM_WIDTH
IN_COLS = POOL_WIDTH + 3 * FOX_WIDTH + FOX_HEADS + MEM_WIDTH
Q_BLOCK = 128
N_EXPERTS = 256
TOP_K = 8
N_GROUPS = 8
TOPK_GROUPS = 4
EXPERT_HIDDEN = D_MODEL // 4
SHARED_HIDDEN = D_MODEL // 4
ROUTED_SCALE = 2.5
EXPERT_BLOCK = 128
ALPHA = (2 * DEPTH) ** 0.25
BETA = (8 * DEPTH) ** -0.25
LN_EPS = 1e-5

kernel_name = "hybrid_pool_fox_memory_moe_deepnorm"


def layer_norm(x, g, b):
    xf = x.astype(jnp.float32)
    mu = jnp.mean(xf, axis=-1, keepdims=True)
    var = jnp.mean(jnp.square(xf - mu), axis=-1, keepdims=True)
    y = (xf - mu) * lax.rsqrt(var + LN_EPS)
    return (y * g + b).astype(x.dtype)


def pool_mixer(u, w_pool, pool_scale):
    B, S, _ = u.shape
    ug = u.reshape(B, S, len(POOL_WINDOWS), POOL_GROUP).astype(jnp.float32)
    cs = jnp.cumsum(ug, axis=1)
    pos = jnp.arange(S)
    outs = []
    for g, w in enumerate(POOL_WINDOWS):
        c = cs[:, :, g]
        lag = jnp.pad(c[:, :-w], ((0, 0), (w, 0), (0, 0)))
        cnt = jnp.minimum(pos + 1, w).astype(jnp.float32)[None, :, None]
        outs.append((c - lag) / cnt - ug[:, :, g])
    d = jnp.stack(outs, axis=2).astype(u.dtype)
    y = jnp.einsum('bsgc,gcd->bsgd', d, w_pool)
    return y.reshape(B, S, POOL_WIDTH) * pool_scale


def forgetting_attention(q, k, v, f_logit):
    B, S, H, hd = q.shape
    logf = jax.nn.log_sigmoid(f_logit.astype(jnp.float32))
    F = jnp.cumsum(logf, axis=1)
    Fk = jnp.transpose(F, (0, 2, 1))[:, :, None, :]
    nb = S // Q_BLOCK
    qb = jnp.transpose(q.reshape(B, nb, Q_BLOCK, H, hd), (1, 0, 2, 3, 4))
    Fb = jnp.transpose(F.reshape(B, nb, Q_BLOCK, H), (1, 0, 3, 2))
    kpos = jnp.arange(S)
    scale = hd ** -0.5

    def block(args):
        i, q_i, F_i = args
        s = jnp.einsum('bqhd,bkhd->bhqk', q_i, k).astype(jnp.float32) * scale
        s = s + F_i[..., None] - Fk
        qpos = i * Q_BLOCK + jnp.arange(Q_BLOCK)
        s = jnp.where(kpos[None, :] <= qpos[:, None], s, -jnp.inf)
        p = jax.nn.softmax(s, axis=-1)
        return jnp.einsum('bhqk,bkhd->bqhd', p.astype(v.dtype), v)

    out = lax.map(block, (jnp.arange(nb, dtype=jnp.int32), qb, Fb))
    return jnp.transpose(out, (1, 0, 2, 3, 4)).reshape(B, S, H * hd)


def memory_attention(q, mem, w_mem_kv):
    B, S, _ = q.shape
    kv = mem @ w_mem_kv
    k, v = jnp.split(kv, 2, axis=-1)
    M = mem.shape[1]
    qh = q.reshape(B, S, MEM_HEADS, MEM_HEAD_DIM)
    kh = k.reshape(B, M, MEM_HEADS, MEM_HEAD_DIM)
    vh = v.reshape(B, M, MEM_HEADS, MEM_HEAD_DIM)
    s = jnp.einsum('bshd,bmhd->bhsm', qh, kh).astype(jnp.float32) * (MEM_HEAD_DIM ** -0.5)
    p = jax.nn.softmax(s, axis=-1)
    o = jnp.einsum('bhsm,bmhd->bshd', p.astype(vh.dtype), vh)
    return o.reshape(B, S, MEM_WIDTH)


def token_mixer(x, mem, w_in, b_f, w_pool, pool_scale, w_mem_kv, w_out):
    B, S, _ = x.shape
    proj = x @ w_in
    P, Fw = POOL_WIDTH, FOX_WIDTH
    u_pool, q, k, v, f_logit, q_mem = jnp.split(
        proj, [P, P + Fw, P + 2 * Fw, P + 3 * Fw, P + 3 * Fw + FOX_HEADS], axis=-1)
    y_pool = pool_mixer(u_pool, w_pool, pool_scale)
    shp = (B, S, FOX_HEADS, HEAD_DIM)
    y_fox = forgetting_attention(q.reshape(shp), k.reshape(shp), v.reshape(shp), f_logit + b_f)
    y_mem = memory_attention(q_mem, mem, w_mem_kv)
    return jnp.concatenate([y_pool, y_fox, y_mem], axis=-1) @ w_out


def swiglu(x, wg, wu, wd):
    return (jax.nn.silu(x @ wg) * (x @ wu)) @ wd


def routed_experts(xt, eidx, gates, w_gate, w_up, w_down):
    T, D = xt.shape
    A = T * TOP_K
    flat_e = eidx.reshape(A)
    flat_tok = jnp.arange(A, dtype=jnp.int32) // TOP_K
    flat_g = gates.reshape(A)
    order = jnp.argsort(flat_e)
    se, stok, sg = flat_e[order], flat_tok[order], flat_g[order]
    counts = jnp.bincount(flat_e, length=N_EXPERTS)
    padded = (counts + EXPERT_BLOCK - 1) // EXPERT_BLOCK * EXPERT_BLOCK
    start_sorted = jnp.cumsum(counts) - counts
    pad_end = jnp.cumsum(padded)
    start_pad = pad_end - padded
    dest = start_pad[se] + (jnp.arange(A, dtype=jnp.int32) - start_sorted[se])
    n_rows = EXPERT_BLOCK * (-(-(A + N_EXPERTS * (EXPERT_BLOCK - 1)) // EXPERT_BLOCK))
    n_blk = n_rows // EXPERT_BLOCK
    row_tok = jnp.full((n_rows,), T, jnp.int32).at[dest].set(stok)
    row_g = jnp.zeros((n_rows,), gates.dtype).at[dest].set(sg)
    blk_e = jnp.minimum(
        jnp.searchsorted(pad_end, jnp.arange(n_blk, dtype=jnp.int32) * EXPERT_BLOCK, side='right'),
        N_EXPERTS - 1)
    x_pad = jnp.concatenate([xt, jnp.zeros((1, D), xt.dtype)], axis=0)

    def step(acc, args):
        e, tok, g = args
        xb = x_pad[tok]
        h = jax.nn.silu(xb @ w_gate[e]) * (xb @ w_up[e])
        y = ((h @ w_down[e]) * g[:, None]).astype(acc.dtype)
        return acc.at[tok].add(y), None

    acc0 = jnp.zeros((T + 1, D), xt.dtype)
    acc, _ = lax.scan(step, acc0, (blk_e, row_tok.reshape(n_blk, EXPERT_BLOCK),
                                   row_g.reshape(n_blk, EXPERT_BLOCK)))
    return acc[:T]


def moe(x, w_router, router_bias, w_gate, w_up, w_down, ws_gate, ws_up, ws_down):
    B, S, D = x.shape
    T = B * S
    xt = x.reshape(T, D)
    scores = jax.nn.sigmoid((xt @ w_router).astype(jnp.float32))
    biased = scores + router_bias.astype(jnp.float32)
    grp = biased.reshape(T, N_GROUPS, N_EXPERTS // N_GROUPS)
    gscore = lax.top_k(grp, 2)[0].sum(-1)
    _, gidx = lax.top_k(gscore, TOPK_GROUPS)
    gmask = jax.nn.one_hot(gidx, N_GROUPS, dtype=jnp.int32).sum(-2) > 0
    emask = jnp.repeat(gmask, N_EXPERTS // N_GROUPS, axis=-1)
    _, eidx = lax.top_k(jnp.where(emask, biased, -jnp.inf), TOP_K)
    sel = jnp.take_along_axis(scores, eidx, axis=-1)
    gates = sel / jnp.sum(sel, axis=-1, keepdims=True) * ROUTED_SCALE
    routed = routed_experts(xt, eidx, gates, w_gate, w_up, w_down)
    shared = swiglu(xt, ws_gate, ws_up, ws_down)
    return (routed + shared).reshape(B, S, D)


def setup_inputs(seed: int = 0) -> dict:
    key = jax.random.key(seed)
    ks = jax.random.split(key, 20)
    f32 = jnp.float32
    nrm = lambda k, shape, s: jax.random.normal(k, shape, f32) * s
    L, D, E, H = DEPTH, D_MODEL, N_EXPERTS, EXPERT_HIDDEN
    return {
        "x": nrm(ks[0], (BATCH, SEQ, D), 1.0),
        "mem": nrm(ks[1], (BATCH, MEM_LEN, D), 1.0),
        "w_in": nrm(ks[2], (L, D, IN_COLS), D ** -0.5),
        "b_f": 1.0 + 2.0 * jax.random.uniform(ks[3], (L, FOX_HEADS), f32),
        "w_pool": nrm(ks[4], (L, len(POOL_WINDOWS), POOL_GROUP, POOL_GROUP), POOL_GROUP ** -0.5),
        "pool_scale": 1.0 + nrm(ks[5], (L, POOL_WIDTH), 0.02),
        "w_mem_kv": nrm(ks[6], (L, D, 2 * MEM_WIDTH), D ** -0.5),
        "w_out": nrm(ks[7], (L, MIX_WIDTH, D), MIX_WIDTH ** -0.5 * BETA),
        "ln1_g": 1.0 + nrm(ks[8], (L, D), 0.02),
        "ln1_b": nrm(ks[9], (L, D), 0.02),
        "w_router": nrm(ks[10], (L, D, E), D ** -0.5),
        "router_bias": nrm(ks[11], (L, E), 0.01),
        "w_gate": nrm(ks[12], (L, E, D, H), D ** -0.5),
        "w_up": nrm(ks[13], (L, E, D, H), D ** -0.5),
        "w_down": nrm(ks[14], (L, E, H, D), H ** -0.5 * BETA),
        "ws_gate": nrm(ks[15], (L, D, SHARED_HIDDEN), D ** -0.5),
        "ws_up": nrm(ks[16], (L, D, SHARED_HIDDEN), D ** -0.5),
        "ws_down": nrm(ks[17], (L, SHARED_HIDDEN, D), SHARED_HIDDEN ** -0.5 * BETA),
        "ln2_g": 1.0 + nrm(ks[18], (L, D), 0.02),
        "ln2_b": nrm(ks[19], (L, D), 0.02),
    }


def reference(x, mem, w_in, b_f, w_pool, pool_scale, w_mem_kv, w_out, ln1_g, ln1_b,
              w_router, router_bias, w_gate, w_up, w_down, ws_gate, ws_up, ws_down,
              ln2_g, ln2_b):
    for l in range(DEPTH):
        h = token_mixer(x, mem, w_in[l], b_f[l], w_pool[l], pool_scale[l], w_mem_kv[l], w_out[l])
        x = layer_norm(ALPHA * x + h, ln1_g[l], ln1_b[l])
        h = moe(x, w_router[l], router_bias[l], w_gate[l], w_up[l], w_down[l],
                ws_gate[l], ws_up[l], ws_down[l])
        x = layer_norm(ALPHA * x + h, ln2_g[l], ln2_b[l])
    return x
```

```cpp
#include <hip/hip_runtime.h>
#include <hip/hip_cooperative_groups.h>
#include <cstdio>
#include <cstdint>
namespace cg = cooperative_groups;

#define LAS __attribute__((address_space(3)))
typedef unsigned short bf16_t;
typedef short bf16x8 __attribute__((ext_vector_type(8)));
typedef short s16x4 __attribute__((ext_vector_type(4)));
typedef float f32x4 __attribute__((ext_vector_type(4)));
typedef float f32x2 __attribute__((ext_vector_type(2)));
typedef float f32x16 __attribute__((ext_vector_type(16)));
typedef unsigned u32x4 __attribute__((ext_vector_type(4)));
typedef unsigned u32x2 __attribute__((ext_vector_type(2)));

constexpr int NB = 8, SEQ = 4096, T = NB * SEQ, DM = 1024;
constexpr int INC = 2056;
constexpr int NE = 256, TOPK = 8, EH = 256;
constexpr float ALPHA = 1.189207115002721f;
constexpr float LN_EPS = 1e-5f;
constexpr float LOG2E = 1.4426950408889634f;
constexpr float C2 = 0.125f * LOG2E;
constexpr int MAXTILES = 1280 + 128;

constexpr size_t MiB = 1u << 20;
constexpr size_t WS_CTL = 0, WS_WD = 1 * MiB, WS_HB = 130 * MiB, WS_X1B = 306 * MiB, WS_BINS = 370 * MiB, WS_GATES = 402 * MiB, WS_FC = 403 * MiB, WS_FLOG = 404 * MiB,
                 WS_KVM = 405 * MiB, WS_Y = 408 * MiB, WS_WGU = 408 * MiB, WS_WIN = 665 * MiB, WS_WMKV = 669 * MiB, WS_WOUT = 670 * MiB, WS_WR = 672 * MiB, WS_MEMB = 673 * MiB,
                 WS_XB = 677 * MiB, WS_Q = 741 * MiB, WS_K = 773 * MiB, WS_V = 805 * MiB, WS_QM = 837 * MiB, WS_U = 853 * MiB, WS_YMIX = 869 * MiB, WS_LOG = 933 * MiB, WS_END = 965 * MiB;
constexpr size_t CTL_ZERO_BYTES = 1 * MiB;

constexpr int RING_BYTES = 131072;
constexpr int TE_OFF = 131072, TB_OFF = 135168, CN_OFF = 137216, MISC_OFF = 139264, LDS_BYTES = 147456;

struct Args {
    const float *x, *mem, *w_in, *b_f, *w_pool, *pool_scale, *w_mem_kv, *w_out, *ln1_g, *ln1_b, *w_router, *router_bias, *w_gate, *w_up, *w_down, *ws_gate, *ws_up, *ws_down, *ln2_g, *ln2_b;
    float* out; unsigned char* ws; int ph_lo, ph_hi;
};

__device__ __forceinline__ unsigned f2bf(float f) { unsigned u = __float_as_uint(f); return (u + 0x7fffu + ((u >> 16) & 1u)) >> 16; }
__device__ __forceinline__ unsigned pk2(float lo, float hi) { return f2bf(lo) | (f2bf(hi) << 16); }
__device__ __forceinline__ float bflo(unsigned w) { return __uint_as_float(w << 16); }
__device__ __forceinline__ float bfhi(unsigned w) { return __uint_as_float(w & 0xffff0000u); }
__device__ __forceinline__ float wave_sum(float v) {
#pragma unroll
    for (int o = 1; o < 64; o <<= 1) v += __shfl_xor(v, o);
    return v;
}
#define LDS_WAIT() asm volatile("s_waitcnt lgkmcnt(0)" ::: "memory")

namespace pg8 {
constexpr int BM = 256, BK = 64, HALF = 128, HTB = HALF * BK * 2, NXCD = 8, WGM = 8;
__device__ __forceinline__ int lds_byte(int r, int c) { const int st = (r >> 4) * 2 + (c >> 5), rr = r & 15, cc = c & 31, ob = rr * 64 + cc * 2; return st * 1024 + (ob ^ (((ob >> 9) & 1) << 5)); }
__device__ __forceinline__ void stage_rc(int b, int& R, int& C) { const int st = b / 1024, sb = b % 1024, swz = sb ^ (((sb >> 9) & 1) << 5); R = (st >> 1) * 16 + swz / 64; C = (st & 1) * 32 + (swz % 64) / 2; }
__device__ __forceinline__ int perm32(int rho) { const int n = rho >> 4, i = rho & 15; return 8 * (i >> 2) + 4 * n + (i & 3); }
__device__ __forceinline__ int xcd_remap(int L, int nwg) { const int q = nwg / NXCD, r = nwg % NXCD, xcd = L % NXCD, off = L / NXCD; return (xcd < r ? xcd * (q + 1) : r * (q + 1) + (xcd - r) * q) + off; }

struct Unit { int pm, pn, e, rows, mt; };

struct DenseSched {
    int nM, nN, nwg, G, c, K; const char* Bt;
    __device__ __forceinline__ void init(int M, int N, int K_, int G_, int c_, const void* Bt_) { nM = M / BM; nN = N / BM; nwg = nM * nN; G = G_; c = c_; K = K_; Bt = (const char*)Bt_; }
    __device__ __forceinline__ bool next(int i, Unit& u) const {
        const long L = (long)i * G + c; if (L >= nwg) return false;
        const int wgid = xcd_remap((int)L, nwg);
        const int nig = WGM * nN, gid = wgid / nig, fm = gid * WGM, gsz = (nM - fm) < WGM ? (nM - fm) : WGM;
        u.pm = fm + ((wgid % nig) % gsz); u.pn = (wgid % nig) / gsz; u.e = 0; u.rows = 256; u.mt = u.pm; return true;
    }
    __device__ __forceinline__ unsigned a_off(const Unit& u, int h, int R, int C) const { return (unsigned)(((u.pm * BM + h * HALF + R) * K + C) * 2); }
    __device__ __forceinline__ const char* b_ptr(const Unit& u) const { return Bt + (size_t)u.pn * BM * K * 2; }
};

struct GroupSched {
    int nunits, G, c, shift, NTR, mode, K; const LAS unsigned short* tile_e; const LAS int* tbase; const LAS int* cnt; const int* bins; const char* Bt; size_t estride;
    __device__ __forceinline__ bool next(int i, Unit& u) const {
        const long L = (long)i * G + c; if (L >= nunits) return false;
        const int wgid = xcd_remap((int)L, nunits);
        const int tau = wgid >> shift; u.pn = wgid & ((1 << shift) - 1); u.pm = tau;
        if (tau < NTR) { const int e = tile_e[tau]; u.e = e; u.mt = tau - tbase[e]; const int left = cnt[e] - u.mt * 256; u.rows = left < 256 ? left : 256; }
        else { u.e = NE; u.mt = tau - NTR; u.rows = 256; }
        return true;
    }
    __device__ __forceinline__ unsigned a_off(const Unit& u, int h, int R, int C) const {
        if (mode == 0) { const int rl = h * HALF + R; int tok;
            if (u.e < NE) tok = (rl < u.rows) ? (bins[(size_t)u.e * T + u.mt * 256 + rl] >> 3) : 0; else tok = u.mt * 256 + rl;
            return (unsigned)((tok * 1024 + C) * 2); }
        return (unsigned)(((u.pm * BM + h * HALF + R) * 256 + C) * 2);
    }
    __device__ __forceinline__ const char* b_ptr(const Unit& u) const { return Bt + (size_t)u.e * estride + (size_t)u.pn * BM * K * 2; }
};

__device__ __forceinline__ unsigned cvt_pk_bf16(float lo, float hi) { unsigned r; asm volatile("v_cvt_pk_bf16_f32 %0, %1, %2" : "=v"(r) : "v"(lo), "v"(hi)); return r; }

template <class Epi, class Sched>
__device__ __forceinline__ void gemm_phase(LAS unsigned char* lds, const char* Abase, int K, const Sched& S, const Epi& E) {
    const int tid = threadIdx.x, wid = __builtin_amdgcn_readfirstlane(tid >> 6), lane = tid & 63, wr = wid >> 2, wc = wid & 3, fr = lane & 15, fq = lane >> 4;
    const int nt = K / BK;
    int RA[2], CA[2]; unsigned voffB[2];
#pragma unroll
    for (int i = 0; i < 2; ++i) { int R, C; stage_rc(tid * 16 + i * 8192, R, C); const int Rb = Epi::PERM ? ((R & ~31) + perm32(R & 31)) : R; RA[i] = R; CA[i] = C; voffB[i] = (unsigned)(Rb * K + C) * 2u; }
    const size_t kstep = (size_t)(BK * 2);
    const size_t hstep = (size_t)HALF * K * 2;
    const unsigned ldsw = (unsigned)wid * 1024u;
    const int aoff = lds_byte(wr * 64 + fr, fq * 8), boff = lds_byte(wc * 32 + fr, fq * 8);
#define PG8_SA(b, h) (((b) * 2 + (h)) * HTB)
#define PG8_SB(b, h) ((4 + (b) * 2 + (h)) * HTB)
#define PG8_STAGEB(bufoff, gbase) do { _Pragma("unroll") for (int _i = 0; _i < 2; ++_i) \
        __builtin_amdgcn_global_load_lds((const unsigned*)((const char*)(gbase) + voffB[_i]), (LAS unsigned*)(lds + (bufoff) + ldsw + _i * 8192), 16, 0, 0); } while (0)
#define PG8_STAGEA(bufoff, koff, v0, v1) do { \
        __builtin_amdgcn_global_load_lds((const unsigned*)(Abase + (koff) + (v0)), (LAS unsigned*)(lds + (bufoff) + ldsw), 16, 0, 0); \
        __builtin_amdgcn_global_load_lds((const unsigned*)(Abase + (koff) + (v1)), (LAS unsigned*)(lds + (bufoff) + ldsw + 8192), 16, 0, 0); } while (0)
#define PG8_LDA(dst, b, h) do { _Pragma("unroll") for (int m = 0; m < 4; ++m) _Pragma("unroll") for (int k = 0; k < 2; ++k) dst[m][k] = *(const LAS bf16x8*)(lds + PG8_SA(b, h) + aoff + m * 2048 + k * 1024); } while (0)
#define PG8_LDB(dst, b, h) do { _Pragma("unroll") for (int n = 0; n < 2; ++n) _Pragma("unroll") for (int k = 0; k < 2; ++k) dst[n][k] = *(const LAS bf16x8*)(lds + PG8_SB(b, h) + boff + n * 2048 + k * 1024); } while (0)
#define PG8_MMA(ai, bj, At, Bt) do { __builtin_amdgcn_s_setprio(1); _Pragma("unroll") for (int m = 0; m < 4; ++m) _Pragma("unroll") for (int n = 0; n < 2; ++n) _Pragma("unroll") for (int k = 0; k < 2; ++k) \
        acc[ai][bj][m][n] = __builtin_amdgcn_mfma_f32_16x16x32_bf16(Bt[n][k], At[m][k], acc[ai][bj][m][n], 0, 0, 0); __builtin_amdgcn_s_setprio(0); } while (0)
#define PG8_WAIT_V(n) asm volatile("s_waitcnt vmcnt(" #n ")" ::: "memory")
#define PG8_WAIT_L(n) asm volatile("s_waitcnt lgkmcnt(" #n ")" ::: "memory")
#define PG8_BAR __builtin_amdgcn_s_barrier()
#define PG8_SCHED __builtin_amdgcn_sched_barrier(0)
    Unit cur, nxt; int ui = 0;
    if (!S.next(0, cur)) return;
    unsigned vc00 = S.a_off(cur, 0, RA[0], CA[0]), vc01 = S.a_off(cur, 0, RA[1], CA[1]), vc10 = S.a_off(cur, 1, RA[0], CA[0]), vc11 = S.a_off(cur, 1, RA[1], CA[1]);
    asm volatile("" : "+v"(vc00), "+v"(vc01), "+v"(vc10), "+v"(vc11));
    f32x4 acc[2][2][4][2];
#pragma unroll
    for (int a = 0; a < 2; ++a)
#pragma unroll
        for (int b = 0; b < 2; ++b)
#pragma unroll
            for (int m = 0; m < 4; ++m)
#pragma unroll
                for (int n = 0; n < 2; ++n) acc[a][b][m][n] = (f32x4){0.f, 0.f, 0.f, 0.f};
    bf16x8 At[4][2], B0[2][2], B1[2][2];
    const char* cB = S.b_ptr(cur);
    PG8_STAGEB(PG8_SB(0, 0), cB); PG8_STAGEB(PG8_SB(0, 1), cB + hstep); PG8_STAGEA(PG8_SA(0, 0), 0, vc00, vc01); PG8_STAGEA(PG8_SA(0, 1), 0, vc10, vc11);
    if (wr == 1) PG8_BAR;
    PG8_WAIT_V(2); PG8_BAR;
    PG8_STAGEB(PG8_SB(1, 0), cB + kstep); PG8_STAGEA(PG8_SA(1, 0), kstep, vc00, vc01); PG8_STAGEB(PG8_SB(1, 1), cB + hstep + kstep);
    PG8_WAIT_V(6); PG8_BAR;
    for (;;) {
        const bool has_next = S.next(ui + 1, nxt);
        unsigned vn00 = vc00, vn01 = vc01, vn10 = vc10, vn11 = vc11;
        if (has_next) { vn00 = S.a_off(nxt, 0, RA[0], CA[0]); vn01 = S.a_off(nxt, 0, RA[1], CA[1]); vn10 = S.a_off(nxt, 1, RA[0], CA[0]); vn11 = S.a_off(nxt, 1, RA[1], CA[1]); }
        asm volatile("" : "+v"(vn00), "+v"(vn01), "+v"(vn10), "+v"(vn11));
        const char* nB = has_next ? S.b_ptr(nxt) : cB;
        for (int t = 0; t < nt; t += 2) {
            const bool last = (t == nt - 2);
            const size_t k1 = (size_t)(t + 1) * kstep;
            const size_t k2 = last ? 0 : (size_t)(t + 2) * kstep, k3 = k2 + kstep;
            const char* b2 = last ? nB : cB + (size_t)(t + 2) * kstep; const char* b3 = b2 + kstep;
            const unsigned s00 = last ? vn00 : vc00, s01 = last ? vn01 : vc01, s10 = last ? vn10 : vc10, s11 = last ? vn11 : vc11;
            PG8_LDB(B0, 0, 0); PG8_LDB(B1, 0, 1); PG8_SCHED; PG8_LDA(At, 0, 0); PG8_STAGEA(PG8_SA(1, 1), k1, vc10, vc11);
            PG8_WAIT_V(8); PG8_WAIT_L(0); PG8_BAR; PG8_MMA(0, 0, At, B0); PG8_MMA(0, 1, At, B1); PG8_BAR; PG8_SCHED;
            PG8_LDA(At, 0, 1); PG8_STAGEB(PG8_SB(0, 0), b2); PG8_STAGEB(PG8_SB(0, 1), b2 + hstep); PG8_STAGEA(PG8_SA(0, 0), k2, s00, s01);
            PG8_WAIT_V(8); PG8_WAIT_L(0); PG8_BAR; PG8_MMA(1, 0, At, B0); PG8_MMA(1, 1, At, B1); PG8_BAR; PG8_SCHED;
            PG8_LDB(B0, 1, 0); PG8_LDB(B1, 1, 1); PG8_SCHED; PG8_LDA(At, 1, 0); PG8_STAGEA(PG8_SA(0, 1), k2, s10, s11);
            PG8_WAIT_V(8); PG8_WAIT_L(0); PG8_BAR; PG8_MMA(0, 0, At, B0); PG8_MMA(0, 1, At, B1); PG8_BAR; PG8_SCHED;
            PG8_LDA(At, 1, 1); PG8_STAGEB(PG8_SB(1, 0), b3); PG8_STAGEB(PG8_SB(1, 1), b3 + hstep); PG8_STAGEA(PG8_SA(1, 0), k3, s00, s01);
            PG8_WAIT_V(8); PG8_WAIT_L(0); PG8_BAR; PG8_MMA(1, 0, At, B0); PG8_MMA(1, 1, At, B1); PG8_BAR; PG8_SCHED;
        }
        if (wr == 0) PG8_BAR;
        E(acc, cur, wr, wc, fr, fq);
        if (!has_next) break;
#pragma unroll
        for (int a = 0; a < 2; ++a)
#pragma unroll
            for (int b = 0; b < 2; ++b)
#pragma unroll
                for (int m = 0; m < 4; ++m)
#pragma unroll
                    for (int n = 0; n < 2; ++n) acc[a][b][m][n] = (f32x4){0.f, 0.f, 0.f, 0.f};
        cur = nxt; cB = nB; vc00 = vn00; vc01 = vn01; vc10 = vn10; vc11 = vn11; ++ui;
        if (wr == 1) PG8_BAR;
    }
    PG8_WAIT_V(0);
    PG8_BAR;
#undef PG8_SA
#undef PG8_SB
#undef PG8_STAGEA
#undef PG8_STAGEB
#undef PG8_LDA
#undef PG8_LDB
#undef PG8_MMA
#undef PG8_WAIT_V
#undef PG8_WAIT_L
#undef PG8_BAR
#undef PG8_SCHED
}

struct EpiInProj {
    static constexpr bool PERM = true;
    bf16_t *Q, *Kb, *V, *U, *QM;
    __device__ __forceinline__ void operator()(const f32x4 (&acc)[2][2][4][2], const Unit& u, int wr, int wc, int fr, int fq) const {
        bf16_t* base; int ldc, colt; float sc = 1.f; const int pn = u.pn;
        if (pn < 2) { base = Q; ldc = 512; colt = pn * 256; sc = C2; } else if (pn < 4) { base = Kb; ldc = 512; colt = (pn - 2) * 256; } else if (pn < 6) { base = V; ldc = 512; colt = (pn - 4) * 256; }
        else if (pn == 6) { base = U; ldc = 256; colt = 0; } else { base = QM; ldc = 256; colt = 0; sc = C2; }
        const int row0 = u.pm * BM + wr * 64 + fr, col0 = colt + wc * 32 + 8 * fq;
#pragma unroll
        for (int ai = 0; ai < 2; ++ai)
#pragma unroll
            for (int m = 0; m < 4; ++m) { bf16_t* rowp = base + (size_t)(row0 + ai * HALF + m * 16) * ldc + col0;
#pragma unroll
                for (int bj = 0; bj < 2; ++bj) { const f32x4 v0 = acc[ai][bj][m][0] * sc, v1 = acc[ai][bj][m][1] * sc;
                    u32x4 w; w.x = cvt_pk_bf16(v0[0], v0[1]); w.y = cvt_pk_bf16(v0[2], v0[3]); w.z = cvt_pk_bf16(v1[0], v1[1]); w.w = cvt_pk_bf16(v1[2], v1[3]);
                    *(u32x4*)(rowp + bj * HALF) = w; } }
    }
};
struct EpiBf16 {
    static constexpr bool PERM = true;
    bf16_t* O; int ldc;
    __device__ __forceinline__ void operator()(const f32x4 (&acc)[2][2][4][2], const Unit& u, int wr, int wc, int fr, int fq) const {
        const int row0 = u.pm * BM + wr * 64 + fr, col0 = u.pn * BM + wc * 32 + 8 * fq;
#pragma unroll
        for (int ai = 0; ai < 2; ++ai)
#pragma unroll
            for (int m = 0; m < 4; ++m) { bf16_t* rowp = O + (size_t)(row0 + ai * HALF + m * 16) * ldc + col0;
#pragma unroll
                for (int bj = 0; bj < 2; ++bj) { const f32x4 v0 = acc[ai][bj][m][0], v1 = acc[ai][bj][m][1];
                    u32x4 w; w.x = cvt_pk_bf16(v0[0], v0[1]); w.y = cvt_pk_bf16(v0[2], v0[3]); w.z = cvt_pk_bf16(v1[0], v1[1]); w.w = cvt_pk_bf16(v1[2], v1[3]);
                    *(u32x4*)(rowp + bj * HALF) = w; } }
    }
};
struct EpiF32 {
    static constexpr bool PERM = false;
    float* C; int ldc; const float* R; float rs;
    __device__ __forceinline__ void operator()(const f32x4 (&acc)[2][2][4][2], const Unit& u, int wr, int wc, int fr, int fq) const {
        const int row0 = u.pm * BM + wr * 64 + fr, col0 = u.pn * BM + wc * 32 + 4 * fq;
#pragma unroll
        for (int ai = 0; ai < 2; ++ai)
#pragma unroll
            for (int m = 0; m < 4; ++m) { const size_t off = (size_t)(row0 + ai * HALF + m * 16) * ldc + col0;
#pragma unroll
                for (int bj = 0; bj < 2; ++bj)
#pragma unroll
                    for (int n = 0; n < 2; ++n) { f32x4 v = acc[ai][bj][m][n]; if (R) v += *(const f32x4*)(R + off + bj * HALF + n * 16) * rs; *(f32x4*)(C + off + bj * HALF + n * 16) = v; }
                if (m & 1) asm volatile("" ::: "memory"); }
    }
};
struct EpiGateUp {
    static constexpr bool PERM = true;
    bf16_t* H;
    __device__ __forceinline__ void operator()(const f32x4 (&acc)[2][2][4][2], const Unit& u, int wr, int wc, int fr, int fq) const {
        const int row0 = u.pm * BM + wr * 64 + fr, col0 = u.pn * 128 + wc * 32 + 8 * fq;
#pragma unroll
        for (int ai = 0; ai < 2; ++ai)
#pragma unroll
            for (int m = 0; m < 4; ++m) { bf16_t* rowp = H + (size_t)(row0 + ai * HALF + m * 16) * EH + col0; float hv[8];
#pragma unroll
                for (int n = 0; n < 2; ++n)
#pragma unroll
                    for (int j = 0; j < 4; ++j) { const float g = acc[ai][0][m][n][j], up = acc[ai][1][m][n][j]; hv[n * 4 + j] = g * __builtin_amdgcn_rcpf(1.f + __builtin_amdgcn_exp2f(-g * LOG2E)) * up; }
                u32x4 w; w.x = cvt_pk_bf16(hv[0], hv[1]); w.y = cvt_pk_bf16(hv[2], hv[3]); w.z = cvt_pk_bf16(hv[4], hv[5]); w.w = cvt_pk_bf16(hv[6], hv[7]);
                *(u32x4*)rowp = w; }
    }
};
struct EpiDown {
    static constexpr bool PERM = true;
    bf16_t* Y; float* SH; const int* bins; const float* gates;
    __device__ __forceinline__ void operator()(const f32x4 (&acc)[2][2][4][2], const Unit& u, int wr, int wc, int fr, int fq) const {
        const int col0 = u.pn * BM + wc * 32 + 8 * fq;
        if (u.e == NE) {
#pragma unroll
            for (int ai = 0; ai < 2; ++ai)
#pragma unroll
                for (int m = 0; m < 4; ++m) { const int tok = u.mt * 256 + ai * HALF + wr * 64 + m * 16 + fr; float* rowp = SH + (size_t)tok * DM + col0;
#pragma unroll
                    for (int bj = 0; bj < 2; ++bj) { *(f32x4*)(rowp + bj * HALF) = acc[ai][bj][m][0]; *(f32x4*)(rowp + bj * HALF + 4) = acc[ai][bj][m][1]; } }
        } else {
            const int* bp = bins + (size_t)u.e * T + u.mt * 256;
#pragma unroll
            for (int ai = 0; ai < 2; ++ai)
#pragma unroll
                for (int m = 0; m < 4; ++m) { const int rl = ai * HALF + wr * 64 + m * 16 + fr;
                    if (rl < u.rows) { const int a = bp[rl]; const float g = gates[a]; bf16_t* rowp = Y + (size_t)a * DM + col0;
#pragma unroll
                        for (int bj = 0; bj < 2; ++bj) { const f32x4 v0 = acc[ai][bj][m][0] * g, v1 = acc[ai][bj][m][1] * g;
                            u32x4 w; w.x = cvt_pk_bf16(v0[0], v0[1]); w.y = cvt_pk_bf16(v0[2], v0[3]); w.z = cvt_pk_bf16(v1[0], v1[1]); w.w = cvt_pk_bf16(v1[2], v1[3]);
                            *(u32x4*)(rowp + bj * HALF) = w; } } }
        }
    }
};
}

namespace att {
constexpr int SLOTB = 8192, L_K = 0, L_V = 2 * SLOTB, L_WS = 4 * SLOTB, L_OST = L_WS + 8 * 256, L_FK = L_OST + 8 * 4096, L_END = L_FK + 16384;
#define SBAR() __builtin_amdgcn_sched_barrier(0)
__device__ __forceinline__ int crow(int r, int hi) { return (r & 3) + 8 * (r >> 2) + 4 * hi; }
__device__ __forceinline__ void glds16(const void* gsrc, unsigned lds_dst) { unsigned keep;
    asm volatile("s_mov_b32 %0, m0\n\ts_mov_b32 m0, %2\n\ts_nop 0\n\tglobal_load_lds_dwordx4 %1, off\n\ts_mov_b32 m0, %0" : "=&s"(keep) : "v"(gsrc), "s"(lds_dst) : "memory"); }
__device__ __forceinline__ unsigned cvtpk(float lo, float hi) { unsigned r; asm("v_cvt_pk_bf16_f32 %0, %1, %2" : "=v"(r) : "v"(lo), "v"(hi)); return r; }
#define ATT_WAIT_BAR() asm volatile("s_waitcnt vmcnt(0) lgkmcnt(0)\n\ts_barrier" ::: "memory")

struct Job { const bf16_t* Q; int qpitch; const bf16_t* K; const bf16_t* V; int kvpitch; bf16_t* O; int nt; int causal; const float* FC; int q0; };

template <bool FOX> __device__ __forceinline__ void unit(const Job& j, LAS unsigned char* shm) {
    const int tid = threadIdx.x, lane = tid & 63, r32 = lane & 31, hi = lane >> 5; const int wid = __builtin_amdgcn_readfirstlane(tid >> 6);
    const unsigned lds0 = (unsigned)(uintptr_t)shm;
    LAS float* wsf = (LAS float*)(shm + L_WS) + wid * 64;
    LAS float* fk = (LAS float*)(shm + L_FK);
    const int NT = j.nt;
    float fq = 0.f;
    if (FOX) {
        for (int i = tid; i < NT * 16; i += 512) *(LAS f32x4*)(fk + 4 * i) = *(const f32x4*)(j.FC + 4 * i);
        fq = j.FC[j.q0 + wid * 32 + r32];
    }
    const bf16_t* ksrc = j.K + (size_t)lane * j.kvpitch + wid * 8;
    const bf16_t* vsrc = j.V + (size_t)(16 * (wid & 3) + (lane >> 2)) * j.kvpitch + (wid >> 2) * 32 + (lane & 3) * 8;
    const unsigned kdst = lds0 + L_K + wid * 1024, vdst = lds0 + L_V + wid * 1024;
#define DMA_K(t, slot) glds16(ksrc + (size_t)(t) * 64 * j.kvpitch, (unsigned)__builtin_amdgcn_readfirstlane(kdst + (slot) * SLOTB))
#define DMA_V(t, slot) glds16(vsrc + (size_t)(t) * 64 * j.kvpitch, (unsigned)__builtin_amdgcn_readfirstlane(vdst + (slot) * SLOTB))
    const bf16_t* Qw = j.Q + (size_t)(wid * 32) * j.qpitch;
    bf16x8 qr[4];
#pragma unroll
    for (int d0 = 0; d0 < 4; ++d0) qr[d0] = *reinterpret_cast<const bf16x8*>(Qw + (size_t)r32 * j.qpitch + d0 * 16 + hi * 8);
    asm volatile("s_waitcnt vmcnt(0) lgkmcnt(0)" ::: "memory");
    { const int t0 = FOX ? NT - 1 : 0; DMA_K(t0, 0); DMA_V(t0, 0); }
    float mrun = -1e30f, l_reg = 0.f; f32x16 o[2]; o[0] = f32x16{}; o[1] = f32x16{};
    const int qrel = wid * 32 + r32;
    for (int it = 0; it < NT; ++it) {
        const int tcur = FOX ? NT - 1 - it : it, slot = it & 1;
        ATT_WAIT_BAR();
        if (it + 1 < NT) { const int tn = FOX ? tcur - 1 : tcur + 1; DMA_K(tn, slot ^ 1); DMA_V(tn, slot ^ 1); }
        f32x16 p0, p1;
        if (FOX) {
#pragma unroll
            for (int g = 0; g < 4; ++g) { const f32x4 a = *(const LAS f32x4*)(fk + 64 * tcur + 8 * g + 4 * hi), b = *(const LAS f32x4*)(fk + 64 * tcur + 32 + 8 * g + 4 * hi);
#pragma unroll
                for (int i = 0; i < 4; ++i) { p0[4 * g + i] = fq - a[i]; p1[4 * g + i] = fq - b[i]; } }
        } else { p0 = f32x16{}; p1 = f32x16{}; }
        { const LAS unsigned char* kb = shm + L_K + slot * SLOTB + hi * 1024 + r32 * 16;
#pragma unroll
          for (int d0 = 0; d0 < 4; ++d0) { const bf16x8 b0 = *(const LAS bf16x8*)(kb + d0 * 2048), b1 = *(const LAS bf16x8*)(kb + d0 * 2048 + 512);
              p0 = __builtin_amdgcn_mfma_f32_32x32x16_bf16(b0, qr[d0], p0, 0, 0, 0); p1 = __builtin_amdgcn_mfma_f32_32x32x16_bf16(b1, qr[d0], p1, 0, 0, 0); } }
        if (j.causal && tcur >= NT - 4) { const int kb0 = 64 * (tcur - (NT - 4)) + 4 * hi;
#pragma unroll
            for (int r = 0; r < 16; ++r) { const int kv = kb0 + (r & 3) + 8 * (r >> 2); if (kv > qrel) p0[r] = -INFINITY; if (kv + 32 > qrel) p1[r] = -INFINITY; } }
        float rm = p0[0];
#pragma unroll
        for (int r = 1; r < 16; ++r) rm = fmaxf(rm, p0[r]);
#pragma unroll
        for (int r = 0; r < 16; ++r) rm = fmaxf(rm, p1[r]);
        rm = fmaxf(rm, __shfl_xor(rm, 32));
        const float mn = fmaxf(mrun, rm), alpha = __builtin_amdgcn_exp2f(mrun - mn); mrun = mn;
        float rs = 0.f;
#pragma unroll
        for (int r = 0; r < 16; ++r) { p0[r] = __builtin_amdgcn_exp2f(p0[r] - mn); p1[r] = __builtin_amdgcn_exp2f(p1[r] - mn); rs += p0[r] + p1[r]; }
        l_reg = l_reg * alpha + rs;
        if (hi == 0) wsf[r32] = alpha;
        LDS_WAIT();
#pragma unroll
        for (int r = 0; r < 16; ++r) { const float f = wsf[crow(r, hi)]; o[0][r] *= f; o[1][r] *= f; }
        u32x4 pw0, pw1, pw2, pw3;
        pw0 = (u32x4){cvtpk(p0[0], p0[1]), cvtpk(p0[2], p0[3]), cvtpk(p0[4], p0[5]), cvtpk(p0[6], p0[7])};
        pw1 = (u32x4){cvtpk(p0[8], p0[9]), cvtpk(p0[10], p0[11]), cvtpk(p0[12], p0[13]), cvtpk(p0[14], p0[15])};
        pw2 = (u32x4){cvtpk(p1[0], p1[1]), cvtpk(p1[2], p1[3]), cvtpk(p1[4], p1[5]), cvtpk(p1[6], p1[7])};
        pw3 = (u32x4){cvtpk(p1[8], p1[9]), cvtpk(p1[10], p1[11]), cvtpk(p1[12], p1[13]), cvtpk(p1[14], p1[15])};
        const bf16x8 pa0 = __builtin_bit_cast(bf16x8, pw0), pa1 = __builtin_bit_cast(bf16x8, pw1), pa2 = __builtin_bit_cast(bf16x8, pw2), pa3 = __builtin_bit_cast(bf16x8, pw3);
        const int vb = (int)(lds0 + L_V + slot * SLOTB) + ((lane >> 4) & 1) * 32 + (lane & 3) * 8 + (4 * hi + ((lane & 15) >> 2)) * 64;
#pragma unroll
        for (int d0 = 0; d0 < 2; ++d0) { s16x4 lo[4], hh[4];
#pragma unroll
            for (int ks = 0; ks < 4; ++ks) {
                asm volatile("ds_read_b64_tr_b16 %0,%1 offset:%c2" : "=&v"(lo[ks]) : "v"(vb), "i"(d0 * 4096 + ks * 1024) : "memory");
                asm volatile("ds_read_b64_tr_b16 %0,%1 offset:%c2" : "=&v"(hh[ks]) : "v"(vb), "i"(d0 * 4096 + ks * 1024 + 512) : "memory"); }
            asm volatile("s_waitcnt lgkmcnt(0)" ::: "memory"); SBAR();
#define PK(k) (bf16x8){lo[k][0], lo[k][1], lo[k][2], lo[k][3], hh[k][0], hh[k][1], hh[k][2], hh[k][3]}
            o[d0] = __builtin_amdgcn_mfma_f32_32x32x16_bf16(pa0, PK(0), o[d0], 0, 0, 0);
            o[d0] = __builtin_amdgcn_mfma_f32_32x32x16_bf16(pa1, PK(1), o[d0], 0, 0, 0);
            o[d0] = __builtin_amdgcn_mfma_f32_32x32x16_bf16(pa2, PK(2), o[d0], 0, 0, 0);
            o[d0] = __builtin_amdgcn_mfma_f32_32x32x16_bf16(pa3, PK(3), o[d0], 0, 0, 0);
#undef PK
        }
    }
    l_reg += __shfl_xor(l_reg, 32);
    if (hi == 0) wsf[32 + r32] = l_reg;
    LDS_WAIT();
    float rli[16];
#pragma unroll
    for (int r = 0; r < 16; ++r) rli[r] = 1.0f / wsf[32 + crow(r, hi)];
    bf16_t* Ow = j.O + (size_t)(wid * 32) * DM;
    { LAS bf16_t* stg = (LAS bf16_t*)(shm + L_OST) + wid * 2048;
#pragma unroll
      for (int r = 0; r < 16; ++r) { const int orow = crow(r, hi);
#pragma unroll
          for (int d0 = 0; d0 < 2; ++d0) stg[orow * 64 + d0 * 32 + r32] = (bf16_t)f2bf(o[d0][r] * rli[r]); }
      LDS_WAIT();
#pragma unroll
      for (int i = 0; i < 4; ++i) { const int row = i * 8 + (lane >> 3), ch = lane & 7; const u32x4 v = *(const LAS u32x4*)(stg + row * 64 + ch * 8); *(u32x4*)(Ow + (size_t)row * DM + ch * 8) = v; } }
    asm volatile("s_waitcnt vmcnt(0) lgkmcnt(0)\n\ts_barrier" ::: "memory");
#undef DMA_K
#undef DMA_V
}
#undef SBAR
}

struct Ctx { int tid, lane, wave, vcu, G; LAS unsigned char* lds; };

__device__ __forceinline__ void tr_item(const float* W, int ldw, bf16_t* WT, int ldt, LAS float* scr, int lane) {
#pragma unroll 8
    for (int i = 0; i < 32; ++i) { const int kk = 2 * i + (lane >> 5); scr[kk * 33 + (lane & 31)] = W[(size_t)kk * ldw + (lane & 31)]; }
    LDS_WAIT(); asm volatile("" ::: "memory");
    const int c = lane & 7;
#pragma unroll
    for (int j = 0; j < 4; ++j) { const int n = (lane >> 3) + 8 * j; const LAS float* s = scr + (8 * c) * 33 + n;
        u32x4 o; o.x = pk2(s[0 * 33], s[1 * 33]); o.y = pk2(s[2 * 33], s[3 * 33]); o.z = pk2(s[4 * 33], s[5 * 33]); o.w = pk2(s[6 * 33], s[7 * 33]);
        *(u32x4*)(WT + (size_t)n * ldt + 8 * c) = o; }
    LDS_WAIT(); asm volatile("" ::: "memory");
}

__device__ __forceinline__ void p0_prologue(const Args& a, const Ctx& c) {
    unsigned char* ws = a.ws;
    bf16_t* WGU = (bf16_t*)(ws + WS_WGU); bf16_t* WD = (bf16_t*)(ws + WS_WD); bf16_t* WIN = (bf16_t*)(ws + WS_WIN); bf16_t* WMKV = (bf16_t*)(ws + WS_WMKV);
    bf16_t* WOUT = (bf16_t*)(ws + WS_WOUT); bf16_t* WR = (bf16_t*)(ws + WS_WR);
    LAS float* WfT = (LAS float*)c.lds;
    LAS float* scr = (LAS float*)(c.lds + 32768 + c.wave * 8448);
    for (int idx = c.tid; idx < 8192; idx += 512) { const int h = idx & 7, k = idx >> 3; WfT[h * 1024 + k] = a.w_in[(size_t)k * INC + 1792 + h]; }
    const int gw = c.vcu * 8 + c.wave, NGW = c.G * 8;
    constexpr int NEXP_ITEMS = (NE + 1) * 384;
    constexpr int I_WIN = 1024, I_MKV = 256, I_OUT = 384, I_R = 128;
    constexpr int NITEMS = NEXP_ITEMS + I_WIN + I_MKV + I_OUT + I_R;
    for (int it = gw; it < NITEMS; it += NGW) {
        int r = it;
        if (r < NEXP_ITEMS) { const int e = r / 384; r -= e * 384;
            if (r < 256) { const int up = r >> 7; r &= 127; const int kb = r >> 3, nb = r & 7, n0 = nb * 32;
                const float* src = (e < NE) ? ((up ? a.w_up : a.w_gate) + (size_t)e * DM * EH) : (up ? a.ws_up : a.ws_gate);
                const int drow = (n0 >> 7) * 256 + up * 128 + (n0 & 127);
                tr_item(src + (size_t)kb * 64 * EH + n0, EH, WGU + ((size_t)e * 512 + drow) * DM + kb * 64, DM, scr, c.lane);
            } else { r -= 256; const int kb = r >> 5, nb = r & 31;
                const float* src = (e < NE) ? (a.w_down + (size_t)e * EH * DM) : a.ws_down;
                tr_item(src + (size_t)kb * 64 * DM + nb * 32, DM, WD + ((size_t)e * DM + nb * 32) * EH + kb * 64, EH, scr, c.lane); }
            continue; }
        r -= NEXP_ITEMS;
        if (r < I_WIN) {
            int col0, drow0, nbw;
            if (r < 256) { col0 = 256; drow0 = 0; nbw = 16; } else if (r < 512) { r -= 256; col0 = 768; drow0 = 512; nbw = 16; } else if (r < 768) { r -= 512; col0 = 1280; drow0 = 1024; nbw = 16; }
            else if (r < 896) { r -= 768; col0 = 0; drow0 = 1536; nbw = 8; } else { r -= 896; col0 = 1800; drow0 = 1792; nbw = 8; }
            const int kb = r / nbw, nb = r % nbw;
            tr_item(a.w_in + (size_t)kb * 64 * INC + col0 + nb * 32, INC, WIN + (size_t)(drow0 + nb * 32) * DM + kb * 64, DM, scr, c.lane);
            continue; }
        r -= I_WIN;
        if (r < I_MKV) { const int kb = r >> 4, nb = r & 15; tr_item(a.w_mem_kv + (size_t)kb * 64 * 512 + nb * 32, 512, WMKV + (size_t)(nb * 32) * DM + kb * 64, DM, scr, c.lane); continue; }
        r -= I_MKV;
        if (r < I_OUT) { const int kb = r >> 5, nb = r & 31; tr_item(a.w_out + (size_t)(256 + kb * 64) * DM + nb * 32, DM, WOUT + (size_t)(nb * 32) * DM + 256 + kb * 64, DM, scr, c.lane); continue; }
        r -= I_OUT;
        { const int kb = r >> 3, nb = r & 7; tr_item(a.w_router + (size_t)kb * 64 * NE + nb * 32, NE, WR + (size_t)(nb * 32) * DM + kb * 64, DM, scr, c.lane); }
    }
    for (int idx = (c.vcu * 512 + c.tid); idx < 256 * 1024; idx += c.G * 512) { const int k = idx >> 10, n = idx & 1023, g = k >> 6, cc = k & 63; float s = 0.f;
        for (int d = 0; d < 64; ++d) s += a.w_pool[g * 4096 + cc * 64 + d] * a.pool_scale[g * 64 + d] * a.w_out[(size_t)(g * 64 + d) * DM + n];
        WOUT[(size_t)n * DM + k] = (bf16_t)f2bf(s); }
    __syncthreads();
    bf16_t* XB = (bf16_t*)(ws + WS_XB); float* FLOG = (float*)(ws + WS_FLOG);
    for (int m = gw; m < T; m += NGW) {
        const f32x4* xr = (const f32x4*)(a.x + (size_t)m * DM) + c.lane; f32x4 v[4];
#pragma unroll
        for (int j = 0; j < 4; ++j) v[j] = xr[64 * j];
        u32x2* o8 = (u32x2*)(XB + (size_t)m * DM) + c.lane;
#pragma unroll
        for (int j = 0; j < 4; ++j) o8[64 * j] = (u32x2){pk2(v[j].x, v[j].y), pk2(v[j].z, v[j].w)};
        float acc[8];
#pragma unroll
        for (int h = 0; h < 8; ++h) { float s = 0.f;
#pragma unroll
            for (int j = 0; j < 4; ++j) { const f32x4 w = *(const LAS f32x4*)(WfT + h * 1024 + 4 * c.lane + 256 * j); s += (v[j].x * w.x + v[j].y * w.y) + (v[j].z * w.z + v[j].w * w.w); }
            acc[h] = wave_sum(s); }
        float z = acc[0];
#pragma unroll
        for (int h = 1; h < 8; ++h) z = (c.lane == h) ? acc[h] : z;
        if (c.lane < 8) { z += a.b_f[c.lane]; const float lf = (z >= 0.f) ? -log1pf(expf(-z)) : (z - log1pf(expf(z))); FLOG[(size_t)m * 8 + c.lane] = lf; }
    }
    bf16_t* MEMB = (bf16_t*)(ws + WS_MEMB);
    for (int m = gw; m < NB * 256; m += NGW) {
        const f32x4* xr = (const f32x4*)(a.mem + (size_t)m * DM) + c.lane; u32x2* o8 = (u32x2*)(MEMB + (size_t)m * DM) + c.lane;
#pragma unroll
        for (int j = 0; j < 4; ++j) { const f32x4 v = xr[64 * j]; o8[64 * j] = (u32x2){pk2(v.x, v.y), pk2(v.z, v.w)}; }
    }
}

__device__ __forceinline__ void p1_fscan(const Args& a, const Ctx& c) {
    if (c.vcu >= 64) return;
    const float* FLOG = (const float*)(a.ws + WS_FLOG); float* FC = (float*)(a.ws + WS_FC);
    LAS float* wtot = (LAS float*)c.lds;
    const int bh = c.vcu, b = bh >> 3, h = bh & 7; float p[8]; float run = 0.f;
#pragma unroll
    for (int i = 0; i < 8; ++i) { run += FLOG[((size_t)b * SEQ + c.tid * 8 + i) * 8 + h]; p[i] = run; }
    float inc = run;
#pragma unroll
    for (int o = 1; o < 64; o <<= 1) { const float t = __shfl_up(inc, o); if (c.lane >= o) inc += t; }
    if (c.lane == 63) wtot[c.wave] = inc;
    __syncthreads();
    float base = inc - run;
    for (int w = 0; w < c.wave; ++w) base += wtot[w];
#pragma unroll
    for (int i = 0; i < 8; ++i) FC[(size_t)bh * SEQ + c.tid * 8 + i] = (base + p[i]) * LOG2E;
    __syncthreads();
}

__device__ __forceinline__ void p2_mixers(const Args& a, const Ctx& c) {
    unsigned char* ws = a.ws;
    const bf16_t* Q = (const bf16_t*)(ws + WS_Q); const bf16_t* Kb = (const bf16_t*)(ws + WS_K); const bf16_t* V = (const bf16_t*)(ws + WS_V); const bf16_t* QM = (const bf16_t*)(ws + WS_QM);
    const bf16_t* U = (const bf16_t*)(ws + WS_U); const bf16_t* KVM = (const bf16_t*)(ws + WS_KVM); bf16_t* YMIX = (bf16_t*)(ws + WS_YMIX); const float* FC = (const float*)(ws + WS_FC);
    { const int cp = c.tid & 127, rg = c.tid >> 7, ch = 2 * cp, w = 2 << (ch >> 6);
      for (int i = 0; i < 32; ++i) { const int t = c.vcu * 128 + rg * 32 + i; if (t >= T) break; const int pos = t & (SEQ - 1), cnt = (pos + 1 < w) ? pos + 1 : w;
          float s0 = 0.f, s1 = 0.f, u0 = 0.f, u1 = 0.f;
          for (int jw = 0; jw < cnt; ++jw) { const unsigned wv = *(const unsigned*)(U + (size_t)(t - jw) * 256 + ch); const float x0 = bflo(wv), x1 = bfhi(wv); s0 += x0; s1 += x1; if (jw == 0) { u0 = x0; u1 = x1; } }
          const float inv = 1.0f / (float)cnt;
          *(unsigned*)(YMIX + (size_t)t * DM + ch) = pk2(s0 * inv - u0, s1 * inv - u1); } }
    __syncthreads();
    { const int bh = c.vcu >> 2, s = c.vcu & 3, b = bh >> 3, h = bh & 7;
      for (int i = 0; i < 4; ++i) { const int qb = (i == 0) ? s : (i == 1) ? 15 - s : (i == 2) ? 7 - s : 8 + s;
          att::Job j; const size_t row0 = (size_t)b * SEQ;
          j.Q = Q + (row0 + qb * 256) * 512 + h * 64; j.qpitch = 512; j.K = Kb + row0 * 512 + h * 64; j.V = V + row0 * 512 + h * 64; j.kvpitch = 512;
          j.O = YMIX + (row0 + qb * 256) * DM + 256 + h * 64; j.nt = 4 * qb + 4; j.causal = 1; j.FC = FC + (size_t)bh * SEQ; j.q0 = qb * 256;
          att::unit<true>(j, c.lds); } }
    for (int i = 0; i < 2; ++i) { const int mu = c.vcu * 2 + i, b = mu >> 6, hm = (mu >> 4) & 3, qb = mu & 15;
        att::Job j; const size_t row0 = (size_t)b * SEQ + qb * 256;
        j.Q = QM + row0 * 256 + hm * 64; j.qpitch = 256; j.K = KVM + (size_t)b * 256 * 512 + hm * 64; j.V = KVM + (size_t)b * 256 * 512 + 256 + hm * 64; j.kvpitch = 512;
        j.O = YMIX + row0 * DM + 768 + hm * 64; j.nt = 4; j.causal = 0; j.FC = nullptr; j.q0 = 0;
        att::unit<false>(j, c.lds); }
}

__device__ __forceinline__ void p4_ln1(const Args& a, const Ctx& c) {
    bf16_t* X1B = (bf16_t*)(a.ws + WS_X1B); const int gw = c.vcu * 8 + c.wave, NGW = c.G * 8;
    f32x4 g4[4], b4[4];
#pragma unroll
    for (int j = 0; j < 4; ++j) { g4[j] = *((const f32x4*)a.ln1_g + c.lane + 64 * j); b4[j] = *((const f32x4*)a.ln1_b + c.lane + 64 * j); }
    for (int m = gw; m < T; m += NGW) {
        const f32x4* xr = (const f32x4*)(a.out + (size_t)m * DM) + c.lane; f32x4 v[4]; float s = 0.f;
#pragma unroll
        for (int j = 0; j < 4; ++j) { v[j] = xr[64 * j]; s += (v[j].x + v[j].y) + (v[j].z + v[j].w); }
        const float mean = wave_sum(s) * (1.f / DM); float s2 = 0.f;
#pragma unroll
        for (int j = 0; j < 4; ++j) { v[j] = v[j] - mean; s2 += (v[j].x * v[j].x + v[j].y * v[j].y) + (v[j].z * v[j].z + v[j].w * v[j].w); }
        const float rstd = 1.f / sqrtf(wave_sum(s2) * (1.f / DM) + LN_EPS);
        u32x2* o8 = (u32x2*)(X1B + (size_t)m * DM) + c.lane;
#pragma unroll
        for (int j = 0; j < 4; ++j) { const f32x4 y = v[j] * rstd * g4[j] + b4[j]; o8[64 * j] = (u32x2){pk2(y.x, y.y), pk2(y.z, y.w)}; }
    }
}

__device__ __forceinline__ void p6_route(const Args& a, const Ctx& c) {
    const float* LOG = (const float*)(a.ws + WS_LOG); int* cnt = (int*)(a.ws + WS_CTL); int* bins = (int*)(a.ws + WS_BINS); float* gates = (float*)(a.ws + WS_GATES);
    const int gw = c.vcu * 8 + c.wave, NGW = c.G * 8, lane = c.lane;
    const f32x4 bs = *((const f32x4*)a.router_bias + lane);
    for (int tok = gw; tok < T; tok += NGW) {
        const f32x4 lg = *((const f32x4*)(LOG + (size_t)tok * NE) + lane);
        float sc0 = 1.f / (1.f + expf(-lg.x)), sc1 = 1.f / (1.f + expf(-lg.y)), sc2 = 1.f / (1.f + expf(-lg.z)), sc3 = 1.f / (1.f + expf(-lg.w));
        float v0 = sc0 + bs.x, v1 = sc1 + bs.y, v2 = sc2 + bs.z, v3 = sc3 + bs.w;
        float m1, m2; { const float A = fmaxf(v0, v1), B = fminf(v0, v1), C = fmaxf(v2, v3), Dd = fminf(v2, v3); m1 = fmaxf(A, C); m2 = fmaxf(fminf(A, C), fmaxf(B, Dd)); }
#pragma unroll
        for (int o = 1; o < 8; o <<= 1) { const float o1 = __shfl_xor(m1, o), o2 = __shfl_xor(m2, o); const float n1 = fmaxf(m1, o1), n2 = fmaxf(fminf(m1, o1), fmaxf(m2, o2)); m1 = n1; m2 = n2; }
        const float gs = m1 + m2; const int g = lane >> 3; int rank = 0;
#pragma unroll
        for (int jg = 0; jg < 8; ++jg) { const float gj = __shfl(gs, 8 * jg); rank += (gj > gs || (gj == gs && jg < g)) ? 1 : 0; }
        const bool selg = rank < 4;
        if (!selg) { v0 = -INFINITY; v1 = -INFINITY; v2 = -INFINITY; v3 = -INFINITY; }
        int my_e = 0; float my_s = 0.f;
#pragma unroll
        for (int k = 0; k < TOPK; ++k) {
            float best = v0; int bi = 0;
            if (v1 > best) { best = v1; bi = 1; } if (v2 > best) { best = v2; bi = 2; } if (v3 > best) { best = v3; bi = 3; }
            int idx = 4 * lane + bi;
#pragma unroll
            for (int o = 1; o < 64; o <<= 1) { const float ov = __shfl_xor(best, o); const int oi = __shfl_xor(idx, o); if (ov > best || (ov == best && oi < idx)) { best = ov; idx = oi; } }
            const int sub = idx & 3; const float mys = (sub == 0) ? sc0 : (sub == 1) ? sc1 : (sub == 2) ? sc2 : sc3;
            const float sk = __shfl(mys, idx >> 2);
            if ((idx >> 2) == lane) { if (sub == 0) v0 = -INFINITY; else if (sub == 1) v1 = -INFINITY; else if (sub == 2) v2 = -INFINITY; else v3 = -INFINITY; }
            if (lane == k) { my_e = idx; my_s = sk; }
        }
        float tot = (lane < 8) ? my_s : 0.f;
        tot += __shfl_xor(tot, 1); tot += __shfl_xor(tot, 2); tot += __shfl_xor(tot, 4);
        if (lane < 8) { const float gate = my_s / tot * 2.5f; const int aid = tok * 8 + lane; const int pos = atomicAdd(&cnt[my_e], 1); bins[(size_t)my_e * T + pos] = aid; gates[aid] = gate; }
    }
}

__device__ __forceinline__ int build_tables(const Args& a, const Ctx& c) {
    const int* cnt = (const int*)(a.ws + WS_CTL);
    LAS unsigned short* te = (LAS unsigned short*)(c.lds + TE_OFF); LAS int* tb = (LAS int*)(c.lds + TB_OFF); LAS int* cn = (LAS int*)(c.lds + CN_OFF);
    __syncthreads();
    if (c.tid < NE) cn[c.tid] = __hip_atomic_load(cnt + c.tid, __ATOMIC_RELAXED, __HIP_MEMORY_SCOPE_AGENT);
    __syncthreads();
    if (c.tid == 0) { int run = 0; for (int e = 0; e < NE; ++e) { tb[e] = run; run += (cn[e] + 255) >> 8; } tb[NE] = run; }
    __syncthreads();
    if (c.tid < NE) { const int n = (cn[c.tid] + 255) >> 8, b0 = tb[c.tid]; for (int jt = 0; jt < n; ++jt) te[b0 + jt] = (unsigned short)c.tid; }
    __syncthreads();
    return tb[NE];
}

__device__ __forceinline__ void p9_combine(const Args& a, const Ctx& c) {
    const bf16_t* X1B = (const bf16_t*)(a.ws + WS_X1B); const bf16_t* Y = (const bf16_t*)(a.ws + WS_Y); const int gw = c.vcu * 8 + c.wave, NGW = c.G * 8;
    f32x4 g4[4], b4[4];
#pragma unroll
    for (int j = 0; j < 4; ++j) { g4[j] = *((const f32x4*)a.ln2_g + c.lane + 64 * j); b4[j] = *((const f32x4*)a.ln2_b + c.lane + 64 * j); }
    for (int m = gw; m < T; m += NGW) {
        f32x4* orow = (f32x4*)(a.out + (size_t)m * DM) + c.lane; f32x4 v[4]; float s = 0.f;
        const u32x2* x8 = (const u32x2*)(X1B + (size_t)m * DM) + c.lane;
#pragma unroll
        for (int j = 0; j < 4; ++j) { const u32x2 xw = x8[64 * j]; v[j] = orow[64 * j] + (f32x4){bflo(xw.x), bfhi(xw.x), bflo(xw.y), bfhi(xw.y)} * ALPHA; }
#pragma unroll
        for (int k = 0; k < TOPK; ++k) { const u32x2* y8 = (const u32x2*)(Y + ((size_t)m * TOPK + k) * DM) + c.lane;
#pragma unroll
            for (int j = 0; j < 4; ++j) { const u32x2 yw = y8[64 * j]; v[j] += (f32x4){bflo(yw.x), bfhi(yw.x), bflo(yw.y), bfhi(yw.y)}; } }
#pragma unroll
        for (int j = 0; j < 4; ++j) s += (v[j].x + v[j].y) + (v[j].z + v[j].w);
        const float mean = wave_sum(s) * (1.f / DM); float s2 = 0.f;
#pragma unroll
        for (int j = 0; j < 4; ++j) { v[j] = v[j] - mean; s2 += (v[j].x * v[j].x + v[j].y * v[j].y) + (v[j].z * v[j].z + v[j].w * v[j].w); }
        const float rstd = 1.f / sqrtf(wave_sum(s2) * (1.f / DM) + LN_EPS);
#pragma unroll
        for (int j = 0; j < 4; ++j) orow[64 * j] = v[j] * rstd * g4[j] + b4[j];
    }
}

constexpr int NPHASE = 10;
__global__ void __launch_bounds__(512, 2) mk_fwd(Args a) {
    extern __shared__ __attribute__((aligned(16))) unsigned char lds_raw[];
    cg::grid_group grid = cg::this_grid();
    Ctx c; c.lds = (LAS unsigned char*)lds_raw; c.tid = threadIdx.x; c.lane = c.tid & 63; c.wave = __builtin_amdgcn_readfirstlane(c.tid >> 6); c.G = gridDim.x;
    { const int bx = blockIdx.x; c.vcu = (c.G % 8 == 0) ? (bx % 8) * (c.G / 8) + bx / 8 : bx; }
    unsigned char* ws = a.ws; const int lo = a.ph_lo, hi = a.ph_hi;
#define IN(k) (lo <= (k) && (k) < hi)
#define SEAM(k) do { if (IN(k) && IN((k) + 1)) grid.sync(); } while (0)
    if (IN(0)) p0_prologue(a, c);
    SEAM(0);
    if (IN(1)) {
        p1_fscan(a, c);
        { pg8::DenseSched S; S.init(T, 2048, DM, c.G, (int)blockIdx.x, ws + WS_WIN);
          pg8::EpiInProj E{(bf16_t*)(ws + WS_Q), (bf16_t*)(ws + WS_K), (bf16_t*)(ws + WS_V), (bf16_t*)(ws + WS_U), (bf16_t*)(ws + WS_QM)};
          pg8::gemm_phase(c.lds, (const char*)(ws + WS_XB), DM, S, E); }
        { pg8::DenseSched S; S.init(NB * 256, 512, DM, c.G, (int)blockIdx.x, ws + WS_WMKV);
          pg8::EpiBf16 E{(bf16_t*)(ws + WS_KVM), 512};
          pg8::gemm_phase(c.lds, (const char*)(ws + WS_MEMB), DM, S, E); }
    }
    SEAM(1);
    if (IN(2)) p2_mixers(a, c);
    SEAM(2);
    if (IN(3)) { pg8::DenseSched S; S.init(T, DM, DM, c.G, (int)blockIdx.x, ws + WS_WOUT);
        pg8::EpiF32 E{a.out, DM, a.x, ALPHA};
        pg8::gemm_phase(c.lds, (const char*)(ws + WS_YMIX), DM, S, E); }
    SEAM(3);
    if (IN(4)) p4_ln1(a, c);
    SEAM(4);
    if (IN(5)) { pg8::DenseSched S; S.init(T, NE, DM, c.G, (int)blockIdx.x, ws + WS_WR);
        pg8::EpiF32 E{(float*)(ws + WS_LOG), NE, nullptr, 0.f};
        pg8::gemm_phase(c.lds, (const char*)(ws + WS_X1B), DM, S, E); }
    SEAM(5);
    if (IN(6)) p6_route(a, c);
    SEAM(6);
    if (IN(7)) { const int NTR = build_tables(a, c);
        pg8::GroupSched S; S.nunits = (NTR + 128) * 2; S.G = c.G; S.c = (int)blockIdx.x; S.shift = 1; S.NTR = NTR; S.mode = 0; S.K = DM;
        S.tile_e = (const LAS unsigned short*)(c.lds + TE_OFF); S.tbase = (const LAS int*)(c.lds + TB_OFF); S.cnt = (const LAS int*)(c.lds + CN_OFF);
        S.bins = (const int*)(ws + WS_BINS); S.Bt = (const char*)(ws + WS_WGU); S.estride = (size_t)512 * DM * 2;
        pg8::EpiGateUp E{(bf16_t*)(ws + WS_HB)};
        pg8::gemm_phase(c.lds, (const char*)(ws + WS_X1B), DM, S, E); }
    SEAM(7);
    if (IN(8)) { const int NTR = build_tables(a, c);
        pg8::GroupSched S; S.nunits = (NTR + 128) * 4; S.G = c.G; S.c = (int)blockIdx.x; S.shift = 2; S.NTR = NTR; S.mode = 1; S.K = EH;
        S.tile_e = (const LAS unsigned short*)(c.lds + TE_OFF); S.tbase = (const LAS int*)(c.lds + TB_OFF); S.cnt = (const LAS int*)(c.lds + CN_OFF);
        S.bins = (const int*)(ws + WS_BINS); S.Bt = (const char*)(ws + WS_WD); S.estride = (size_t)DM * EH * 2;
        pg8::EpiDown E{(bf16_t*)(ws + WS_Y), a.out, (const int*)(ws + WS_BINS), (const float*)(ws + WS_GATES)};
        pg8::gemm_phase(c.lds, (const char*)(ws + WS_HB), EH, S, E); }
    SEAM(8);
    if (IN(9)) p9_combine(a, c);
#undef IN
#undef SEAM
}

#ifndef MK_N_LAUNCHES
#define MK_N_LAUNCHES 1
#endif
extern "C" void kernel_launch(void* const* d_in, const int* in_sizes, int n_in, void* d_out, int out_size, void* d_ws, size_t ws_size, hipStream_t stream) {
    static int grid = 0;
    if (grid == 0) {
        if (n_in != 20 || out_size != T * DM || ws_size < WS_END) { fprintf(stderr, "kernel_launch: unexpected shapes (n_in %d out %d ws %zu)\n", n_in, out_size, ws_size); grid = -1; return; }
        int dev = 0, cus = 0, per_cu = 0;
        (void)hipGetDevice(&dev); (void)hipDeviceGetAttribute(&cus, hipDeviceAttributeMultiprocessorCount, dev);
        if (hipFuncSetAttribute((const void*)mk_fwd, hipFuncAttributeMaxDynamicSharedMemorySize, LDS_BYTES) != hipSuccess) { fprintf(stderr, "kernel_launch: hipFuncSetAttribute failed\n"); grid = -1; return; }
        (void)hipOccupancyMaxActiveBlocksPerMultiprocessor(&per_cu, (const void*)mk_fwd, 512, LDS_BYTES);
        if (per_cu < 1) { fprintf(stderr, "kernel_launch: occupancy query says %d blocks per CU\n", per_cu); grid = -1; return; }
        grid = cus;
        if (grid != 256) fprintf(stderr, "kernel_launch: %d CUs (built for 256)\n", grid);
    }
    if (grid < 0) return;
    (void)hipMemsetAsync((char*)d_ws + WS_CTL, 0, CTL_ZERO_BYTES, stream);
    Args a{};
    const float** p = (const float**)&a;
    for (int i = 0; i < 20; ++i) p[i] = (const float*)d_in[i];
    a.out = (float*)d_out; a.ws = (unsigned char*)d_ws;
    const int nl = MK_N_LAUNCHES;
    for (int li = 0; li < nl; ++li) {
        a.ph_lo = (nl == 1) ? 0 : li; a.ph_hi = (nl == 1) ? NPHASE : li + 1;
        void* args[] = {&a};
        const hipError_t e = hipLaunchCooperativeKernel((void*)mk_fwd, dim3(grid), dim3(512), args, LDS_BYTES, stream);
        if (e != hipSuccess) { fprintf(stderr, "kernel_launch: cooperative launch failed: %s\n", hipGetErrorString(e)); break; }
    }
}
```

```cpp
#include <hip/hip_runtime.h>
#include <hip/hip_cooperative_groups.h>
#include <cstdio>
#include <cstdint>
namespace cg = cooperative_groups;

#define LAS __attribute__((address_space(3)))
typedef unsigned short bf16_t;
typedef short bf16x8 __attribute__((ext_vector_type(8)));
typedef short s16x4 __attribute__((ext_vector_type(4)));
typedef float f32x4 __attribute__((ext_vector_type(4)));
typedef float f32x2 __attribute__((ext_vector_type(2)));
typedef float f32x16 __attribute__((ext_vector_type(16)));
typedef unsigned u32x4 __attribute__((ext_vector_type(4)));
typedef unsigned u32x2 __attribute__((ext_vector_type(2)));

constexpr int NB = 8, SEQ = 4096, T = NB * SEQ, DM = 1024;
constexpr int INC = 2056;
constexpr int NE = 256, TOPK = 8, EH = 256;
constexpr float ALPHA = 1.189207115002721f;
constexpr float LN_EPS = 1e-5f;
constexpr float LOG2E = 1.4426950408889634f;
constexpr float C2 = 0.125f * LOG2E;
constexpr int MAXTILES = 1280 + 128;

constexpr size_t MiB = 1u << 20;
constexpr size_t WS_CTL = 0, WS_WD = 1 * MiB, WS_HB = 130 * MiB, WS_X1B = 306 * MiB, WS_BINS = 370 * MiB, WS_GATES = 402 * MiB, WS_FC = 403 * MiB, WS_FLOG = 404 * MiB,
                 WS_KVM = 405 * MiB, WS_Y = 408 * MiB, WS_WGU = 408 * MiB, WS_WIN = 665 * MiB, WS_WMKV = 669 * MiB, WS_WOUT = 670 * MiB, WS_WR = 672 * MiB, WS_MEMB = 673 * MiB,
                 WS_XB = 677 * MiB, WS_Q = 741 * MiB, WS_K = 773 * MiB, WS_V = 805 * MiB, WS_QM = 837 * MiB, WS_U = 853 * MiB, WS_YMIX = 869 * MiB, WS_LOG = 933 * MiB, WS_END = 965 * MiB;
constexpr size_t CTL_ZERO_BYTES = 1 * MiB;

constexpr int RING_BYTES = 131072;
constexpr int TE_OFF = 131072, TB_OFF = 135168, CN_OFF = 137216, MISC_OFF = 139264, LDS_BYTES = 147456;

struct Args {
    const float *x, *mem, *w_in, *b_f, *w_pool, *pool_scale, *w_mem_kv, *w_out, *ln1_g, *ln1_b, *w_router, *router_bias, *w_gate, *w_up, *w_down, *ws_gate, *ws_up, *ws_down, *ln2_g, *ln2_b;
    float* out; unsigned char* ws; int ph_lo, ph_hi, li, pad;
};

__device__ __forceinline__ unsigned f2bf(float f) { unsigned u = __float_as_uint(f); return (u + 0x7fffu + ((u >> 16) & 1u)) >> 16; }
__device__ __forceinline__ unsigned pk2(float lo, float hi) { return f2bf(lo) | (f2bf(hi) << 16); }
__device__ __forceinline__ float bflo(unsigned w) { return __uint_as_float(w << 16); }
__device__ __forceinline__ float bfhi(unsigned w) { return __uint_as_float(w & 0xffff0000u); }
__device__ __forceinline__ float wave_sum(float v) {
#pragma unroll
    for (int o = 1; o < 64; o <<= 1) v += __shfl_xor(v, o);
    return v;
}
#define LDS_WAIT() asm volatile("s_waitcnt lgkmcnt(0)" ::: "memory")

namespace pg8 {
constexpr int BM = 256, BK = 64, HALF = 128, HTB = HALF * BK * 2, NXCD = 8, WGM = 8;
__device__ __forceinline__ int lds_byte(int r, int c) { const int st = (r >> 4) * 2 + (c >> 5), rr = r & 15, cc = c & 31, ob = rr * 64 + cc * 2; return st * 1024 + (ob ^ (((ob >> 9) & 1) << 5)); }
__device__ __forceinline__ void stage_rc(int b, int& R, int& C) { const int st = b / 1024, sb = b % 1024, swz = sb ^ (((sb >> 9) & 1) << 5); R = (st >> 1) * 16 + swz / 64; C = (st & 1) * 32 + (swz % 64) / 2; }
__device__ __forceinline__ int perm32(int rho) { const int n = rho >> 4, i = rho & 15; return 8 * (i >> 2) + 4 * n + (i & 3); }
__device__ __forceinline__ int xcd_remap(int L, int nwg) { const int q = nwg / NXCD, r = nwg % NXCD, xcd = L % NXCD, off = L / NXCD; return (xcd < r ? xcd * (q + 1) : r * (q + 1) + (xcd - r) * q) + off; }

struct Unit { int pm, pn, e, rows, mt; };

struct DenseSched {
    int nM, nN, nwg, G, c, K; const char* Bt;
    __device__ __forceinline__ void init(int M, int N, int K_, int G_, int c_, const void* Bt_) { nM = M / BM; nN = N / BM; nwg = nM * nN; G = G_; c = c_; K = K_; Bt = (const char*)Bt_; }
    __device__ __forceinline__ bool next(int i, Unit& u) const {
        const long L = (long)i * G + c; if (L >= nwg) return false;
        const int wgid = xcd_remap((int)L, nwg);
        const int nig = WGM * nN, gid = wgid / nig, fm = gid * WGM, gsz = (nM - fm) < WGM ? (nM - fm) : WGM;
        u.pm = fm + ((wgid % nig) % gsz); u.pn = (wgid % nig) / gsz; u.e = 0; u.rows = 256; u.mt = u.pm; return true;
    }
    __device__ __forceinline__ unsigned a_off(const Unit& u, int h, int R, int C) const { return (unsigned)(((u.pm * BM + h * HALF + R) * K + C) * 2); }
    __device__ __forceinline__ const char* b_ptr(const Unit& u) const { return Bt + (size_t)u.pn * BM * K * 2; }
};

struct GroupSched {
    int nunits, G, c, shift, NTR, mode, K; const LAS unsigned short* tile_e; const LAS int* tbase; const LAS int* cnt; const int* bins; const char* Bt; size_t estride;
    __device__ __forceinline__ bool next(int i, Unit& u) const {
        const long L = (long)i * G + c; if (L >= nunits) return false;
        const int wgid = xcd_remap((int)L, nunits);
        const int tau = wgid >> shift; u.pn = wgid & ((1 << shift) - 1); u.pm = tau;
        if (tau < NTR) { const int e = tile_e[tau]; u.e = e; u.mt = tau - tbase[e]; const int left = cnt[e] - u.mt * 256; u.rows = left < 256 ? left : 256; }
        else { u.e = NE; u.mt = tau - NTR; u.rows = 256; }
        return true;
    }
    __device__ __forceinline__ unsigned a_off(const Unit& u, int h, int R, int C) const {
        if (mode == 0) { const int rl = h * HALF + R; int tok;
            if (u.e < NE) tok = (rl < u.rows) ? (bins[(size_t)u.e * T + u.mt * 256 + rl] >> 3) : 0; else tok = u.mt * 256 + rl;
            return (unsigned)((tok * 1024 + C) * 2); }
        return (unsigned)(((u.pm * BM + h * HALF + R) * 256 + C) * 2);
    }
    __device__ __forceinline__ const char* b_ptr(const Unit& u) const { return Bt + (size_t)u.e * estride + (size_t)u.pn * BM * K * 2; }
};

__device__ __forceinline__ unsigned cvt_pk_bf16(float lo, float hi) { unsigned r; asm volatile("v_cvt_pk_bf16_f32 %0, %1, %2" : "=v"(r) : "v"(lo), "v"(hi)); return r; }

template <class Epi, class Sched>
__device__ __forceinline__ void gemm_phase(LAS unsigned char* lds, const char* Abase, int K, const Sched& S, const Epi& E) {
    const int tid = threadIdx.x, wid = __builtin_amdgcn_readfirstlane(tid >> 6), lane = tid & 63, wr = wid >> 2, wc = wid & 3, fr = lane & 15, fq = lane >> 4;
    const int nt = K / BK;
    int RA[2], CA[2]; unsigned voffB[2];
#pragma unroll
    for (int i = 0; i < 2; ++i) { int R, C; stage_rc(tid * 16 + i * 8192, R, C); const int Rb = Epi::PERM ? ((R & ~31) + perm32(R & 31)) : R; RA[i] = R; CA[i] = C; voffB[i] = (unsigned)(Rb * K + C) * 2u; }
    const size_t kstep = (size_t)(BK * 2);
    const size_t hstep = (size_t)HALF * K * 2;
    const unsigned ldsw = (unsigned)wid * 1024u;
    const int aoff = lds_byte(wr * 64 + fr, fq * 8), boff = lds_byte(wc * 32 + fr, fq * 8);
#define PG8_SA(b, h) (((b) * 2 + (h)) * HTB)
#define PG8_SB(b, h) ((4 + (b) * 2 + (h)) * HTB)
#define PG8_STAGEB(bufoff, gbase) do { _Pragma("unroll") for (int _i = 0; _i < 2; ++_i) \
        __builtin_amdgcn_global_load_lds((const unsigned*)((const char*)(gbase) + voffB[_i]), (LAS unsigned*)(lds + (bufoff) + ldsw + _i * 8192), 16, 0, 0); } while (0)
#define PG8_STAGEA(bufoff, koff, v0, v1) do { \
        __builtin_amdgcn_global_load_lds((const unsigned*)(Abase + (koff) + (v0)), (LAS unsigned*)(lds + (bufoff) + ldsw), 16, 0, 0); \
        __builtin_amdgcn_global_load_lds((const unsigned*)(Abase + (koff) + (v1)), (LAS unsigned*)(lds + (bufoff) + ldsw + 8192), 16, 0, 0); } while (0)
#define PG8_LDA(dst, b, h) do { _Pragma("unroll") for (int m = 0; m < 4; ++m) _Pragma("unroll") for (int k = 0; k < 2; ++k) dst[m][k] = *(const LAS bf16x8*)(lds + PG8_SA(b, h) + aoff + m * 2048 + k * 1024); } while (0)
#define PG8_LDB(dst, b, h) do { _Pragma("unroll") for (int n = 0; n < 2; ++n) _Pragma("unroll") for (int k = 0; k < 2; ++k) dst[n][k] = *(const LAS bf16x8*)(lds + PG8_SB(b, h) + boff + n * 2048 + k * 1024); } while (0)
#define PG8_MMA(ai, bj, At, Bt) do { __builtin_amdgcn_s_setprio(1); _Pragma("unroll") for (int m = 0; m < 4; ++m) _Pragma("unroll") for (int n = 0; n < 2; ++n) _Pragma("unroll") for (int k = 0; k < 2; ++k) \
        acc[ai][bj][m][n] = __builtin_amdgcn_mfma_f32_16x16x32_bf16(Bt[n][k], At[m][k], acc[ai][bj][m][n], 0, 0, 0); __builtin_amdgcn_s_setprio(0); } while (0)
#define PG8_WAIT_V(n) asm volatile("s_waitcnt vmcnt(" #n ")" ::: "memory")
#define PG8_WAIT_L(n) asm volatile("s_waitcnt lgkmcnt(" #n ")" ::: "memory")
#define PG8_BAR __builtin_amdgcn_s_barrier()
#define PG8_SCHED __builtin_amdgcn_sched_barrier(0)
    Unit cur, nxt; int ui = 0;
    if (!S.next(0, cur)) return;
    unsigned vc00 = S.a_off(cur, 0, RA[0], CA[0]), vc01 = S.a_off(cur, 0, RA[1], CA[1]), vc10 = S.a_off(cur, 1, RA[0], CA[0]), vc11 = S.a_off(cur, 1, RA[1], CA[1]);
    asm volatile("" : "+v"(vc00), "+v"(vc01), "+v"(vc10), "+v"(vc11));
    f32x4 acc[2][2][4][2];
#pragma unroll
    for (int a = 0; a < 2; ++a)
#pragma unroll
        for (int b = 0; b < 2; ++b)
#pragma unroll
            for (int m = 0; m < 4; ++m)
#pragma unroll
                for (int n = 0; n < 2; ++n) acc[a][b][m][n] = (f32x4){0.f, 0.f, 0.f, 0.f};
    bf16x8 At[4][2], B0[2][2], B1[2][2];
    const char* cB = S.b_ptr(cur);
    PG8_STAGEB(PG8_SB(0, 0), cB); PG8_STAGEB(PG8_SB(0, 1), cB + hstep); PG8_STAGEA(PG8_SA(0, 0), 0, vc00, vc01); PG8_STAGEA(PG8_SA(0, 1), 0, vc10, vc11);
    if (wr == 1) PG8_BAR;
    PG8_WAIT_V(2); PG8_BAR;
    PG8_STAGEB(PG8_SB(1, 0), cB + kstep); PG8_STAGEA(PG8_SA(1, 0), kstep, vc00, vc01); PG8_STAGEB(PG8_SB(1, 1), cB + hstep + kstep);
    PG8_WAIT_V(6); PG8_BAR;
    for (;;) {
        const bool has_next = S.next(ui + 1, nxt);
        unsigned vn00 = vc00, vn01 = vc01, vn10 = vc10, vn11 = vc11;
        if (has_next) { vn00 = S.a_off(nxt, 0, RA[0], CA[0]); vn01 = S.a_off(nxt, 0, RA[1], CA[1]); vn10 = S.a_off(nxt, 1, RA[0], CA[0]); vn11 = S.a_off(nxt, 1, RA[1], CA[1]); }
        asm volatile("" : "+v"(vn00), "+v"(vn01), "+v"(vn10), "+v"(vn11));
        const char* nB = has_next ? S.b_ptr(nxt) : cB;
        for (int t = 0; t < nt; t += 2) {
            const bool last = (t == nt - 2);
            const size_t k1 = (size_t)(t + 1) * kstep;
            const size_t k2 = last ? 0 : (size_t)(t + 2) * kstep, k3 = k2 + kstep;
            const char* b2 = last ? nB : cB + (size_t)(t + 2) * kstep; const char* b3 = b2 + kstep;
            const unsigned s00 = last ? vn00 : vc00, s01 = last ? vn01 : vc01, s10 = last ? vn10 : vc10, s11 = last ? vn11 : vc11;
            PG8_LDB(B0, 0, 0); PG8_LDB(B1, 0, 1); PG8_SCHED; PG8_LDA(At, 0, 0); PG8_STAGEA(PG8_SA(1, 1), k1, vc10, vc11);
            PG8_WAIT_V(8); PG8_WAIT_L(0); PG8_BAR; PG8_MMA(0, 0, At, B0); PG8_MMA(0, 1, At, B1); PG8_BAR; PG8_SCHED;
            PG8_LDA(At, 0, 1); PG8_STAGEB(PG8_SB(0, 0), b2); PG8_STAGEB(PG8_SB(0, 1), b2 + hstep); PG8_STAGEA(PG8_SA(0, 0), k2, s00, s01);
            PG8_WAIT_V(8); PG8_WAIT_L(0); PG8_BAR; PG8_MMA(1, 0, At, B0); PG8_MMA(1, 1, At, B1); PG8_BAR; PG8_SCHED;
            PG8_LDB(B0, 1, 0); PG8_LDB(B1, 1, 1); PG8_SCHED; PG8_LDA(At, 1, 0); PG8_STAGEA(PG8_SA(0, 1), k2, s10, s11);
            PG8_WAIT_V(8); PG8_WAIT_L(0); PG8_BAR; PG8_MMA(0, 0, At, B0); PG8_MMA(0, 1, At, B1); PG8_BAR; PG8_SCHED;
            PG8_LDA(At, 1, 1); PG8_STAGEB(PG8_SB(1, 0), b3); PG8_STAGEB(PG8_SB(1, 1), b3 + hstep); PG8_STAGEA(PG8_SA(1, 0), k3, s00, s01);
            PG8_WAIT_V(8); PG8_WAIT_L(0); PG8_BAR; PG8_MMA(1, 0, At, B0); PG8_MMA(1, 1, At, B1); PG8_BAR; PG8_SCHED;
        }
        if (wr == 0) PG8_BAR;
        E(acc, cur, wr, wc, fr, fq);
        if (!has_next) break;
#pragma unroll
        for (int a = 0; a < 2; ++a)
#pragma unroll
            for (int b = 0; b < 2; ++b)
#pragma unroll
                for (int m = 0; m < 4; ++m)
#pragma unroll
                    for (int n = 0; n < 2; ++n) acc[a][b][m][n] = (f32x4){0.f, 0.f, 0.f, 0.f};
        cur = nxt; cB = nB; vc00 = vn00; vc01 = vn01; vc10 = vn10; vc11 = vn11; ++ui;
        if (wr == 1) PG8_BAR;
    }
    PG8_WAIT_V(0);
    PG8_BAR;
#undef PG8_SA
#undef PG8_SB
#undef PG8_STAGEA
#undef PG8_STAGEB
#undef PG8_LDA
#undef PG8_LDB
#undef PG8_MMA
#undef PG8_WAIT_V
#undef PG8_WAIT_L
#undef PG8_BAR
#undef PG8_SCHED
}

struct EpiInProj {
    static constexpr bool PERM = true;
    bf16_t *Q, *Kb, *V, *U, *QM;
    __device__ __forceinline__ void operator()(const f32x4 (&acc)[2][2][4][2], const Unit& u, int wr, int wc, int fr, int fq) const {
        bf16_t* base; int ldc, colt; float sc = 1.f; const int pn = u.pn;
        if (pn < 2) { base = Q; ldc = 512; colt = pn * 256; sc = C2; } else if (pn < 4) { base = Kb; ldc = 512; colt = (pn - 2) * 256; } else if (pn < 6) { base = V; ldc = 512; colt = (pn - 4) * 256; }
        else if (pn == 6) { base = U; ldc = 256; colt = 0; } else { base = QM; ldc = 256; colt = 0; sc = C2; }
        const int row0 = u.pm * BM + wr * 64 + fr, col0 = colt + wc * 32 + 8 * fq;
#pragma unroll
        for (int ai = 0; ai < 2; ++ai)
#pragma unroll
            for (int m = 0; m < 4; ++m) { bf16_t* rowp = base + (size_t)(row0 + ai * HALF + m * 16) * ldc + col0;
#pragma unroll
                for (int bj = 0; bj < 2; ++bj) { const f32x4 v0 = acc[ai][bj][m][0] * sc, v1 = acc[ai][bj][m][1] * sc;
                    u32x4 w; w.x = cvt_pk_bf16(v0[0], v0[1]); w.y = cvt_pk_bf16(v0[2], v0[3]); w.z = cvt_pk_bf16(v1[0], v1[1]); w.w = cvt_pk_bf16(v1[2], v1[3]);
                    *(u32x4*)(rowp + bj * HALF) = w; } }
    }
};
struct EpiBf16 {
    static constexpr bool PERM = true;
    bf16_t* O; int ldc;
    __device__ __forceinline__ void operator()(const f32x4 (&acc)[2][2][4][2], const Unit& u, int wr, int wc, int fr, int fq) const {
        const int row0 = u.pm * BM + wr * 64 + fr, col0 = u.pn * BM + wc * 32 + 8 * fq;
#pragma unroll
        for (int ai = 0; ai < 2; ++ai)
#pragma unroll
            for (int m = 0; m < 4; ++m) { bf16_t* rowp = O + (size_t)(row0 + ai * HALF + m * 16) * ldc + col0;
#pragma unroll
                for (int bj = 0; bj < 2; ++bj) { const f32x4 v0 = acc[ai][bj][m][0], v1 = acc[ai][bj][m][1];
                    u32x4 w; w.x = cvt_pk_bf16(v0[0], v0[1]); w.y = cvt_pk_bf16(v0[2], v0[3]); w.z = cvt_pk_bf16(v1[0], v1[1]); w.w = cvt_pk_bf16(v1[2], v1[3]);
                    *(u32x4*)(rowp + bj * HALF) = w; } }
    }
};
struct EpiF32 {
    static constexpr bool PERM = false;
    float* C; int ldc; const float* R; float rs;
    __device__ __forceinline__ void operator()(const f32x4 (&acc)[2][2][4][2], const Unit& u, int wr, int wc, int fr, int fq) const {
        const int row0 = u.pm * BM + wr * 64 + fr, col0 = u.pn * BM + wc * 32 + 4 * fq;
#pragma unroll
        for (int ai = 0; ai < 2; ++ai)
#pragma unroll
            for (int m = 0; m < 4; ++m) { const size_t off = (size_t)(row0 + ai * HALF + m * 16) * ldc + col0;
#pragma unroll
                for (int bj = 0; bj < 2; ++bj)
#pragma unroll
                    for (int n = 0; n < 2; ++n) { f32x4 v = acc[ai][bj][m][n]; if (R) v += *(const f32x4*)(R + off + bj * HALF + n * 16) * rs; *(f32x4*)(C + off + bj * HALF + n * 16) = v; }
                if (m & 1) asm volatile("" ::: "memory"); }
    }
};
struct EpiGateUp {
    static constexpr bool PERM = true;
    bf16_t* H;
    __device__ __forceinline__ void operator()(const f32x4 (&acc)[2][2][4][2], const Unit& u, int wr, int wc, int fr, int fq) const {
        const int row0 = u.pm * BM + wr * 64 + fr, col0 = u.pn * 128 + wc * 32 + 8 * fq;
#pragma unroll
        for (int ai = 0; ai < 2; ++ai)
#pragma unroll
            for (int m = 0; m < 4; ++m) { bf16_t* rowp = H + (size_t)(row0 + ai * HALF + m * 16) * EH + col0; float hv[8];
#pragma unroll
                for (int n = 0; n < 2; ++n)
#pragma unroll
                    for (int j = 0; j < 4; ++j) { const float g = acc[ai][0][m][n][j], up = acc[ai][1][m][n][j]; hv[n * 4 + j] = g * __builtin_amdgcn_rcpf(1.f + __builtin_amdgcn_exp2f(-g * LOG2E)) * up; }
                u32x4 w; w.x = cvt_pk_bf16(hv[0], hv[1]); w.y = cvt_pk_bf16(hv[2], hv[3]); w.z = cvt_pk_bf16(hv[4], hv[5]); w.w = cvt_pk_bf16(hv[6], hv[7]);
                *(u32x4*)rowp = w; }
    }
};
struct EpiDown {
    static constexpr bool PERM = true;
    bf16_t* Y; float* SH; const int* bins; const float* gates;
    __device__ __forceinline__ void operator()(const f32x4 (&acc)[2][2][4][2], const Unit& u, int wr, int wc, int fr, int fq) const {
        const int col0 = u.pn * BM + wc * 32 + 8 * fq;
        if (u.e == NE) {
#pragma unroll
            for (int ai = 0; ai < 2; ++ai)
#pragma unroll
                for (int m = 0; m < 4; ++m) { const int tok = u.mt * 256 + ai * HALF + wr * 64 + m * 16 + fr; float* rowp = SH + (size_t)tok * DM + col0;
#pragma unroll
                    for (int bj = 0; bj < 2; ++bj) { *(f32x4*)(rowp + bj * HALF) = acc[ai][bj][m][0]; *(f32x4*)(rowp + bj * HALF + 4) = acc[ai][bj][m][1]; } }
        } else {
            const int* bp = bins + (size_t)u.e * T + u.mt * 256;
#pragma unroll
            for (int ai = 0; ai < 2; ++ai)
#pragma unroll
                for (int m = 0; m < 4; ++m) { const int rl = ai * HALF + wr * 64 + m * 16 + fr;
                    if (rl < u.rows) { const int a = bp[rl]; const float g = gates[a]; bf16_t* rowp = Y + (size_t)a * DM + col0;
#pragma unroll
                        for (int bj = 0; bj < 2; ++bj) { const f32x4 v0 = acc[ai][bj][m][0] * g, v1 = acc[ai][bj][m][1] * g;
                            u32x4 w; w.x = cvt_pk_bf16(v0[0], v0[1]); w.y = cvt_pk_bf16(v0[2], v0[3]); w.z = cvt_pk_bf16(v1[0], v1[1]); w.w = cvt_pk_bf16(v1[2], v1[3]);
                            *(u32x4*)(rowp + bj * HALF) = w; } } }
        }
    }
};
}

namespace att {
constexpr int SLOTB = 8192, L_K = 0, L_V = 2 * SLOTB, L_WS = 4 * SLOTB, L_OST = L_WS + 8 * 256, L_FK = L_OST + 8 * 4096, L_END = L_FK + 16384;
#define SBAR() __builtin_amdgcn_sched_barrier(0)
__device__ __forceinline__ int crow(int r, int hi) { return (r & 3) + 8 * (r >> 2) + 4 * hi; }
__device__ __forceinline__ void glds16(const void* gsrc, unsigned lds_dst) { unsigned keep;
    asm volatile("s_mov_b32 %0, m0\n\ts_mov_b32 m0, %2\n\ts_nop 0\n\tglobal_load_lds_dwordx4 %1, off\n\ts_mov_b32 m0, %0" : "=&s"(keep) : "v"(gsrc), "s"(lds_dst) : "memory"); }
__device__ __forceinline__ unsigned cvtpk(float lo, float hi) { unsigned r; asm("v_cvt_pk_bf16_f32 %0, %1, %2" : "=v"(r) : "v"(lo), "v"(hi)); return r; }
#define ATT_WAIT_BAR() asm volatile("s_waitcnt vmcnt(0) lgkmcnt(0)\n\ts_barrier" ::: "memory")

struct Job { const bf16_t* Q; int qpitch; const bf16_t* K; const bf16_t* V; int kvpitch; bf16_t* O; int nt; int causal; const float* FC; int q0; };

template <bool FOX> __device__ __forceinline__ void unit(const Job& j, LAS unsigned char* shm) {
    const int tid = threadIdx.x, lane = tid & 63, r32 = lane & 31, hi = lane >> 5; const int wid = __builtin_amdgcn_readfirstlane(tid >> 6);
    const unsigned lds0 = (unsigned)(uintptr_t)shm;
    LAS float* wsf = (LAS float*)(shm + L_WS) + wid * 64;
    LAS float* fk = (LAS float*)(shm + L_FK);
    const int NT = j.nt;
    float fq = 0.f;
    if (FOX) {
        for (int i = tid; i < NT * 16; i += 512) *(LAS f32x4*)(fk + 4 * i) = *(const f32x4*)(j.FC + 4 * i);
        fq = j.FC[j.q0 + wid * 32 + r32];
    }
    const bf16_t* ksrc = j.K + (size_t)lane * j.kvpitch + wid * 8;
    const bf16_t* vsrc = j.V + (size_t)(16 * (wid & 3) + (lane >> 2)) * j.kvpitch + (wid >> 2) * 32 + (lane & 3) * 8;
    const unsigned kdst = lds0 + L_K + wid * 1024, vdst = lds0 + L_V + wid * 1024;
#define DMA_K(t, slot) glds16(ksrc + (size_t)(t) * 64 * j.kvpitch, (unsigned)__builtin_amdgcn_readfirstlane(kdst + (slot) * SLOTB))
#define DMA_V(t, slot) glds16(vsrc + (size_t)(t) * 64 * j.kvpitch, (unsigned)__builtin_amdgcn_readfirstlane(vdst + (slot) * SLOTB))
    const bf16_t* Qw = j.Q + (size_t)(wid * 32) * j.qpitch;
    bf16x8 qr[4];
#pragma unroll
    for (int d0 = 0; d0 < 4; ++d0) qr[d0] = *reinterpret_cast<const bf16x8*>(Qw + (size_t)r32 * j.qpitch + d0 * 16 + hi * 8);
    asm volatile("s_waitcnt vmcnt(0) lgkmcnt(0)" ::: "memory");
    { const int t0 = FOX ? NT - 1 : 0; DMA_K(t0, 0); DMA_V(t0, 0); }
    float mrun = -1e30f, l_reg = 0.f; f32x16 o[2]; o[0] = f32x16{}; o[1] = f32x16{};
    const int qrel = wid * 32 + r32;
    for (int it = 0; it < NT; ++it) {
        const int tcur = FOX ? NT - 1 - it : it, slot = it & 1;
        ATT_WAIT_BAR();
        if (it + 1 < NT) { const int tn = FOX ? tcur - 1 : tcur + 1; DMA_K(tn, slot ^ 1); DMA_V(tn, slot ^ 1); }
        f32x16 p0, p1;
        if (FOX) {
#pragma unroll
            for (int g = 0; g < 4; ++g) { const f32x4 a = *(const LAS f32x4*)(fk + 64 * tcur + 8 * g + 4 * hi), b = *(const LAS f32x4*)(fk + 64 * tcur + 32 + 8 * g + 4 * hi);
#pragma unroll
                for (int i = 0; i < 4; ++i) { p0[4 * g + i] = fq - a[i]; p1[4 * g + i] = fq - b[i]; } }
        } else { p0 = f32x16{}; p1 = f32x16{}; }
        { const LAS unsigned char* kb = shm + L_K + slot * SLOTB + hi * 1024 + r32 * 16;
#pragma unroll
          for (int d0 = 0; d0 < 4; ++d0) { const bf16x8 b0 = *(const LAS bf16x8*)(kb + d0 * 2048), b1 = *(const LAS bf16x8*)(kb + d0 * 2048 + 512);
              p0 = __builtin_amdgcn_mfma_f32_32x32x16_bf16(b0, qr[d0], p0, 0, 0, 0); p1 = __builtin_amdgcn_mfma_f32_32x32x16_bf16(b1, qr[d0], p1, 0, 0, 0); } }
        if (j.causal && tcur >= NT - 4) { const int kb0 = 64 * (tcur - (NT - 4)) + 4 * hi;
#pragma unroll
            for (int r = 0; r < 16; ++r) { const int kv = kb0 + (r & 3) + 8 * (r >> 2); if (kv > qrel) p0[r] = -INFINITY; if (kv + 32 > qrel) p1[r] = -INFINITY; } }
        float rm = p0[0];
#pragma unroll
        for (int r = 1; r < 16; ++r) rm = fmaxf(rm, p0[r]);
#pragma unroll
        for (int r = 0; r < 16; ++r) rm = fmaxf(rm, p1[r]);
        rm = fmaxf(rm, __shfl_xor(rm, 32));
        const float mn = fmaxf(mrun, rm), alpha = __builtin_amdgcn_exp2f(mrun - mn); mrun = mn;
        float rs = 0.f;
#pragma unroll
        for (int r = 0; r < 16; ++r) { p0[r] = __builtin_amdgcn_exp2f(p0[r] - mn); p1[r] = __builtin_amdgcn_exp2f(p1[r] - mn); rs += p0[r] + p1[r]; }
        l_reg = l_reg * alpha + rs;
        if (hi == 0) wsf[r32] = alpha;
        LDS_WAIT();
#pragma unroll
        for (int r = 0; r < 16; ++r) { const float f = wsf[crow(r, hi)]; o[0][r] *= f; o[1][r] *= f; }
        u32x4 pw0, pw1, pw2, pw3;
        pw0 = (u32x4){cvtpk(p0[0], p0[1]), cvtpk(p0[2], p0[3]), cvtpk(p0[4], p0[5]), cvtpk(p0[6], p0[7])};
        pw1 = (u32x4){cvtpk(p0[8], p0[9]), cvtpk(p0[10], p0[11]), cvtpk(p0[12], p0[13]), cvtpk(p0[14], p0[15])};
        pw2 = (u32x4){cvtpk(p1[0], p1[1]), cvtpk(p1[2], p1[3]), cvtpk(p1[4], p1[5]), cvtpk(p1[6], p1[7])};
        pw3 = (u32x4){cvtpk(p1[8], p1[9]), cvtpk(p1[10], p1[11]), cvtpk(p1[12], p1[13]), cvtpk(p1[14], p1[15])};
        const bf16x8 pa0 = __builtin_bit_cast(bf16x8, pw0), pa1 = __builtin_bit_cast(bf16x8, pw1), pa2 = __builtin_bit_cast(bf16x8, pw2), pa3 = __builtin_bit_cast(bf16x8, pw3);
        const int vb = (int)(lds0 + L_V + slot * SLOTB) + ((lane >> 4) & 1) * 32 + (lane & 3) * 8 + (4 * hi + ((lane & 15) >> 2)) * 64;
#pragma unroll
        for (int d0 = 0; d0 < 2; ++d0) { s16x4 lo[4], hh[4];
#pragma unroll
            for (int ks = 0; ks < 4; ++ks) {
                asm volatile("ds_read_b64_tr_b16 %0,%1 offset:%c2" : "=&v"(lo[ks]) : "v"(vb), "i"(d0 * 4096 + ks * 1024) : "memory");
                asm volatile("ds_read_b64_tr_b16 %0,%1 offset:%c2" : "=&v"(hh[ks]) : "v"(vb), "i"(d0 * 4096 + ks * 1024 + 512) : "memory"); }
            asm volatile("s_waitcnt lgkmcnt(0)" ::: "memory"); SBAR();
#define PK(k) (bf16x8){lo[k][0], lo[k][1], lo[k][2], lo[k][3], hh[k][0], hh[k][1], hh[k][2], hh[k][3]}
            o[d0] = __builtin_amdgcn_mfma_f32_32x32x16_bf16(pa0, PK(0), o[d0], 0, 0, 0);
            o[d0] = __builtin_amdgcn_mfma_f32_32x32x16_bf16(pa1, PK(1), o[d0], 0, 0, 0);
            o[d0] = __builtin_amdgcn_mfma_f32_32x32x16_bf16(pa2, PK(2), o[d0], 0, 0, 0);
            o[d0] = __builtin_amdgcn_mfma_f32_32x32x16_bf16(pa3, PK(3), o[d0], 0, 0, 0);
#undef PK
        }
    }
    l_reg += __shfl_xor(l_reg, 32);
    if (hi == 0) wsf[32 + r32] = l_reg;
    LDS_WAIT();
    float rli[16];
#pragma unroll
    for (int r = 0; r < 16; ++r) rli[r] = 1.0f / wsf[32 + crow(r, hi)];
    bf16_t* Ow = j.O + (size_t)(wid * 32) * DM;
    { LAS bf16_t* stg = (LAS bf16_t*)(shm + L_OST) + wid * 2048;
#pragma unroll
      for (int r = 0; r < 16; ++r) { const int orow = crow(r, hi);
#pragma unroll
          for (int d0 = 0; d0 < 2; ++d0) stg[orow * 64 + d0 * 32 + r32] = (bf16_t)f2bf(o[d0][r] * rli[r]); }
      LDS_WAIT();
#pragma unroll
      for (int i = 0; i < 4; ++i) { const int row = i * 8 + (lane >> 3), ch = lane & 7; const u32x4 v = *(const LAS u32x4*)(stg + row * 64 + ch * 8); *(u32x4*)(Ow + (size_t)row * DM + ch * 8) = v; } }
    asm volatile("s_waitcnt vmcnt(0) lgkmcnt(0)\n\ts_barrier" ::: "memory");
#undef DMA_K
#undef DMA_V
}
#undef SBAR
}

#define XB_TMO      128
#define XB_XCNT(j)  (256  + 64 * (j))
#define XB_XSUB(j)  (1280 + 64 * (j))
#define XB_XGEN(j)  (2304 + 64 * (j))
#define XB_TOP      3328
#define XB_TOPGEN   3392
#define XCD_BAR_WORDS 3456
#define XB_SPIN_CAP (1u << 18)
constexpr int CW_BAR = 4096;
__device__ __forceinline__ unsigned xb_ld(unsigned* p)              { return __hip_atomic_load(p, __ATOMIC_RELAXED, __HIP_MEMORY_SCOPE_AGENT); }
__device__ __forceinline__ unsigned xb_add(unsigned* p, unsigned v) { return __hip_atomic_fetch_add(p, v, __ATOMIC_RELAXED, __HIP_MEMORY_SCOPE_AGENT); }
__device__ __forceinline__ unsigned xb_xcc_id() { return (unsigned)__builtin_amdgcn_s_getreg((3 << 11) | 20) & 0xFu; }
#define XB_SPIN(cond, bar) do { unsigned _sp = 0; while (cond) { __builtin_amdgcn_s_sleep(1); \
    if ((++_sp & 255u) == 0u) { if (xb_ld(&(bar)[XB_TMO])) break; if (_sp > XB_SPIN_CAP) { atomicAdd(&(bar)[XB_TMO], 1u); break; } } } } while (0)
struct XcdBarrier { unsigned* bar; unsigned x; volatile LAS unsigned* st; };
__device__ __forceinline__ XcdBarrier xcd_barrier_post(unsigned* bar, volatile LAS unsigned* st) {
    XcdBarrier b; b.bar = bar; b.x = xb_xcc_id(); b.st = st;
    if (threadIdx.x == 0) (void)xb_add(&bar[XB_XCNT(b.x)], 1u);
    return b;
}
__device__ __forceinline__ void xcd_barrier_complete(unsigned* bar, unsigned x, unsigned& nloc, unsigned& nx) {
    const unsigned G = gridDim.x * gridDim.y * gridDim.z;
    unsigned sum, cnt, mine, sp = 0u;
    for (;;) {
        sum = 0u; cnt = 0u; mine = 0u;
#pragma unroll
        for (unsigned j = 0; j < 16; ++j) { const unsigned c = xb_ld(&bar[XB_XCNT(j)]); sum += c; cnt += (c > 0u) ? 1u : 0u; mine = (j == x) ? c : mine; }
        if (sum == G) break;
        __builtin_amdgcn_s_sleep(1);
        if ((++sp & 255u) == 0u) { if (xb_ld(&bar[XB_TMO])) break; if (sp > XB_SPIN_CAP) { atomicAdd(&bar[XB_TMO], 1u); break; } }
    }
    nloc = mine > 0u ? mine : 1u; nx = cnt > 0u ? cnt : 1u;
}
__device__ __forceinline__ void xcd_barrier(const XcdBarrier& b) {
    asm volatile("s_waitcnt vmcnt(0)" ::: "memory");
    __syncthreads();
    if (threadIdx.x == 0) {
        unsigned* bar = b.bar;
        __builtin_amdgcn_s_waitcnt(0);
        unsigned nloc = b.st[0], nx = b.st[1];
        if (nloc == 0u) { xcd_barrier_complete(bar, b.x, nloc, nx); b.st[0] = nloc; b.st[1] = nx; }
        const unsigned old = xb_add(&bar[XB_XSUB(b.x)], 1u);
        const unsigned gen = old / nloc;
        if (old + 1u == (gen + 1u) * nloc) {
            __builtin_amdgcn_fence(__ATOMIC_RELEASE, "agent");
            asm volatile("s_waitcnt vmcnt(0)" ::: "memory");
            const unsigned og = xb_add(&bar[XB_TOP], 1u);
            const unsigned tg = og / nx;
            if (og + 1u == (tg + 1u) * nx) xb_add(&bar[XB_TOPGEN], 1u);
            else XB_SPIN(xb_ld(&bar[XB_TOPGEN]) == tg, bar);
            __builtin_amdgcn_fence(__ATOMIC_ACQUIRE, "agent");
            xb_add(&bar[XB_XGEN(b.x)], 1u);
            asm volatile("s_waitcnt vmcnt(0)" ::: "memory");
        } else {
            XB_SPIN(xb_ld(&bar[XB_XGEN(b.x)]) == gen, bar);
            __builtin_amdgcn_fence(__ATOMIC_ACQUIRE, "agent");
            asm volatile("s_waitcnt vmcnt(0)" ::: "memory");
        }
    }
    __syncthreads();
}

struct Ctx { int tid, lane, wave, vcu, G; LAS unsigned char* lds; };

__device__ __forceinline__ void tr_item(const float* W, int ldw, bf16_t* WT, int ldt, LAS float* scr, int lane) {
#pragma unroll 8
    for (int i = 0; i < 32; ++i) { const int kk = 2 * i + (lane >> 5); scr[kk * 33 + (lane & 31)] = W[(size_t)kk * ldw + (lane & 31)]; }
    LDS_WAIT(); asm volatile("" ::: "memory");
    const int c = lane & 7;
#pragma unroll
    for (int j = 0; j < 4; ++j) { const int n = (lane >> 3) + 8 * j; const LAS float* s = scr + (8 * c) * 33 + n;
        u32x4 o; o.x = pk2(s[0 * 33], s[1 * 33]); o.y = pk2(s[2 * 33], s[3 * 33]); o.z = pk2(s[4 * 33], s[5 * 33]); o.w = pk2(s[6 * 33], s[7 * 33]);
        *(u32x4*)(WT + (size_t)n * ldt + 8 * c) = o; }
    LDS_WAIT(); asm volatile("" ::: "memory");
}

__device__ __forceinline__ void p0_prologue(const Args& a, const Ctx& c) {
    unsigned char* ws = a.ws;
    bf16_t* WGU = (bf16_t*)(ws + WS_WGU); bf16_t* WD = (bf16_t*)(ws + WS_WD); bf16_t* WIN = (bf16_t*)(ws + WS_WIN); bf16_t* WMKV = (bf16_t*)(ws + WS_WMKV);
    bf16_t* WOUT = (bf16_t*)(ws + WS_WOUT); bf16_t* WR = (bf16_t*)(ws + WS_WR);
    LAS float* WfT = (LAS float*)c.lds;
    LAS float* scr = (LAS float*)(c.lds + 32768 + c.wave * 8448);
    for (int idx = c.tid; idx < 8192; idx += 512) { const int h = idx & 7, k = idx >> 3; WfT[h * 1024 + k] = a.w_in[(size_t)k * INC + 1792 + h]; }
    const int gw = c.vcu * 8 + c.wave, NGW = c.G * 8;
    constexpr int NEXP_ITEMS = (NE + 1) * 384;
    constexpr int I_WIN = 1024, I_MKV = 256, I_OUT = 384, I_R = 128;
    constexpr int NITEMS = NEXP_ITEMS + I_WIN + I_MKV + I_OUT + I_R;
    for (int it = gw; it < NITEMS; it += NGW) {
        int r = it;
        if (r < NEXP_ITEMS) { const int e = r / 384; r -= e * 384;
            if (r < 256) { const int up = r >> 7; r &= 127; const int kb = r >> 3, nb = r & 7, n0 = nb * 32;
                const float* src = (e < NE) ? ((up ? a.w_up : a.w_gate) + (size_t)e * DM * EH) : (up ? a.ws_up : a.ws_gate);
                const int drow = (n0 >> 7) * 256 + up * 128 + (n0 & 127);
                tr_item(src + (size_t)kb * 64 * EH + n0, EH, WGU + ((size_t)e * 512 + drow) * DM + kb * 64, DM, scr, c.lane);
            } else { r -= 256; const int kb = r >> 5, nb = r & 31;
                const float* src = (e < NE) ? (a.w_down + (size_t)e * EH * DM) : a.ws_down;
                tr_item(src + (size_t)kb * 64 * DM + nb * 32, DM, WD + ((size_t)e * DM + nb * 32) * EH + kb * 64, EH, scr, c.lane); }
            continue; }
        r -= NEXP_ITEMS;
        if (r < I_WIN) {
            int col0, drow0, nbw;
            if (r < 256) { col0 = 256; drow0 = 0; nbw = 16; } else if (r < 512) { r -= 256; col0 = 768; drow0 = 512; nbw = 16; } else if (r < 768) { r -= 512; col0 = 1280; drow0 = 1024; nbw = 16; }
            else if (r < 896) { r -= 768; col0 = 0; drow0 = 1536; nbw = 8; } else { r -= 896; col0 = 1800; drow0 = 1792; nbw = 8; }
            const int kb = r / nbw, nb = r % nbw;
            tr_item(a.w_in + (size_t)kb * 64 * INC + col0 + nb * 32, INC, WIN + (size_t)(drow0 + nb * 32) * DM + kb * 64, DM, scr, c.lane);
            continue; }
        r -= I_WIN;
        if (r < I_MKV) { const int kb = r >> 4, nb = r & 15; tr_item(a.w_mem_kv + (size_t)kb * 64 * 512 + nb * 32, 512, WMKV + (size_t)(nb * 32) * DM + kb * 64, DM, scr, c.lane); continue; }
        r -= I_MKV;
        if (r < I_OUT) { const int kb = r >> 5, nb = r & 31; tr_item(a.w_out + (size_t)(256 + kb * 64) * DM + nb * 32, DM, WOUT + (size_t)(nb * 32) * DM + 256 + kb * 64, DM, scr, c.lane); continue; }
        r -= I_OUT;
        { const int kb = r >> 3, nb = r & 7; tr_item(a.w_router + (size_t)kb * 64 * NE + nb * 32, NE, WR + (size_t)(nb * 32) * DM + kb * 64, DM, scr, c.lane); }
    }
    for (int idx = (c.vcu * 512 + c.tid); idx < 256 * 1024; idx += c.G * 512) { const int k = idx >> 10, n = idx & 1023, g = k >> 6, cc = k & 63; float s = 0.f;
        for (int d = 0; d < 64; ++d) s += a.w_pool[g * 4096 + cc * 64 + d] * a.pool_scale[g * 64 + d] * a.w_out[(size_t)(g * 64 + d) * DM + n];
        WOUT[(size_t)n * DM + k] = (bf16_t)f2bf(s); }
    __syncthreads();
    bf16_t* XB = (bf16_t*)(ws + WS_XB); float* FLOG = (float*)(ws + WS_FLOG);
    for (int m = gw; m < T; m += NGW) {
        const f32x4* xr = (const f32x4*)(a.x + (size_t)m * DM) + c.lane; f32x4 v[4];
#pragma unroll
        for (int j = 0; j < 4; ++j) v[j] = xr[64 * j];
        u32x2* o8 = (u32x2*)(XB + (size_t)m * DM) + c.lane;
#pragma unroll
        for (int j = 0; j < 4; ++j) o8[64 * j] = (u32x2){pk2(v[j].x, v[j].y), pk2(v[j].z, v[j].w)};
        float acc[8];
#pragma unroll
        for (int h = 0; h < 8; ++h) { float s = 0.f;
#pragma unroll
            for (int j = 0; j < 4; ++j) { const f32x4 w = *(const LAS f32x4*)(WfT + h * 1024 + 4 * c.lane + 256 * j); s += (v[j].x * w.x + v[j].y * w.y) + (v[j].z * w.z + v[j].w * w.w); }
            acc[h] = wave_sum(s); }
        float z = acc[0];
#pragma unroll
        for (int h = 1; h < 8; ++h) z = (c.lane == h) ? acc[h] : z;
        if (c.lane < 8) { z += a.b_f[c.lane]; const float lf = (z >= 0.f) ? -log1pf(expf(-z)) : (z - log1pf(expf(z))); FLOG[(size_t)m * 8 + c.lane] = lf; }
    }
    bf16_t* MEMB = (bf16_t*)(ws + WS_MEMB);
    for (int m = gw; m < NB * 256; m += NGW) {
        const f32x4* xr = (const f32x4*)(a.mem + (size_t)m * DM) + c.lane; u32x2* o8 = (u32x2*)(MEMB + (size_t)m * DM) + c.lane;
#pragma unroll
        for (int j = 0; j < 4; ++j) { const f32x4 v = xr[64 * j]; o8[64 * j] = (u32x2){pk2(v.x, v.y), pk2(v.z, v.w)}; }
    }
}

__device__ __forceinline__ void p1_fscan(const Args& a, const Ctx& c) {
    if (c.vcu >= 64) return;
    const float* FLOG = (const float*)(a.ws + WS_FLOG); float* FC = (float*)(a.ws + WS_FC);
    LAS float* wtot = (LAS float*)c.lds;
    const int bh = c.vcu, b = bh >> 3, h = bh & 7; float p[8]; float run = 0.f;
#pragma unroll
    for (int i = 0; i < 8; ++i) { run += FLOG[((size_t)b * SEQ + c.tid * 8 + i) * 8 + h]; p[i] = run; }
    float inc = run;
#pragma unroll
    for (int o = 1; o < 64; o <<= 1) { const float t = __shfl_up(inc, o); if (c.lane >= o) inc += t; }
    if (c.lane == 63) wtot[c.wave] = inc;
    __syncthreads();
    float base = inc - run;
    for (int w = 0; w < c.wave; ++w) base += wtot[w];
#pragma unroll
    for (int i = 0; i < 8; ++i) FC[(size_t)bh * SEQ + c.tid * 8 + i] = (base + p[i]) * LOG2E;
    __syncthreads();
}

__device__ __forceinline__ void p2_mixers(const Args& a, const Ctx& c) {
    unsigned char* ws = a.ws;
    const bf16_t* Q = (const bf16_t*)(ws + WS_Q); const bf16_t* Kb = (const bf16_t*)(ws + WS_K); const bf16_t* V = (const bf16_t*)(ws + WS_V); const bf16_t* QM = (const bf16_t*)(ws + WS_QM);
    const bf16_t* U = (const bf16_t*)(ws + WS_U); const bf16_t* KVM = (const bf16_t*)(ws + WS_KVM); bf16_t* YMIX = (bf16_t*)(ws + WS_YMIX); const float* FC = (const float*)(ws + WS_FC);
    { const int cp = c.tid & 127, rg = c.tid >> 7, ch = 2 * cp, w = 2 << (ch >> 6);
      for (int i = 0; i < 32; ++i) { const int t = c.vcu * 128 + rg * 32 + i; if (t >= T) break; const int pos = t & (SEQ - 1), cnt = (pos + 1 < w) ? pos + 1 : w;
          float s0 = 0.f, s1 = 0.f, u0 = 0.f, u1 = 0.f;
          for (int jw = 0; jw < cnt; ++jw) { const unsigned wv = *(const unsigned*)(U + (size_t)(t - jw) * 256 + ch); const float x0 = bflo(wv), x1 = bfhi(wv); s0 += x0; s1 += x1; if (jw == 0) { u0 = x0; u1 = x1; } }
          const float inv = 1.0f / (float)cnt;
          *(unsigned*)(YMIX + (size_t)t * DM + ch) = pk2(s0 * inv - u0, s1 * inv - u1); } }
    __syncthreads();
    { const int bh = c.vcu >> 2, s = c.vcu & 3, b = bh >> 3, h = bh & 7;
      for (int i = 0; i < 4; ++i) { const int qb = (i == 0) ? s : (i == 1) ? 15 - s : (i == 2) ? 7 - s : 8 + s;
          att::Job j; const size_t row0 = (size_t)b * SEQ;
          j.Q = Q + (row0 + qb * 256) * 512 + h * 64; j.qpitch = 512; j.K = Kb + row0 * 512 + h * 64; j.V = V + row0 * 512 + h * 64; j.kvpitch = 512;
          j.O = YMIX + (row0 + qb * 256) * DM + 256 + h * 64; j.nt = 4 * qb + 4; j.causal = 1; j.FC = FC + (size_t)bh * SEQ; j.q0 = qb * 256;
          att::unit<true>(j, c.lds); } }
    for (int i = 0; i < 2; ++i) { const int mu = c.vcu * 2 + i, b = mu >> 6, hm = (mu >> 4) & 3, qb = mu & 15;
        att::Job j; const size_t row0 = (size_t)b * SEQ + qb * 256;
        j.Q = QM + row0 * 256 + hm * 64; j.qpitch = 256; j.K = KVM + (size_t)b * 256 * 512 + hm * 64; j.V = KVM + (size_t)b * 256 * 512 + 256 + hm * 64; j.kvpitch = 512;
        j.O = YMIX + row0 * DM + 768 + hm * 64; j.nt = 4; j.causal = 0; j.FC = nullptr; j.q0 = 0;
        att::unit<false>(j, c.lds); }
}

__device__ __forceinline__ void p4_ln1(const Args& a, const Ctx& c) {
    bf16_t* X1B = (bf16_t*)(a.ws + WS_X1B); const int gw = c.vcu * 8 + c.wave, NGW = c.G * 8;
    f32x4 g4[4], b4[4];
#pragma unroll
    for (int j = 0; j < 4; ++j) { g4[j] = *((const f32x4*)a.ln1_g + c.lane + 64 * j); b4[j] = *((const f32x4*)a.ln1_b + c.lane + 64 * j); }
    for (int m = gw; m < T; m += NGW) {
        const f32x4* xr = (const f32x4*)(a.out + (size_t)m * DM) + c.lane; f32x4 v[4]; float s = 0.f;
#pragma unroll
        for (int j = 0; j < 4; ++j) { v[j] = xr[64 * j]; s += (v[j].x + v[j].y) + (v[j].z + v[j].w); }
        const float mean = wave_sum(s) * (1.f / DM); float s2 = 0.f;
#pragma unroll
        for (int j = 0; j < 4; ++j) { v[j] = v[j] - mean; s2 += (v[j].x * v[j].x + v[j].y * v[j].y) + (v[j].z * v[j].z + v[j].w * v[j].w); }
        const float rstd = 1.f / sqrtf(wave_sum(s2) * (1.f / DM) + LN_EPS);
        u32x2* o8 = (u32x2*)(X1B + (size_t)m * DM) + c.lane;
#pragma unroll
        for (int j = 0; j < 4; ++j) { const f32x4 y = v[j] * rstd * g4[j] + b4[j]; o8[64 * j] = (u32x2){pk2(y.x, y.y), pk2(y.z, y.w)}; }
    }
}

__device__ __forceinline__ void p6_route(const Args& a, const Ctx& c) {
    const float* LOG = (const float*)(a.ws + WS_LOG); int* cnt = (int*)(a.ws + WS_CTL); int* bins = (int*)(a.ws + WS_BINS); float* gates = (float*)(a.ws + WS_GATES);
    const int gw = c.vcu * 8 + c.wave, NGW = c.G * 8, lane = c.lane;
    const f32x4 bs = *((const f32x4*)a.router_bias + lane);
    for (int tok = gw; tok < T; tok += NGW) {
        const f32x4 lg = *((const f32x4*)(LOG + (size_t)tok * NE) + lane);
        float sc0 = 1.f / (1.f + expf(-lg.x)), sc1 = 1.f / (1.f + expf(-lg.y)), sc2 = 1.f / (1.f + expf(-lg.z)), sc3 = 1.f / (1.f + expf(-lg.w));
        float v0 = sc0 + bs.x, v1 = sc1 + bs.y, v2 = sc2 + bs.z, v3 = sc3 + bs.w;
        float m1, m2; { const float A = fmaxf(v0, v1), B = fminf(v0, v1), C = fmaxf(v2, v3), Dd = fminf(v2, v3); m1 = fmaxf(A, C); m2 = fmaxf(fminf(A, C), fmaxf(B, Dd)); }
#pragma unroll
        for (int o = 1; o < 8; o <<= 1) { const float o1 = __shfl_xor(m1, o), o2 = __shfl_xor(m2, o); const float n1 = fmaxf(m1, o1), n2 = fmaxf(fminf(m1, o1), fmaxf(m2, o2)); m1 = n1; m2 = n2; }
        const float gs = m1 + m2; const int g = lane >> 3; int rank = 0;
#pragma unroll
        for (int jg = 0; jg < 8; ++jg) { const float gj = __shfl(gs, 8 * jg); rank += (gj > gs || (gj == gs && jg < g)) ? 1 : 0; }
        const bool selg = rank < 4;
        if (!selg) { v0 = -INFINITY; v1 = -INFINITY; v2 = -INFINITY; v3 = -INFINITY; }
        int my_e = 0; float my_s = 0.f;
#pragma unroll
        for (int k = 0; k < TOPK; ++k) {
            float best = v0; int bi = 0;
            if (v1 > best) { best = v1; bi = 1; } if (v2 > best) { best = v2; bi = 2; } if (v3 > best) { best = v3; bi = 3; }
            int idx = 4 * lane + bi;
#pragma unroll
            for (int o = 1; o < 64; o <<= 1) { const float ov = __shfl_xor(best, o); const int oi = __shfl_xor(idx, o); if (ov > best || (ov == best && oi < idx)) { best = ov; idx = oi; } }
            const int sub = idx & 3; const float mys = (sub == 0) ? sc0 : (sub == 1) ? sc1 : (sub == 2) ? sc2 : sc3;
            const float sk = __shfl(mys, idx >> 2);
            if ((idx >> 2) == lane) { if (sub == 0) v0 = -INFINITY; else if (sub == 1) v1 = -INFINITY; else if (sub == 2) v2 = -INFINITY; else v3 = -INFINITY; }
            if (lane == k) { my_e = idx; my_s = sk; }
        }
        float tot = (lane < 8) ? my_s : 0.f;
        tot += __shfl_xor(tot, 1); tot += __shfl_xor(tot, 2); tot += __shfl_xor(tot, 4);
        if (lane < 8) { const float gate = my_s / tot * 2.5f; const int aid = tok * 8 + lane; const int pos = atomicAdd(&cnt[my_e], 1); bins[(size_t)my_e * T + pos] = aid; gates[aid] = gate; }
    }
}

__device__ __forceinline__ int build_tables(const Args& a, const Ctx& c) {
    const int* cnt = (const int*)(a.ws + WS_CTL);
    LAS unsigned short* te = (LAS unsigned short*)(c.lds + TE_OFF); LAS int* tb = (LAS int*)(c.lds + TB_OFF); LAS int* cn = (LAS int*)(c.lds + CN_OFF);
    __syncthreads();
    if (c.tid < NE) cn[c.tid] = __hip_atomic_load(cnt + c.tid, __ATOMIC_RELAXED, __HIP_MEMORY_SCOPE_AGENT);
    __syncthreads();
    if (c.tid == 0) { int run = 0; for (int e = 0; e < NE; ++e) { tb[e] = run; run += (cn[e] + 255) >> 8; } tb[NE] = run; }
    __syncthreads();
    if (c.tid < NE) { const int n = (cn[c.tid] + 255) >> 8, b0 = tb[c.tid]; for (int jt = 0; jt < n; ++jt) te[b0 + jt] = (unsigned short)c.tid; }
    __syncthreads();
    return tb[NE];
}

__device__ __forceinline__ void p9_combine(const Args& a, const Ctx& c) {
    const bf16_t* X1B = (const bf16_t*)(a.ws + WS_X1B); const bf16_t* Y = (const bf16_t*)(a.ws + WS_Y); const int gw = c.vcu * 8 + c.wave, NGW = c.G * 8;
    f32x4 g4[4], b4[4];
#pragma unroll
    for (int j = 0; j < 4; ++j) { g4[j] = *((const f32x4*)a.ln2_g + c.lane + 64 * j); b4[j] = *((const f32x4*)a.ln2_b + c.lane + 64 * j); }
    for (int m = gw; m < T; m += NGW) {
        f32x4* orow = (f32x4*)(a.out + (size_t)m * DM) + c.lane; f32x4 v[4]; float s = 0.f;
        const u32x2* x8 = (const u32x2*)(X1B + (size_t)m * DM) + c.lane;
#pragma unroll
        for (int j = 0; j < 4; ++j) { const u32x2 xw = x8[64 * j]; v[j] = orow[64 * j] + (f32x4){bflo(xw.x), bfhi(xw.x), bflo(xw.y), bfhi(xw.y)} * ALPHA; }
#pragma unroll
        for (int k = 0; k < TOPK; ++k) { const u32x2* y8 = (const u32x2*)(Y + ((size_t)m * TOPK + k) * DM) + c.lane;
#pragma unroll
            for (int j = 0; j < 4; ++j) { const u32x2 yw = y8[64 * j]; v[j] += (f32x4){bflo(yw.x), bfhi(yw.x), bflo(yw.y), bfhi(yw.y)}; } }
#pragma unroll
        for (int j = 0; j < 4; ++j) s += (v[j].x + v[j].y) + (v[j].z + v[j].w);
        const float mean = wave_sum(s) * (1.f / DM); float s2 = 0.f;
#pragma unroll
        for (int j = 0; j < 4; ++j) { v[j] = v[j] - mean; s2 += (v[j].x * v[j].x + v[j].y * v[j].y) + (v[j].z * v[j].z + v[j].w * v[j].w); }
        const float rstd = 1.f / sqrtf(wave_sum(s2) * (1.f / DM) + LN_EPS);
#pragma unroll
        for (int j = 0; j < 4; ++j) orow[64 * j] = v[j] * rstd * g4[j] + b4[j];
    }
}

constexpr int NPHASE = 10;
__global__ void __launch_bounds__(512, 2) mk_fwd(Args a) {
    extern __shared__ __attribute__((aligned(16))) unsigned char lds_raw[];
    cg::grid_group grid = cg::this_grid();
    Ctx c; c.lds = (LAS unsigned char*)lds_raw; c.tid = threadIdx.x; c.lane = c.tid & 63; c.wave = __builtin_amdgcn_readfirstlane(c.tid >> 6); c.G = gridDim.x;
    { const int bx = blockIdx.x; c.vcu = (c.G % 8 == 0) ? (bx % 8) * (c.G / 8) + bx / 8 : bx; }
    unsigned char* ws = a.ws; const int lo = a.ph_lo, hi = a.ph_hi;
#define IN(k) (lo <= (k) && (k) < hi)
    for (int u = c.tid; u < 32; u += 512) ((volatile LAS unsigned*)(c.lds + MISC_OFF))[u] = 0u;
    __syncthreads();
    XcdBarrier bar = xcd_barrier_post((unsigned*)(ws + WS_CTL) + CW_BAR + a.li * XCD_BAR_WORDS, (volatile LAS unsigned*)(c.lds + MISC_OFF) + 8);
    if (a.ph_lo < 0) grid.sync();
#define SEAM(k) do { if (IN(k) && IN((k) + 1)) xcd_barrier(bar); } while (0)
    if (IN(0)) p0_prologue(a, c);
    SEAM(0);
    if (IN(1)) {
        p1_fscan(a, c);
        { pg8::DenseSched S; S.init(T, 2048, DM, c.G, (int)blockIdx.x, ws + WS_WIN);
          pg8::EpiInProj E{(bf16_t*)(ws + WS_Q), (bf16_t*)(ws + WS_K), (bf16_t*)(ws + WS_V), (bf16_t*)(ws + WS_U), (bf16_t*)(ws + WS_QM)};
          pg8::gemm_phase(c.lds, (const char*)(ws + WS_XB), DM, S, E); }
        { pg8::DenseSched S; S.init(NB * 256, 512, DM, c.G, (int)blockIdx.x, ws + WS_WMKV);
          pg8::EpiBf16 E{(bf16_t*)(ws + WS_KVM), 512};
          pg8::gemm_phase(c.lds, (const char*)(ws + WS_MEMB), DM, S, E); }
    }
    SEAM(1);
    if (IN(2)) p2_mixers(a, c);
    SEAM(2);
    if (IN(3)) { pg8::DenseSched S; S.init(T, DM, DM, c.G, (int)blockIdx.x, ws + WS_WOUT);
        pg8::EpiF32 E{a.out, DM, a.x, ALPHA};
        pg8::gemm_phase(c.lds, (const char*)(ws + WS_YMIX), DM, S, E); }
    SEAM(3);
    if (IN(4)) p4_ln1(a, c);
    SEAM(4);
    if (IN(5)) { pg8::DenseSched S; S.init(T, NE, DM, c.G, (int)blockIdx.x, ws + WS_WR);
        pg8::EpiF32 E{(float*)(ws + WS_LOG), NE, nullptr, 0.f};
        pg8::gemm_phase(c.lds, (const char*)(ws + WS_X1B), DM, S, E); }
    SEAM(5);
    if (IN(6)) p6_route(a, c);
    SEAM(6);
    if (IN(7)) { const int NTR = build_tables(a, c);
        pg8::GroupSched S; S.nunits = (NTR + 128) * 2; S.G = c.G; S.c = (int)blockIdx.x; S.shift = 1; S.NTR = NTR; S.mode = 0; S.K = DM;
        S.tile_e = (const LAS unsigned short*)(c.lds + TE_OFF); S.tbase = (const LAS int*)(c.lds + TB_OFF); S.cnt = (const LAS int*)(c.lds + CN_OFF);
        S.bins = (const int*)(ws + WS_BINS); S.Bt = (const char*)(ws + WS_WGU); S.estride = (size_t)512 * DM * 2;
        pg8::EpiGateUp E{(bf16_t*)(ws + WS_HB)};
        pg8::gemm_phase(c.lds, (const char*)(ws + WS_X1B), DM, S, E); }
    SEAM(7);
    if (IN(8)) { const int NTR = build_tables(a, c);
        pg8::GroupSched S; S.nunits = (NTR + 128) * 4; S.G = c.G; S.c = (int)blockIdx.x; S.shift = 2; S.NTR = NTR; S.mode = 1; S.K = EH;
        S.tile_e = (const LAS unsigned short*)(c.lds + TE_OFF); S.tbase = (const LAS int*)(c.lds + TB_OFF); S.cnt = (const LAS int*)(c.lds + CN_OFF);
        S.bins = (const int*)(ws + WS_BINS); S.Bt = (const char*)(ws + WS_WD); S.estride = (size_t)DM * EH * 2;
        pg8::EpiDown E{(bf16_t*)(ws + WS_Y), a.out, (const int*)(ws + WS_BINS), (const float*)(ws + WS_GATES)};
        pg8::gemm_phase(c.lds, (const char*)(ws + WS_HB), EH, S, E); }
    SEAM(8);
    if (IN(9)) p9_combine(a, c);
#undef IN
#undef SEAM
}

#ifndef MK_N_LAUNCHES
#define MK_N_LAUNCHES 1
#endif
extern "C" void kernel_launch(void* const* d_in, const int* in_sizes, int n_in, void* d_out, int out_size, void* d_ws, size_t ws_size, hipStream_t stream) {
    static int grid = 0;
    if (grid == 0) {
        if (n_in != 20 || out_size != T * DM || ws_size < WS_END) { fprintf(stderr, "kernel_launch: unexpected shapes (n_in %d out %d ws %zu)\n", n_in, out_size, ws_size); grid = -1; return; }
        int dev = 0, cus = 0, per_cu = 0;
        (void)hipGetDevice(&dev); (void)hipDeviceGetAttribute(&cus, hipDeviceAttributeMultiprocessorCount, dev);
        if (hipFuncSetAttribute((const void*)mk_fwd, hipFuncAttributeMaxDynamicSharedMemorySize, LDS_BYTES) != hipSuccess) { fprintf(stderr, "kernel_launch: hipFuncSetAttribute failed\n"); grid = -1; return; }
        (void)hipOccupancyMaxActiveBlocksPerMultiprocessor(&per_cu, (const void*)mk_fwd, 512, LDS_BYTES);
        if (per_cu < 1) { fprintf(stderr, "kernel_launch: occupancy query says %d blocks per CU\n", per_cu); grid = -1; return; }
        grid = cus;
        if (grid != 256) fprintf(stderr, "kernel_launch: %d CUs (built for 256)\n", grid);
    }
    if (grid < 0) return;
    (void)hipMemsetAsync((char*)d_ws + WS_CTL, 0, CTL_ZERO_BYTES, stream);
    Args a{};
    const float** p = (const float**)&a;
    for (int i = 0; i < 20; ++i) p[i] = (const float*)d_in[i];
    a.out = (float*)d_out; a.ws = (unsigned char*)d_ws;
    const int nl = MK_N_LAUNCHES;
    for (int li = 0; li < nl; ++li) {
        a.ph_lo = (nl == 1) ? 0 : li; a.ph_hi = (nl == 1) ? NPHASE : li + 1; a.li = li;
        void* args[] = {&a};
        const hipError_t e = hipLaunchCooperativeKernel((void*)mk_fwd, dim3(grid), dim3(512), args, LDS_BYTES, stream);
        if (e != hipSuccess) { fprintf(stderr, "kernel_launch: cooperative launch failed: %s\n", hipGetErrorString(e)); break; }
    }
}
```

```cpp
#include <hip/hip_runtime.h>
#include <hip/hip_cooperative_groups.h>
#include <cstdio>
#include <cstdint>
namespace cg = cooperative_groups;
#ifndef PROBE_T
#define PROBE_T -1
#endif
#ifndef PROBE_MODE
#define PROBE_MODE 0
#endif
#define PROBE_MULT 4
constexpr int CW_PROBE = 20000;
#define PT_BEGIN(id) unsigned long long ptb_##id = 0ull; if (PROBE_T == (id)) ptb_##id = __builtin_amdgcn_s_memrealtime();
#define PT_END(id, tacc) if (PROBE_T == (id)) { asm volatile("s_waitcnt vmcnt(0)" ::: "memory"); __syncthreads(); *(tacc) += __builtin_amdgcn_s_memrealtime() - ptb_##id; }

#define LAS __attribute__((address_space(3)))
typedef unsigned short bf16_t;
typedef short bf16x8 __attribute__((ext_vector_type(8)));
typedef short s16x4 __attribute__((ext_vector_type(4)));
typedef float f32x4 __attribute__((ext_vector_type(4)));
typedef float f32x2 __attribute__((ext_vector_type(2)));
typedef float f32x16 __attribute__((ext_vector_type(16)));
typedef unsigned u32x4 __attribute__((ext_vector_type(4)));
typedef unsigned u32x2 __attribute__((ext_vector_type(2)));

constexpr int NB = 8, SEQ = 4096, T = NB * SEQ, DM = 1024;
constexpr int INC = 2056;
constexpr int NE = 256, TOPK = 8, EH = 256;
constexpr float ALPHA = 1.189207115002721f;
constexpr float LN_EPS = 1e-5f;
constexpr float LOG2E = 1.4426950408889634f;
constexpr float C2 = 0.125f * LOG2E;
constexpr int MAXTILES = 1280 + 128;

constexpr size_t MiB = 1u << 20;
constexpr size_t WS_CTL = 0, WS_WD = 1 * MiB, WS_HB = 130 * MiB, WS_X1B = 306 * MiB, WS_BINS = 370 * MiB, WS_GATES = 402 * MiB, WS_FC = 403 * MiB, WS_FLOG = 404 * MiB,
                 WS_KVM = 405 * MiB, WS_Y = 408 * MiB, WS_WGU = 408 * MiB, WS_WIN = 665 * MiB, WS_WMKV = 669 * MiB, WS_WOUT = 670 * MiB, WS_WR = 672 * MiB, WS_MEMB = 673 * MiB,
                 WS_XB = 677 * MiB, WS_Q = 741 * MiB, WS_K = 773 * MiB, WS_V = 805 * MiB, WS_QM = 837 * MiB, WS_U = 853 * MiB, WS_YMIX = 869 * MiB, WS_LOG = 933 * MiB, WS_END = 965 * MiB;
constexpr size_t CTL_ZERO_BYTES = 1 * MiB;
constexpr int CW_NRM = 16384;

constexpr int RING_BYTES = 131072;
constexpr int TE_OFF = 131072, TB_OFF = 135168, CN_OFF = 137216, MISC_OFF = 139264, LDS_BYTES = 147456;

struct Args {
    const float *x, *mem, *w_in, *b_f, *w_pool, *pool_scale, *w_mem_kv, *w_out, *ln1_g, *ln1_b, *w_router, *router_bias, *w_gate, *w_up, *w_down, *ws_gate, *ws_up, *ws_down, *ln2_g, *ln2_b;
    float* out; unsigned char* ws; int ph_lo, ph_hi, li, pad;
};

__device__ __forceinline__ unsigned f2bf(float f) { unsigned u = __float_as_uint(f); return (u + 0x7fffu + ((u >> 16) & 1u)) >> 16; }
__device__ __forceinline__ unsigned pk2(float lo, float hi) { return f2bf(lo) | (f2bf(hi) << 16); }
__device__ __forceinline__ float bflo(unsigned w) { return __uint_as_float(w << 16); }
__device__ __forceinline__ float bfhi(unsigned w) { return __uint_as_float(w & 0xffff0000u); }
__device__ __forceinline__ float wave_sum(float v) {
#pragma unroll
    for (int o = 1; o < 64; o <<= 1) v += __shfl_xor(v, o);
    return v;
}
#define LDS_WAIT() asm volatile("s_waitcnt lgkmcnt(0)" ::: "memory")

namespace pg8 {
constexpr int BM = 256, BK = 64, HALF = 128, HTB = HALF * BK * 2, NXCD = 8, WGM = 8;
__device__ __forceinline__ int lds_byte(int r, int c) { const int st = (r >> 4) * 2 + (c >> 5), rr = r & 15, cc = c & 31, ob = rr * 64 + cc * 2; return st * 1024 + (ob ^ (((ob >> 9) & 1) << 5)); }
__device__ __forceinline__ void stage_rc(int b, int& R, int& C) { const int st = b / 1024, sb = b % 1024, swz = sb ^ (((sb >> 9) & 1) << 5); R = (st >> 1) * 16 + swz / 64; C = (st & 1) * 32 + (swz % 64) / 2; }
__device__ __forceinline__ int perm32(int rho) { const int n = rho >> 4, i = rho & 15; return 8 * (i >> 2) + 4 * n + (i & 3); }
__device__ __forceinline__ int xcd_remap(int L, int nwg) { const int q = nwg / NXCD, r = nwg % NXCD, xcd = L % NXCD, off = L / NXCD; return (xcd < r ? xcd * (q + 1) : r * (q + 1) + (xcd - r) * q) + off; }

struct Unit { int pm, pn, e, rows, mt; };

struct DenseSched {
    int nM, nN, nwg, G, c, K; const char* Bt;
    __device__ __forceinline__ void init(int M, int N, int K_, int G_, int c_, const void* Bt_) { nM = M / BM; nN = N / BM; nwg = nM * nN; G = G_; c = c_; K = K_; Bt = (const char*)Bt_; }
    __device__ __forceinline__ bool next(int i, Unit& u) const {
        const long L = (long)i * G + c; if (L >= nwg) return false;
        const int wgid = xcd_remap((int)L, nwg);
        const int nig = WGM * nN, gid = wgid / nig, fm = gid * WGM, gsz = (nM - fm) < WGM ? (nM - fm) : WGM;
        u.pm = fm + ((wgid % nig) % gsz); u.pn = (wgid % nig) / gsz; u.e = 0; u.rows = 256; u.mt = u.pm; return true;
    }
    __device__ __forceinline__ unsigned a_off(const Unit& u, int h, int R, int C) const { return (unsigned)(((u.pm * BM + h * HALF + R) * K + C) * 2); }
    __device__ __forceinline__ const char* b_ptr(const Unit& u) const { return Bt + (size_t)u.pn * BM * K * 2; }
};

struct GroupSched {
    int nunits, G, c, shift, NTR, mode, K; const LAS unsigned short* tile_e; const LAS int* tbase; const LAS int* cnt; const int* bins; const char* Bt; size_t estride;
    __device__ __forceinline__ bool next(int i, Unit& u) const {
        const long L = (long)i * G + c; if (L >= nunits) return false;
        const int wgid = xcd_remap((int)L, nunits);
        const int tau = wgid >> shift; u.pn = wgid & ((1 << shift) - 1); u.pm = tau;
        if (tau < NTR) { const int e = tile_e[tau]; u.e = e; u.mt = tau - tbase[e]; const int left = cnt[e] - u.mt * 256; u.rows = left < 256 ? left : 256; }
        else { u.e = NE; u.mt = tau - NTR; u.rows = 256; }
        return true;
    }
    __device__ __forceinline__ unsigned a_off(const Unit& u, int h, int R, int C) const {
        if (mode == 0) { const int rl = h * HALF + R; int tok;
            if (u.e < NE) tok = (rl < u.rows) ? (bins[(size_t)u.e * T + u.mt * 256 + rl] >> 3) : 0; else tok = u.mt * 256 + rl;
            return (unsigned)((tok * 1024 + C) * 2); }
        return (unsigned)(((u.pm * BM + h * HALF + R) * 256 + C) * 2);
    }
    __device__ __forceinline__ const char* b_ptr(const Unit& u) const { return Bt + (size_t)u.e * estride + (size_t)u.pn * BM * K * 2; }
};

__device__ __forceinline__ unsigned cvt_pk_bf16(float lo, float hi) { unsigned r; asm volatile("v_cvt_pk_bf16_f32 %0, %1, %2" : "=v"(r) : "v"(lo), "v"(hi)); return r; }

template <bool TIME = false, class Epi, class Sched>
__device__ __forceinline__ void gemm_phase(LAS unsigned char* lds, const char* Abase, int K, const Sched& S, const Epi& E, unsigned long long* tacc = nullptr) {
    const int tid = threadIdx.x, wid = __builtin_amdgcn_readfirstlane(tid >> 6), lane = tid & 63, wr = wid >> 2, wc = wid & 3, fr = lane & 15, fq = lane >> 4;
    const int nt = K / BK;
    int RA[2], CA[2]; unsigned voffB[2];
#pragma unroll
    for (int i = 0; i < 2; ++i) { int R, C; stage_rc(tid * 16 + i * 8192, R, C); const int Rb = Epi::PERM ? ((R & ~31) + perm32(R & 31)) : R; RA[i] = R; CA[i] = C; voffB[i] = (unsigned)(Rb * K + C) * 2u; }
    const size_t kstep = (size_t)(BK * 2);
    const size_t hstep = (size_t)HALF * K * 2;
    const unsigned ldsw = (unsigned)wid * 1024u;
    const int aoff = lds_byte(wr * 64 + fr, fq * 8), boff = lds_byte(wc * 32 + fr, fq * 8);
#define PG8_SA(b, h) (((b) * 2 + (h)) * HTB)
#define PG8_SB(b, h) ((4 + (b) * 2 + (h)) * HTB)
#define PG8_STAGEB(bufoff, gbase) do { _Pragma("unroll") for (int _i = 0; _i < 2; ++_i) \
        __builtin_amdgcn_global_load_lds((const unsigned*)((const char*)(gbase) + voffB[_i]), (LAS unsigned*)(lds + (bufoff) + ldsw + _i * 8192), 16, 0, 0); } while (0)
#define PG8_STAGEA(bufoff, koff, v0, v1) do { \
        __builtin_amdgcn_global_load_lds((const unsigned*)(Abase + (koff) + (v0)), (LAS unsigned*)(lds + (bufoff) + ldsw), 16, 0, 0); \
        __builtin_amdgcn_global_load_lds((const unsigned*)(Abase + (koff) + (v1)), (LAS unsigned*)(lds + (bufoff) + ldsw + 8192), 16, 0, 0); } while (0)
#define PG8_LDA(dst, b, h) do { _Pragma("unroll") for (int m = 0; m < 4; ++m) _Pragma("unroll") for (int k = 0; k < 2; ++k) dst[m][k] = *(const LAS bf16x8*)(lds + PG8_SA(b, h) + aoff + m * 2048 + k * 1024); } while (0)
#define PG8_LDB(dst, b, h) do { _Pragma("unroll") for (int n = 0; n < 2; ++n) _Pragma("unroll") for (int k = 0; k < 2; ++k) dst[n][k] = *(const LAS bf16x8*)(lds + PG8_SB(b, h) + boff + n * 2048 + k * 1024); } while (0)
#define PG8_MMA(ai, bj, At, Bt) do { __builtin_amdgcn_s_setprio(1); _Pragma("unroll") for (int m = 0; m < 4; ++m) _Pragma("unroll") for (int n = 0; n < 2; ++n) _Pragma("unroll") for (int k = 0; k < 2; ++k) \
        acc[ai][bj][m][n] = __builtin_amdgcn_mfma_f32_16x16x32_bf16(Bt[n][k], At[m][k], acc[ai][bj][m][n], 0, 0, 0); __builtin_amdgcn_s_setprio(0); } while (0)
#define PG8_WAIT_V(n) asm volatile("s_waitcnt vmcnt(" #n ")" ::: "memory")
#define PG8_WAIT_L(n) asm volatile("s_waitcnt lgkmcnt(" #n ")" ::: "memory")
#define PG8_BAR __builtin_amdgcn_s_barrier()
#define PG8_SCHED __builtin_amdgcn_sched_barrier(0)
    Unit cur, nxt; int ui = 0;
    if (!S.next(0, cur)) return;
    unsigned vc00 = S.a_off(cur, 0, RA[0], CA[0]), vc01 = S.a_off(cur, 0, RA[1], CA[1]), vc10 = S.a_off(cur, 1, RA[0], CA[0]), vc11 = S.a_off(cur, 1, RA[1], CA[1]);
    asm volatile("" : "+v"(vc00), "+v"(vc01), "+v"(vc10), "+v"(vc11));
    f32x4 acc[2][2][4][2];
#pragma unroll
    for (int a = 0; a < 2; ++a)
#pragma unroll
        for (int b = 0; b < 2; ++b)
#pragma unroll
            for (int m = 0; m < 4; ++m)
#pragma unroll
                for (int n = 0; n < 2; ++n) acc[a][b][m][n] = (f32x4){0.f, 0.f, 0.f, 0.f};
    bf16x8 At[4][2], B0[2][2], B1[2][2];
    const char* cB = S.b_ptr(cur);
    PG8_STAGEB(PG8_SB(0, 0), cB); PG8_STAGEB(PG8_SB(0, 1), cB + hstep); PG8_STAGEA(PG8_SA(0, 0), 0, vc00, vc01); PG8_STAGEA(PG8_SA(0, 1), 0, vc10, vc11);
    if (wr == 1) PG8_BAR;
    PG8_WAIT_V(2); PG8_BAR;
    PG8_STAGEB(PG8_SB(1, 0), cB + kstep); PG8_STAGEA(PG8_SA(1, 0), kstep, vc00, vc01); PG8_STAGEB(PG8_SB(1, 1), cB + hstep + kstep);
    PG8_WAIT_V(6); PG8_BAR;
    for (;;) {
        const bool has_next = S.next(ui + 1, nxt);
        unsigned vn00 = vc00, vn01 = vc01, vn10 = vc10, vn11 = vc11;
        if (has_next) { vn00 = S.a_off(nxt, 0, RA[0], CA[0]); vn01 = S.a_off(nxt, 0, RA[1], CA[1]); vn10 = S.a_off(nxt, 1, RA[0], CA[0]); vn11 = S.a_off(nxt, 1, RA[1], CA[1]); }
        asm volatile("" : "+v"(vn00), "+v"(vn01), "+v"(vn10), "+v"(vn11));
        const char* nB = has_next ? S.b_ptr(nxt) : cB;
        for (int t = 0; t < nt; t += 2) {
            const bool last = (t == nt - 2);
            const size_t k1 = (size_t)(t + 1) * kstep;
            const size_t k2 = last ? 0 : (size_t)(t + 2) * kstep, k3 = k2 + kstep;
            const char* b2 = last ? nB : cB + (size_t)(t + 2) * kstep; const char* b3 = b2 + kstep;
            const unsigned s00 = last ? vn00 : vc00, s01 = last ? vn01 : vc01, s10 = last ? vn10 : vc10, s11 = last ? vn11 : vc11;
            PG8_LDB(B0, 0, 0); PG8_LDB(B1, 0, 1); PG8_SCHED; PG8_LDA(At, 0, 0); PG8_STAGEA(PG8_SA(1, 1), k1, vc10, vc11);
            PG8_WAIT_V(8); PG8_WAIT_L(0); PG8_BAR; PG8_MMA(0, 0, At, B0); PG8_MMA(0, 1, At, B1); PG8_BAR; PG8_SCHED;
            PG8_LDA(At, 0, 1); PG8_STAGEB(PG8_SB(0, 0), b2); PG8_STAGEB(PG8_SB(0, 1), b2 + hstep); PG8_STAGEA(PG8_SA(0, 0), k2, s00, s01);
            PG8_WAIT_V(8); PG8_WAIT_L(0); PG8_BAR; PG8_MMA(1, 0, At, B0); PG8_MMA(1, 1, At, B1); PG8_BAR; PG8_SCHED;
            PG8_LDB(B0, 1, 0); PG8_LDB(B1, 1, 1); PG8_SCHED; PG8_LDA(At, 1, 0); PG8_STAGEA(PG8_SA(0, 1), k2, s10, s11);
            PG8_WAIT_V(8); PG8_WAIT_L(0); PG8_BAR; PG8_MMA(0, 0, At, B0); PG8_MMA(0, 1, At, B1); PG8_BAR; PG8_SCHED;
            PG8_LDA(At, 1, 1); PG8_STAGEB(PG8_SB(1, 0), b3); PG8_STAGEB(PG8_SB(1, 1), b3 + hstep); PG8_STAGEA(PG8_SA(1, 0), k3, s00, s01);
            PG8_WAIT_V(8); PG8_WAIT_L(0); PG8_BAR; PG8_MMA(1, 0, At, B0); PG8_MMA(1, 1, At, B1); PG8_BAR; PG8_SCHED;
        }
        if (wr == 0) PG8_BAR;
        if constexpr (TIME) { const unsigned long long t0_ = __builtin_amdgcn_s_memrealtime(); E(acc, cur, wr, wc, fr, fq); asm volatile("s_waitcnt vmcnt(0)" ::: "memory"); *tacc += __builtin_amdgcn_s_memrealtime() - t0_; }
        else E(acc, cur, wr, wc, fr, fq);
        if (!has_next) break;
#pragma unroll
        for (int a = 0; a < 2; ++a)
#pragma unroll
            for (int b = 0; b < 2; ++b)
#pragma unroll
                for (int m = 0; m < 4; ++m)
#pragma unroll
                    for (int n = 0; n < 2; ++n) acc[a][b][m][n] = (f32x4){0.f, 0.f, 0.f, 0.f};
        cur = nxt; cB = nB; vc00 = vn00; vc01 = vn01; vc10 = vn10; vc11 = vn11; ++ui;
        if (wr == 1) PG8_BAR;
    }
    PG8_WAIT_V(0);
    PG8_BAR;
#undef PG8_SA
#undef PG8_SB
#undef PG8_STAGEA
#undef PG8_STAGEB
#undef PG8_LDA
#undef PG8_LDB
#undef PG8_MMA
#undef PG8_WAIT_V
#undef PG8_WAIT_L
#undef PG8_BAR
#undef PG8_SCHED
}

struct EpiInProj {
    static constexpr bool PERM = true;
    bf16_t *Q, *Kb, *V, *U, *QM; unsigned* nrm;
    __device__ __forceinline__ void operator()(const f32x4 (&acc)[2][2][4][2], const Unit& u, int wr, int wc, int fr, int fq) const {
        bf16_t* base; int ldc, colt; float sc = 1.f; const int pn = u.pn;
        float nmax[2] = {0.f, 0.f};
        if (pn < 2) { base = Q; ldc = 512; colt = pn * 256; sc = C2; } else if (pn < 4) { base = Kb; ldc = 512; colt = (pn - 2) * 256; } else if (pn < 6) { base = V; ldc = 512; colt = (pn - 4) * 256; }
        else if (pn == 6) { base = U; ldc = 256; colt = 0; } else { base = QM; ldc = 256; colt = 0; sc = C2; }
        const int row0 = u.pm * BM + wr * 64 + fr, col0 = colt + wc * 32 + 8 * fq;
#pragma unroll
        for (int ai = 0; ai < 2; ++ai)
#pragma unroll
            for (int m = 0; m < 4; ++m) { bf16_t* rowp = base + (size_t)(row0 + ai * HALF + m * 16) * ldc + col0;
#pragma unroll
                for (int bj = 0; bj < 2; ++bj) { const f32x4 v0 = acc[ai][bj][m][0] * sc, v1 = acc[ai][bj][m][1] * sc;
                    u32x4 w; w.x = cvt_pk_bf16(v0[0], v0[1]); w.y = cvt_pk_bf16(v0[2], v0[3]); w.z = cvt_pk_bf16(v1[0], v1[1]); w.w = cvt_pk_bf16(v1[2], v1[3]);
                    *(u32x4*)(rowp + bj * HALF) = w;
                    if (pn < 4) { float q = (v0[0] * v0[0] + v0[1] * v0[1]) + (v0[2] * v0[2] + v0[3] * v0[3]) + (v1[0] * v1[0] + v1[1] * v1[1]) + (v1[2] * v1[2] + v1[3] * v1[3]);
                        q += __shfl_xor(q, 16); q += __shfl_xor(q, 32); nmax[bj] = fmaxf(nmax[bj], q); } } }
        if (pn < 4) {
#pragma unroll
            for (int bj = 0; bj < 2; ++bj) { float q = nmax[bj];
#pragma unroll
                for (int o = 1; o < 16; o <<= 1) q = fmaxf(q, __shfl_xor(q, o));
                if (fr == 0 && fq == 0) { const int b = (u.pm * BM) / SEQ, h = (pn & 1) * 4 + 2 * bj + (wc >> 1), kind = pn >> 1;
                    atomicMax(nrm + ((b * 8 + h) * 2 + kind) * 2 + (wc & 1), __float_as_uint(q)); } }
        }
    }
};
struct EpiBf16 {
    static constexpr bool PERM = true;
    bf16_t* O; int ldc;
    __device__ __forceinline__ void operator()(const f32x4 (&acc)[2][2][4][2], const Unit& u, int wr, int wc, int fr, int fq) const {
        const int row0 = u.pm * BM + wr * 64 + fr, col0 = u.pn * BM + wc * 32 + 8 * fq;
#pragma unroll
        for (int ai = 0; ai < 2; ++ai)
#pragma unroll
            for (int m = 0; m < 4; ++m) { bf16_t* rowp = O + (size_t)(row0 + ai * HALF + m * 16) * ldc + col0;
#pragma unroll
                for (int bj = 0; bj < 2; ++bj) { const f32x4 v0 = acc[ai][bj][m][0], v1 = acc[ai][bj][m][1];
                    u32x4 w; w.x = cvt_pk_bf16(v0[0], v0[1]); w.y = cvt_pk_bf16(v0[2], v0[3]); w.z = cvt_pk_bf16(v1[0], v1[1]); w.w = cvt_pk_bf16(v1[2], v1[3]);
                    *(u32x4*)(rowp + bj * HALF) = w; } }
    }
};
struct EpiRes16 {
    static constexpr bool PERM = true;
    bf16_t* O; const float* R; float rs;
    __device__ __forceinline__ void operator()(const f32x4 (&acc)[2][2][4][2], const Unit& u, int wr, int wc, int fr, int fq) const {
        const int row0 = u.pm * BM + wr * 64 + fr, col0 = u.pn * BM + wc * 32 + 8 * fq;
#pragma unroll
        for (int ai = 0; ai < 2; ++ai)
#pragma unroll
            for (int m = 0; m < 4; ++m) { const size_t row = (size_t)(row0 + ai * HALF + m * 16);
#pragma unroll
                for (int bj = 0; bj < 2; ++bj) { const float* rp = R + row * DM + col0 + bj * HALF;
                    const f32x4 v0 = acc[ai][bj][m][0] + *(const f32x4*)rp * rs, v1 = acc[ai][bj][m][1] + *(const f32x4*)(rp + 4) * rs;
                    u32x4 w; w.x = cvt_pk_bf16(v0[0], v0[1]); w.y = cvt_pk_bf16(v0[2], v0[3]); w.z = cvt_pk_bf16(v1[0], v1[1]); w.w = cvt_pk_bf16(v1[2], v1[3]);
                    *(u32x4*)(O + row * (2 * DM) + col0 + bj * HALF) = w; }
                if (m & 1) asm volatile("" ::: "memory"); }
    }
};
struct EpiF32 {
    static constexpr bool PERM = false;
    float* C; int ldc; const float* R; float rs;
    __device__ __forceinline__ void operator()(const f32x4 (&acc)[2][2][4][2], const Unit& u, int wr, int wc, int fr, int fq) const {
        const int row0 = u.pm * BM + wr * 64 + fr, col0 = u.pn * BM + wc * 32 + 4 * fq;
#pragma unroll
        for (int ai = 0; ai < 2; ++ai)
#pragma unroll
            for (int m = 0; m < 4; ++m) { const size_t off = (size_t)(row0 + ai * HALF + m * 16) * ldc + col0;
#pragma unroll
                for (int bj = 0; bj < 2; ++bj)
#pragma unroll
                    for (int n = 0; n < 2; ++n) { f32x4 v = acc[ai][bj][m][n]; if (R) v += *(const f32x4*)(R + off + bj * HALF + n * 16) * rs; *(f32x4*)(C + off + bj * HALF + n * 16) = v; }
                if (m & 1) asm volatile("" ::: "memory"); }
    }
};
struct EpiGateUp {
    static constexpr bool PERM = true;
    bf16_t* H;
    __device__ __forceinline__ void operator()(const f32x4 (&acc)[2][2][4][2], const Unit& u, int wr, int wc, int fr, int fq) const {
        const int row0 = u.pm * BM + wr * 64 + fr, col0 = u.pn * 128 + wc * 32 + 8 * fq;
#pragma unroll
        for (int ai = 0; ai < 2; ++ai)
#pragma unroll
            for (int m = 0; m < 4; ++m) { bf16_t* rowp = H + (size_t)(row0 + ai * HALF + m * 16) * EH + col0; float hv[8];
#pragma unroll
                for (int n = 0; n < 2; ++n)
#pragma unroll
                    for (int j = 0; j < 4; ++j) { const float g = acc[ai][0][m][n][j], up = acc[ai][1][m][n][j]; hv[n * 4 + j] = g * __builtin_amdgcn_rcpf(1.f + __builtin_amdgcn_exp2f(-g * LOG2E)) * up; }
                u32x4 w; w.x = cvt_pk_bf16(hv[0], hv[1]); w.y = cvt_pk_bf16(hv[2], hv[3]); w.z = cvt_pk_bf16(hv[4], hv[5]); w.w = cvt_pk_bf16(hv[6], hv[7]);
                *(u32x4*)rowp = w; }
    }
};
struct EpiDown {
    static constexpr bool PERM = true;
    bf16_t* Y; float* SH; const int* bins; const float* gates;
    __device__ __forceinline__ void operator()(const f32x4 (&acc)[2][2][4][2], const Unit& u, int wr, int wc, int fr, int fq) const {
        const int col0 = u.pn * BM + wc * 32 + 8 * fq;
        if (u.e == NE) {
#pragma unroll
            for (int ai = 0; ai < 2; ++ai)
#pragma unroll
                for (int m = 0; m < 4; ++m) { const int tok = u.mt * 256 + ai * HALF + wr * 64 + m * 16 + fr; bf16_t* rowp = (bf16_t*)(SH + (size_t)tok * DM) + col0;
#pragma unroll
                    for (int bj = 0; bj < 2; ++bj) { const f32x4 v0 = acc[ai][bj][m][0], v1 = acc[ai][bj][m][1];
                        u32x4 w; w.x = cvt_pk_bf16(v0[0], v0[1]); w.y = cvt_pk_bf16(v0[2], v0[3]); w.z = cvt_pk_bf16(v1[0], v1[1]); w.w = cvt_pk_bf16(v1[2], v1[3]);
                        *(u32x4*)(rowp + bj * HALF) = w; } }
        } else {
            const int* bp = bins + (size_t)u.e * T + u.mt * 256;
            int av[8]; float gv[8];
#pragma unroll
            for (int i = 0; i < 8; ++i) { const int rl = (i >> 2) * HALF + wr * 64 + (i & 3) * 16 + fr; av[i] = bp[rl < u.rows ? rl : u.rows - 1]; }
#pragma unroll
            for (int i = 0; i < 8; ++i) gv[i] = gates[av[i]];
#pragma unroll
            for (int ai = 0; ai < 2; ++ai)
#pragma unroll
                for (int m = 0; m < 4; ++m) { const int rl = ai * HALF + wr * 64 + m * 16 + fr;
                    if (rl < u.rows) { const int a = av[ai * 4 + m]; const float g = gv[ai * 4 + m]; bf16_t* rowp = Y + (size_t)a * DM + col0;
#pragma unroll
                        for (int bj = 0; bj < 2; ++bj) { const f32x4 v0 = acc[ai][bj][m][0] * g, v1 = acc[ai][bj][m][1] * g;
                            u32x4 w; w.x = cvt_pk_bf16(v0[0], v0[1]); w.y = cvt_pk_bf16(v0[2], v0[3]); w.z = cvt_pk_bf16(v1[0], v1[1]); w.w = cvt_pk_bf16(v1[2], v1[3]);
                            *(u32x4*)(rowp + bj * HALF) = w; } } }
        }
    }
};
}

namespace att {
constexpr int SLOTB = 8192, L_K = 0, L_V = 2 * SLOTB, L_WS = 4 * SLOTB, L_OST = L_WS + 8 * 256, L_FK = L_OST + 8 * 4096, L_END = L_FK + 16384;
#define SBAR() __builtin_amdgcn_sched_barrier(0)
__device__ __forceinline__ int crow(int r, int hi) { return (r & 3) + 8 * (r >> 2) + 4 * hi; }
__device__ __forceinline__ void glds16(const void* gsrc, unsigned lds_dst) { unsigned keep;
    asm volatile("s_mov_b32 %0, m0\n\ts_mov_b32 m0, %2\n\ts_nop 0\n\tglobal_load_lds_dwordx4 %1, off\n\ts_mov_b32 m0, %0" : "=&s"(keep) : "v"(gsrc), "s"(lds_dst) : "memory"); }
__device__ __forceinline__ unsigned cvtpk(float lo, float hi) { unsigned r; asm("v_cvt_pk_bf16_f32 %0, %1, %2" : "=v"(r) : "v"(lo), "v"(hi)); return r; }
#define ATT_WAIT_BAR() asm volatile("s_waitcnt vmcnt(0) lgkmcnt(0)\n\ts_barrier" ::: "memory")

struct Job { const bf16_t* Q; int qpitch; const bf16_t* K; const bf16_t* V; int kvpitch; bf16_t* O; int nt; int causal; const float* FC; int q0; float qk2; };
constexpr float SKIP_LOG2 = 36.f;

template <bool FOX> __device__ __forceinline__ void unit(const Job& j, LAS unsigned char* shm) {
    const int tid = threadIdx.x, lane = tid & 63, r32 = lane & 31, hi = lane >> 5; const int wid = __builtin_amdgcn_readfirstlane(tid >> 6);
    const unsigned lds0 = (unsigned)(uintptr_t)shm;
    LAS float* wsf = (LAS float*)(shm + L_WS) + wid * 64;
    LAS float* fk = (LAS float*)(shm + L_FK);
    const int NT = j.nt;
    float fq = 0.f; int tlo = 0;
    if (FOX) {
        const float fq0 = j.FC[j.q0];
        const bool keep = (lane < NT) ? (j.qk2 + fq0 - j.FC[64 * lane + 63] >= -SKIP_LOG2) : false;
        const unsigned long long mk = __ballot(keep);
        tlo = (mk != 0ull) ? (int)__builtin_ctzll(mk) : NT - 1; tlo = __builtin_amdgcn_readfirstlane(tlo);
        for (int i = tlo * 16 + tid; i < NT * 16; i += 512) *(LAS f32x4*)(fk + 4 * i) = *(const f32x4*)(j.FC + 4 * i);
        fq = j.FC[j.q0 + wid * 32 + r32];
    }
    const int NTE = NT - tlo;
    const bf16_t* ksrc = j.K + (size_t)lane * j.kvpitch + wid * 8;
    const bf16_t* vsrc = j.V + (size_t)(16 * (wid & 3) + (lane >> 2)) * j.kvpitch + (wid >> 2) * 32 + (lane & 3) * 8;
    const unsigned kdst = lds0 + L_K + wid * 1024, vdst = lds0 + L_V + wid * 1024;
#define DMA_K(t, slot) glds16(ksrc + (size_t)(t) * 64 * j.kvpitch, (unsigned)__builtin_amdgcn_readfirstlane(kdst + (slot) * SLOTB))
#define DMA_V(t, slot) glds16(vsrc + (size_t)(t) * 64 * j.kvpitch, (unsigned)__builtin_amdgcn_readfirstlane(vdst + (slot) * SLOTB))
    const bf16_t* Qw = j.Q + (size_t)(wid * 32) * j.qpitch;
    bf16x8 qr[4];
#pragma unroll
    for (int d0 = 0; d0 < 4; ++d0) qr[d0] = *reinterpret_cast<const bf16x8*>(Qw + (size_t)r32 * j.qpitch + d0 * 16 + hi * 8);
    asm volatile("s_waitcnt vmcnt(0) lgkmcnt(0)" ::: "memory");
    { const int t0 = FOX ? NT - 1 : 0; DMA_K(t0, 0); DMA_V(t0, 0); }
    float mrun = -1e30f, l_reg = 0.f; f32x16 o[2]; o[0] = f32x16{}; o[1] = f32x16{};
    const int qrel = wid * 32 + r32;
    for (int it = 0; it < NTE; ++it) {
        const int tcur = FOX ? NT - 1 - it : it, slot = it & 1;
        ATT_WAIT_BAR();
        if (it + 1 < NTE) { const int tn = FOX ? tcur - 1 : tcur + 1; DMA_K(tn, slot ^ 1); DMA_V(tn, slot ^ 1); }
        f32x16 p0, p1;
        if (FOX) {
#pragma unroll
            for (int g = 0; g < 4; ++g) { const f32x4 a = *(const LAS f32x4*)(fk + 64 * tcur + 8 * g + 4 * hi), b = *(const LAS f32x4*)(fk + 64 * tcur + 32 + 8 * g + 4 * hi);
#pragma unroll
                for (int i = 0; i < 4; ++i) { p0[4 * g + i] = fq - a[i]; p1[4 * g + i] = fq - b[i]; } }
        } else { p0 = f32x16{}; p1 = f32x16{}; }
        { const LAS unsigned char* kb = shm + L_K + slot * SLOTB + hi * 1024 + r32 * 16;
#pragma unroll
          for (int d0 = 0; d0 < 4; ++d0) { const bf16x8 b0 = *(const LAS bf16x8*)(kb + d0 * 2048), b1 = *(const LAS bf16x8*)(kb + d0 * 2048 + 512);
              p0 = __builtin_amdgcn_mfma_f32_32x32x16_bf16(b0, qr[d0], p0, 0, 0, 0); p1 = __builtin_amdgcn_mfma_f32_32x32x16_bf16(b1, qr[d0], p1, 0, 0, 0); } }
        if (j.causal && tcur >= NT - 4) { const int kb0 = 64 * (tcur - (NT - 4)) + 4 * hi;
#pragma unroll
            for (int r = 0; r < 16; ++r) { const int kv = kb0 + (r & 3) + 8 * (r >> 2); if (kv > qrel) p0[r] = -INFINITY; if (kv + 32 > qrel) p1[r] = -INFINITY; } }
        float rm = p0[0];
#pragma unroll
        for (int r = 1; r < 16; ++r) rm = fmaxf(rm, p0[r]);
#pragma unroll
        for (int r = 0; r < 16; ++r) rm = fmaxf(rm, p1[r]);
        rm = fmaxf(rm, __shfl_xor(rm, 32));
        const float mn = fmaxf(mrun, rm), alpha = __builtin_amdgcn_exp2f(mrun - mn); mrun = mn;
        float rs = 0.f;
#pragma unroll
        for (int r = 0; r < 16; ++r) { p0[r] = __builtin_amdgcn_exp2f(p0[r] - mn); p1[r] = __builtin_amdgcn_exp2f(p1[r] - mn); rs += p0[r] + p1[r]; }
        l_reg = l_reg * alpha + rs;
        if (hi == 0) wsf[r32] = alpha;
        LDS_WAIT();
#pragma unroll
        for (int r = 0; r < 16; ++r) { const float f = wsf[crow(r, hi)]; o[0][r] *= f; o[1][r] *= f; }
        u32x4 pw0, pw1, pw2, pw3;
        pw0 = (u32x4){cvtpk(p0[0], p0[1]), cvtpk(p0[2], p0[3]), cvtpk(p0[4], p0[5]), cvtpk(p0[6], p0[7])};
        pw1 = (u32x4){cvtpk(p0[8], p0[9]), cvtpk(p0[10], p0[11]), cvtpk(p0[12], p0[13]), cvtpk(p0[14], p0[15])};
        pw2 = (u32x4){cvtpk(p1[0], p1[1]), cvtpk(p1[2], p1[3]), cvtpk(p1[4], p1[5]), cvtpk(p1[6], p1[7])};
        pw3 = (u32x4){cvtpk(p1[8], p1[9]), cvtpk(p1[10], p1[11]), cvtpk(p1[12], p1[13]), cvtpk(p1[14], p1[15])};
        const bf16x8 pa0 = __builtin_bit_cast(bf16x8, pw0), pa1 = __builtin_bit_cast(bf16x8, pw1), pa2 = __builtin_bit_cast(bf16x8, pw2), pa3 = __builtin_bit_cast(bf16x8, pw3);
        const int vb = (int)(lds0 + L_V + slot * SLOTB) + ((lane >> 4) & 1) * 32 + (lane & 3) * 8 + (4 * hi + ((lane & 15) >> 2)) * 64;
#pragma unroll
        for (int d0 = 0; d0 < 2; ++d0) { s16x4 lo[4], hh[4];
#pragma unroll
            for (int ks = 0; ks < 4; ++ks) {
                asm volatile("ds_read_b64_tr_b16 %0,%1 offset:%c2" : "=&v"(lo[ks]) : "v"(vb), "i"(d0 * 4096 + ks * 1024) : "memory");
                asm volatile("ds_read_b64_tr_b16 %0,%1 offset:%c2" : "=&v"(hh[ks]) : "v"(vb), "i"(d0 * 4096 + ks * 1024 + 512) : "memory"); }
            asm volatile("s_waitcnt lgkmcnt(0)" ::: "memory"); SBAR();
#define PK(k) (bf16x8){lo[k][0], lo[k][1], lo[k][2], lo[k][3], hh[k][0], hh[k][1], hh[k][2], hh[k][3]}
            o[d0] = __builtin_amdgcn_mfma_f32_32x32x16_bf16(pa0, PK(0), o[d0], 0, 0, 0);
            o[d0] = __builtin_amdgcn_mfma_f32_32x32x16_bf16(pa1, PK(1), o[d0], 0, 0, 0);
            o[d0] = __builtin_amdgcn_mfma_f32_32x32x16_bf16(pa2, PK(2), o[d0], 0, 0, 0);
            o[d0] = __builtin_amdgcn_mfma_f32_32x32x16_bf16(pa3, PK(3), o[d0], 0, 0, 0);
#undef PK
        }
    }
    l_reg += __shfl_xor(l_reg, 32);
    if (hi == 0) wsf[32 + r32] = l_reg;
    LDS_WAIT();
    float rli[16];
#pragma unroll
    for (int r = 0; r < 16; ++r) rli[r] = 1.0f / wsf[32 + crow(r, hi)];
    bf16_t* Ow = j.O + (size_t)(wid * 32) * DM;
    { LAS bf16_t* stg = (LAS bf16_t*)(shm + L_OST) + wid * 2048;
#pragma unroll
      for (int r = 0; r < 16; ++r) { const int orow = crow(r, hi);
#pragma unroll
          for (int d0 = 0; d0 < 2; ++d0) stg[orow * 64 + d0 * 32 + r32] = (bf16_t)f2bf(o[d0][r] * rli[r]); }
      LDS_WAIT();
#pragma unroll
      for (int i = 0; i < 4; ++i) { const int row = i * 8 + (lane >> 3), ch = lane & 7; const u32x4 v = *(const LAS u32x4*)(stg + row * 64 + ch * 8); *(u32x4*)(Ow + (size_t)row * DM + ch * 8) = v; } }
    asm volatile("s_waitcnt vmcnt(0) lgkmcnt(0)\n\ts_barrier" ::: "memory");
#undef DMA_K
#undef DMA_V
}
#undef SBAR
}

#define XB_TMO      128
#define XB_XCNT(j)  (256  + 64 * (j))
#define XB_XSUB(j)  (1280 + 64 * (j))
#define XB_XGEN(j)  (2304 + 64 * (j))
#define XB_TOP      3328
#define XB_TOPGEN   3392
#define XCD_BAR_WORDS 3456
#define XB_SPIN_CAP (1u << 18)
constexpr int CW_BAR = 32768;
__device__ __forceinline__ unsigned xb_ld(unsigned* p)              { return __hip_atomic_load(p, __ATOMIC_RELAXED, __HIP_MEMORY_SCOPE_AGENT); }
__device__ __forceinline__ unsigned xb_add(unsigned* p, unsigned v) { return __hip_atomic_fetch_add(p, v, __ATOMIC_RELAXED, __HIP_MEMORY_SCOPE_AGENT); }
__device__ __forceinline__ unsigned xb_xcc_id() { return (unsigned)__builtin_amdgcn_s_getreg((3 << 11) | 20) & 0xFu; }
#define XB_SPIN(cond, bar) do { unsigned _sp = 0; while (cond) { __builtin_amdgcn_s_sleep(1); \
    if ((++_sp & 255u) == 0u) { if (xb_ld(&(bar)[XB_TMO])) break; if (_sp > XB_SPIN_CAP) { atomicAdd(&(bar)[XB_TMO], 1u); break; } } } } while (0)
struct XcdBarrier { unsigned* bar; unsigned x; volatile LAS unsigned* st; };
__device__ __forceinline__ XcdBarrier xcd_barrier_post(unsigned* bar, volatile LAS unsigned* st) {
    XcdBarrier b; b.bar = bar; b.x = xb_xcc_id(); b.st = st;
    if (threadIdx.x == 0) (void)xb_add(&bar[XB_XCNT(b.x)], 1u);
    return b;
}
__device__ __forceinline__ void xcd_barrier_complete(unsigned* bar, unsigned x, unsigned& nloc, unsigned& nx) {
    const unsigned G = gridDim.x * gridDim.y * gridDim.z;
    unsigned sum, cnt, mine, sp = 0u;
    for (;;) {
        sum = 0u; cnt = 0u; mine = 0u;
#pragma unroll
        for (unsigned j = 0; j < 16; ++j) { const unsigned c = xb_ld(&bar[XB_XCNT(j)]); sum += c; cnt += (c > 0u) ? 1u : 0u; mine = (j == x) ? c : mine; }
        if (sum == G) break;
        __builtin_amdgcn_s_sleep(1);
        if ((++sp & 255u) == 0u) { if (xb_ld(&bar[XB_TMO])) break; if (sp > XB_SPIN_CAP) { atomicAdd(&bar[XB_TMO], 1u); break; } }
    }
    nloc = mine > 0u ? mine : 1u; nx = cnt > 0u ? cnt : 1u;
}
__device__ __forceinline__ void xcd_barrier(const XcdBarrier& b) {
    asm volatile("s_waitcnt vmcnt(0)" ::: "memory");
    __syncthreads();
    if (threadIdx.x == 0) {
        unsigned* bar = b.bar;
        __builtin_amdgcn_s_waitcnt(0);
        unsigned nloc = b.st[0], nx = b.st[1];
        if (nloc == 0u) { xcd_barrier_complete(bar, b.x, nloc, nx); b.st[0] = nloc; b.st[1] = nx; }
        const unsigned old = xb_add(&bar[XB_XSUB(b.x)], 1u);
        const unsigned gen = old / nloc;
        if (old + 1u == (gen + 1u) * nloc) {
            __builtin_amdgcn_fence(__ATOMIC_RELEASE, "agent");
            asm volatile("s_waitcnt vmcnt(0)" ::: "memory");
            const unsigned og = xb_add(&bar[XB_TOP], 1u);
            const unsigned tg = og / nx;
            if (og + 1u == (tg + 1u) * nx) xb_add(&bar[XB_TOPGEN], 1u);
            else XB_SPIN(xb_ld(&bar[XB_TOPGEN]) == tg, bar);
            __builtin_amdgcn_fence(__ATOMIC_ACQUIRE, "agent");
            xb_add(&bar[XB_XGEN(b.x)], 1u);
            asm volatile("s_waitcnt vmcnt(0)" ::: "memory");
        } else {
            XB_SPIN(xb_ld(&bar[XB_XGEN(b.x)]) == gen, bar);
            __builtin_amdgcn_fence(__ATOMIC_ACQUIRE, "agent");
            asm volatile("s_waitcnt vmcnt(0)" ::: "memory");
        }
    }
    __syncthreads();
}

struct Ctx { int tid, lane, wave, vcu, G; LAS unsigned char* lds; };

__device__ __forceinline__ unsigned cvtpk_hw(float lo, float hi) { unsigned r; asm volatile("v_cvt_pk_bf16_f32 %0, %1, %2" : "=v"(r) : "v"(lo), "v"(hi)); return r; }
__device__ __forceinline__ void tr_item64(const float* W, int ldw, bf16_t* WT, int ldt, LAS float* scr, int lane) {
    const int kr = lane >> 4, n4 = (lane & 15) * 4;
#pragma unroll
    for (int hb = 0; hb < 2; ++hb) { f32x4 v[8];
#pragma unroll
        for (int i = 0; i < 8; ++i) v[i] = __builtin_nontemporal_load((const f32x4*)(W + (size_t)(4 * (8 * hb + i) + kr) * ldw + n4));
#pragma unroll
        for (int i = 0; i < 8; ++i) { LAS float* p = scr + (4 * (8 * hb + i) + kr) * 65 + n4; p[0] = v[i].x; p[1] = v[i].y; p[2] = v[i].z; p[3] = v[i].w; } }
    LDS_WAIT(); asm volatile("" ::: "memory");
    const int kc = lane & 7;
#pragma unroll
    for (int j = 0; j < 8; ++j) { const int n = (lane >> 3) + 8 * j; const LAS float* s = scr + (8 * kc) * 65 + n;
        u32x4 o; o.x = cvtpk_hw(s[0 * 65], s[1 * 65]); o.y = cvtpk_hw(s[2 * 65], s[3 * 65]); o.z = cvtpk_hw(s[4 * 65], s[5 * 65]); o.w = cvtpk_hw(s[6 * 65], s[7 * 65]);
        *(u32x4*)(WT + (size_t)n * ldt + 8 * kc) = o; }
    LDS_WAIT(); asm volatile("" ::: "memory");
}

__device__ __forceinline__ void p0_prologue(const Args& a, const Ctx& c) {
    unsigned char* ws = a.ws;
    bf16_t* WGU = (bf16_t*)(ws + WS_WGU); bf16_t* WD = (bf16_t*)(ws + WS_WD); bf16_t* WIN = (bf16_t*)(ws + WS_WIN); bf16_t* WMKV = (bf16_t*)(ws + WS_WMKV);
    bf16_t* WOUT = (bf16_t*)(ws + WS_WOUT); bf16_t* WR = (bf16_t*)(ws + WS_WR);
    LAS float* WfT = (LAS float*)c.lds;
    LAS float* scr = (LAS float*)(c.lds + c.wave * 16640);
    const int gw = c.vcu * 8 + c.wave, NGW = c.G * 8;
    constexpr int NEXP_ITEMS = (NE + 1) * 192;
    constexpr int I_WIN = 512, I_MKV = 128, I_OUT = 192, I_R = 64;
    constexpr int NITEMS = NEXP_ITEMS + I_WIN + I_MKV + I_OUT + I_R;
    for (int it = gw; it < NITEMS; it += NGW) {
        int r = it;
        if (r < NEXP_ITEMS) { const int e = r / 192; r -= e * 192;
            if (r < 128) { const int up = r >> 6; r &= 63; const int kb = r >> 2, nb = r & 3, n0 = nb * 64;
                const float* src = (e < NE) ? ((up ? a.w_up : a.w_gate) + (size_t)e * DM * EH) : (up ? a.ws_up : a.ws_gate);
                const int drow = (n0 >> 7) * 256 + up * 128 + (n0 & 127);
                tr_item64(src + (size_t)kb * 64 * EH + n0, EH, WGU + ((size_t)e * 512 + drow) * DM + kb * 64, DM, scr, c.lane);
            } else { r -= 128; const int kb = r >> 4, nb = r & 15;
                const float* src = (e < NE) ? (a.w_down + (size_t)e * EH * DM) : a.ws_down;
                tr_item64(src + (size_t)kb * 64 * DM + nb * 64, DM, WD + ((size_t)e * DM + nb * 64) * EH + kb * 64, EH, scr, c.lane); }
            continue; }
        r -= NEXP_ITEMS;
        if (r < I_WIN) {
            int col0, drow0, nbw;
            if (r < 128) { col0 = 256; drow0 = 0; nbw = 8; } else if (r < 256) { r -= 128; col0 = 768; drow0 = 512; nbw = 8; } else if (r < 384) { r -= 256; col0 = 1280; drow0 = 1024; nbw = 8; }
            else if (r < 448) { r -= 384; col0 = 0; drow0 = 1536; nbw = 4; } else { r -= 448; col0 = 1800; drow0 = 1792; nbw = 4; }
            const int kb = r / nbw, nb = r % nbw;
            tr_item64(a.w_in + (size_t)kb * 64 * INC + col0 + nb * 64, INC, WIN + (size_t)(drow0 + nb * 64) * DM + kb * 64, DM, scr, c.lane);
            continue; }
        r -= I_WIN;
        if (r < I_MKV) { const int kb = r >> 3, nb = r & 7; tr_item64(a.w_mem_kv + (size_t)kb * 64 * 512 + nb * 64, 512, WMKV + (size_t)(nb * 64) * DM + kb * 64, DM, scr, c.lane); continue; }
        r -= I_MKV;
        if (r < I_OUT) { const int kb = r >> 4, nb = r & 15; tr_item64(a.w_out + (size_t)(256 + kb * 64) * DM + nb * 64, DM, WOUT + (size_t)(nb * 64) * DM + 256 + kb * 64, DM, scr, c.lane); continue; }
        r -= I_OUT;
        { const int kb = r >> 2, nb = r & 3; tr_item64(a.w_router + (size_t)kb * 64 * NE + nb * 64, NE, WR + (size_t)(nb * 64) * DM + kb * 64, DM, scr, c.lane); }
    }
    __syncthreads();
    for (int idx = c.tid; idx < 8192; idx += 512) { const int h = idx & 7, k = idx >> 3; WfT[h * 1024 + k] = a.w_in[(size_t)k * INC + 1792 + h]; }
    for (int idx = (c.vcu * 512 + c.tid); idx < 256 * 1024; idx += c.G * 512) { const int k = idx >> 10, n = idx & 1023, g = k >> 6, cc = k & 63; float s = 0.f;
        for (int d = 0; d < 64; ++d) s += a.w_pool[g * 4096 + cc * 64 + d] * a.pool_scale[g * 64 + d] * a.w_out[(size_t)(g * 64 + d) * DM + n];
        WOUT[(size_t)n * DM + k] = (bf16_t)f2bf(s); }
    __syncthreads();
    bf16_t* XB = (bf16_t*)(ws + WS_XB); float* FLOG = (float*)(ws + WS_FLOG);
    for (int m = gw; m < T; m += NGW) {
        const f32x4* xr = (const f32x4*)(a.x + (size_t)m * DM) + c.lane; f32x4 v[4];
#pragma unroll
        for (int j = 0; j < 4; ++j) v[j] = xr[64 * j];
        u32x2* o8 = (u32x2*)(XB + (size_t)m * DM) + c.lane;
#pragma unroll
        for (int j = 0; j < 4; ++j) o8[64 * j] = (u32x2){pk2(v[j].x, v[j].y), pk2(v[j].z, v[j].w)};
        float acc[8];
#pragma unroll
        for (int h = 0; h < 8; ++h) { float s = 0.f;
#pragma unroll
            for (int j = 0; j < 4; ++j) { const f32x4 w = *(const LAS f32x4*)(WfT + h * 1024 + 4 * c.lane + 256 * j); s += (v[j].x * w.x + v[j].y * w.y) + (v[j].z * w.z + v[j].w * w.w); }
            acc[h] = s; }
        float b4[4], b2[2], z;
        { const bool up = (c.lane & 32) != 0;
#pragma unroll
          for (int i = 0; i < 4; ++i) { const float keep = up ? acc[4 + i] : acc[i], give = up ? acc[i] : acc[4 + i]; b4[i] = keep + __shfl_xor(give, 32); } }
        { const bool up = (c.lane & 16) != 0;
#pragma unroll
          for (int i = 0; i < 2; ++i) { const float keep = up ? b4[2 + i] : b4[i], give = up ? b4[i] : b4[2 + i]; b2[i] = keep + __shfl_xor(give, 16); } }
        { const bool up = (c.lane & 8) != 0; const float keep = up ? b2[1] : b2[0], give = up ? b2[0] : b2[1]; z = keep + __shfl_xor(give, 8); }
        z += __shfl_xor(z, 4); z += __shfl_xor(z, 2); z += __shfl_xor(z, 1);
        if ((c.lane & 7) == 0) { const int h = ((c.lane >> 5) & 1) * 4 + ((c.lane >> 4) & 1) * 2 + ((c.lane >> 3) & 1); z += a.b_f[h];
            const float lf = (z >= 0.f) ? -log1pf(expf(-z)) : (z - log1pf(expf(z))); FLOG[(size_t)m * 8 + h] = lf; }
    }
    bf16_t* MEMB = (bf16_t*)(ws + WS_MEMB);
    for (int m = gw; m < NB * 256; m += NGW) {
        const f32x4* xr = (const f32x4*)(a.mem + (size_t)m * DM) + c.lane; u32x2* o8 = (u32x2*)(MEMB + (size_t)m * DM) + c.lane;
#pragma unroll
        for (int j = 0; j < 4; ++j) { const f32x4 v = xr[64 * j]; o8[64 * j] = (u32x2){pk2(v.x, v.y), pk2(v.z, v.w)}; }
    }
}

__device__ __forceinline__ void p1_fscan(const Args& a, const Ctx& c) {
    if (c.vcu >= 64) return;
    const float* FLOG = (const float*)(a.ws + WS_FLOG); float* FC = (float*)(a.ws + WS_FC);
    LAS float* wtot = (LAS float*)c.lds;
    const int bh = c.vcu, b = bh >> 3, h = bh & 7; float p[8]; float run = 0.f;
#pragma unroll
    for (int i = 0; i < 8; ++i) { run += FLOG[((size_t)b * SEQ + c.tid * 8 + i) * 8 + h]; p[i] = run; }
    float inc = run;
#pragma unroll
    for (int o = 1; o < 64; o <<= 1) { const float t = __shfl_up(inc, o); if (c.lane >= o) inc += t; }
    if (c.lane == 63) wtot[c.wave] = inc;
    __syncthreads();
    float base = inc - run;
    for (int w = 0; w < c.wave; ++w) base += wtot[w];
#pragma unroll
    for (int i = 0; i < 8; ++i) FC[(size_t)bh * SEQ + c.tid * 8 + i] = (base + p[i]) * LOG2E;
    __syncthreads();
}

__device__ __forceinline__ void p2_mixers(const Args& a, const Ctx& c) {
    unsigned char* ws = a.ws;
    const bf16_t* Q = (const bf16_t*)(ws + WS_Q); const bf16_t* Kb = (const bf16_t*)(ws + WS_K); const bf16_t* V = (const bf16_t*)(ws + WS_V); const bf16_t* QM = (const bf16_t*)(ws + WS_QM);
    const bf16_t* U = (const bf16_t*)(ws + WS_U); const bf16_t* KVM = (const bf16_t*)(ws + WS_KVM); bf16_t* YMIX = (bf16_t*)(ws + WS_YMIX); const float* FC = (const float*)(ws + WS_FC);
    { const int cp = c.tid & 127, rg = c.tid >> 7, ch = 2 * cp, w = 2 << (ch >> 6);
      for (int i = 0; i < 32; ++i) { const int t = c.vcu * 128 + rg * 32 + i; if (t >= T) break; const int pos = t & (SEQ - 1), cnt = (pos + 1 < w) ? pos + 1 : w;
          float s0 = 0.f, s1 = 0.f, u0 = 0.f, u1 = 0.f;
          for (int jw = 0; jw < cnt; ++jw) { const unsigned wv = *(const unsigned*)(U + (size_t)(t - jw) * 256 + ch); const float x0 = bflo(wv), x1 = bfhi(wv); s0 += x0; s1 += x1; if (jw == 0) { u0 = x0; u1 = x1; } }
          const float inv = 1.0f / (float)cnt;
          *(unsigned*)(YMIX + (size_t)t * DM + ch) = pk2(s0 * inv - u0, s1 * inv - u1); } }
    __syncthreads();
    { const int s = c.vcu >> 6, r = c.vcu & 63; const float* nrm = (const float*)(ws + WS_CTL) + CW_NRM;
      for (int i = 0; i < 4; ++i) { const int qb = (i == 0) ? s : (i == 1) ? 15 - s : (i == 2) ? 7 - s : 8 + s; const int bh = (r + 17 * i) & 63, b = bh >> 3, h = bh & 7;
          att::Job j; const size_t row0 = (size_t)b * SEQ;
          { const float q2 = nrm[bh * 4 + 0] + nrm[bh * 4 + 1], k2 = nrm[bh * 4 + 2] + nrm[bh * 4 + 3]; j.qk2 = 2.02f * sqrtf(q2 * k2); }
          j.Q = Q + (row0 + qb * 256) * 512 + h * 64; j.qpitch = 512; j.K = Kb + row0 * 512 + h * 64; j.V = V + row0 * 512 + h * 64; j.kvpitch = 512;
          j.O = YMIX + (row0 + qb * 256) * DM + 256 + h * 64; j.nt = 4 * qb + 4; j.causal = 1; j.FC = FC + (size_t)bh * SEQ; j.q0 = qb * 256;
          att::unit<true>(j, c.lds); } }
    for (int i = 0; i < 2; ++i) { const int mu = c.vcu * 2 + i, b = mu >> 6, hm = (mu >> 4) & 3, qb = mu & 15;
        att::Job j; const size_t row0 = (size_t)b * SEQ + qb * 256;
        j.Q = QM + row0 * 256 + hm * 64; j.qpitch = 256; j.K = KVM + (size_t)b * 256 * 512 + hm * 64; j.V = KVM + (size_t)b * 256 * 512 + 256 + hm * 64; j.kvpitch = 512;
        j.O = YMIX + row0 * DM + 768 + hm * 64; j.nt = 4; j.causal = 0; j.FC = nullptr; j.q0 = 0; j.qk2 = 0.f;
        att::unit<false>(j, c.lds); }
}

__device__ __forceinline__ void p4_ln1(const Args& a, const Ctx& c) {
    bf16_t* X1B = (bf16_t*)(a.ws + WS_X1B); const int gw = c.vcu * 8 + c.wave, NGW = c.G * 8;
    f32x4 g4[4], b4[4];
#pragma unroll
    for (int j = 0; j < 4; ++j) { g4[j] = *((const f32x4*)a.ln1_g + c.lane + 64 * j); b4[j] = *((const f32x4*)a.ln1_b + c.lane + 64 * j); }
    for (int m = gw; m < T; m += NGW) {
        const u32x2* xr = (const u32x2*)(a.out + (size_t)m * DM) + c.lane; f32x4 v[4]; float s = 0.f;
#pragma unroll
        for (int j = 0; j < 4; ++j) { const u32x2 hw = xr[64 * j]; v[j] = (f32x4){bflo(hw.x), bfhi(hw.x), bflo(hw.y), bfhi(hw.y)}; s += (v[j].x + v[j].y) + (v[j].z + v[j].w); }
        const float mean = wave_sum(s) * (1.f / DM); float s2 = 0.f;
#pragma unroll
        for (int j = 0; j < 4; ++j) { v[j] = v[j] - mean; s2 += (v[j].x * v[j].x + v[j].y * v[j].y) + (v[j].z * v[j].z + v[j].w * v[j].w); }
        const float rstd = 1.f / sqrtf(wave_sum(s2) * (1.f / DM) + LN_EPS);
        u32x2* o8 = (u32x2*)(X1B + (size_t)m * DM) + c.lane;
#pragma unroll
        for (int j = 0; j < 4; ++j) { const f32x4 y = v[j] * rstd * g4[j] + b4[j]; o8[64 * j] = (u32x2){pk2(y.x, y.y), pk2(y.z, y.w)}; }
    }
}

__device__ __forceinline__ float wave_max_f(float v) {
    int x = __float_as_int(v);  v = fmaxf(v, __int_as_float(__builtin_amdgcn_update_dpp(x, x, 0x121, 0xf, 0xf, false)));
    x = __float_as_int(v);      v = fmaxf(v, __int_as_float(__builtin_amdgcn_update_dpp(x, x, 0x122, 0xf, 0xf, false)));
    x = __float_as_int(v);      v = fmaxf(v, __int_as_float(__builtin_amdgcn_update_dpp(x, x, 0x124, 0xf, 0xf, false)));
    x = __float_as_int(v);      v = fmaxf(v, __int_as_float(__builtin_amdgcn_update_dpp(x, x, 0x128, 0xf, 0xf, false)));
    x = __float_as_int(v);
    const float a = __int_as_float(__builtin_amdgcn_readlane(x, 0)), b = __int_as_float(__builtin_amdgcn_readlane(x, 16)), c = __int_as_float(__builtin_amdgcn_readlane(x, 32)), d = __int_as_float(__builtin_amdgcn_readlane(x, 48));
    return fmaxf(fmaxf(a, b), fmaxf(c, d));
}
#define CSWAP(va, ia, sa, vb, ib, sb) do { const bool sw_ = (vb > va) || (vb == va && ib < ia); const float tv_ = sw_ ? vb : va, tw_ = sw_ ? va : vb; const int ti_ = sw_ ? ib : ia, tj_ = sw_ ? ia : ib; \
    const float ts_ = sw_ ? sb : sa, tt_ = sw_ ? sa : sb; va = tv_; vb = tw_; ia = ti_; ib = tj_; sa = ts_; sb = tt_; } while (0)
__device__ __forceinline__ void p6_route(const Args& a, const Ctx& c) {
    const float* LOG = (const float*)(a.ws + WS_LOG); int* cnt = (int*)(a.ws + WS_CTL); int* bins = (int*)(a.ws + WS_BINS); float* gates = (float*)(a.ws + WS_GATES);
    LAS int* hist = (LAS int*)c.lds; LAS int* base = hist + 256; LAS unsigned short* asg_e = (LAS unsigned short*)(base + 256); LAS unsigned short* asg_r = asg_e + 1024;
    const int lane = c.lane;
    const f32x4 bs = *((const f32x4*)a.router_bias + lane);
    for (int chunk = c.vcu; chunk < T / 128; chunk += c.G) {
        __syncthreads();
        if (c.tid < 256) hist[c.tid] = 0;
        __syncthreads();
        for (int i = 0; i < 16; ++i) {
            const int lt = c.wave * 16 + i, tok = chunk * 128 + lt;
            const f32x4 lg = *((const f32x4*)(LOG + (size_t)tok * NE) + lane);
            float s0 = 1.f / (1.f + expf(-lg.x)), s1 = 1.f / (1.f + expf(-lg.y)), s2 = 1.f / (1.f + expf(-lg.z)), s3 = 1.f / (1.f + expf(-lg.w));
            float v0 = s0 + bs.x, v1 = s1 + bs.y, v2 = s2 + bs.z, v3 = s3 + bs.w;
            int i0 = 4 * lane, i1 = i0 + 1, i2 = i0 + 2, i3 = i0 + 3;
            CSWAP(v0, i0, s0, v1, i1, s1); CSWAP(v2, i2, s2, v3, i3, s3); CSWAP(v0, i0, s0, v2, i2, s2); CSWAP(v1, i1, s1, v3, i3, s3); CSWAP(v1, i1, s1, v2, i2, s2);
            float m1 = v0, m2 = v1;
#pragma unroll
            for (int o = 1; o < 8; o <<= 1) { const float o1 = __shfl_xor(m1, o), o2 = __shfl_xor(m2, o); const float n1 = fmaxf(m1, o1), n2 = fmaxf(fminf(m1, o1), fmaxf(m2, o2)); m1 = n1; m2 = n2; }
            const float gs = m1 + m2; const int g = lane >> 3; int rank = 0; const int gsx = __float_as_int(gs);
#pragma unroll
            for (int jg = 0; jg < 8; ++jg) { const float gj = __int_as_float(__builtin_amdgcn_readlane(gsx, 8 * jg)); rank += (gj > gs || (gj == gs && jg < g)) ? 1 : 0; }
            if (rank >= 4) { v0 = -INFINITY; v1 = -INFINITY; v2 = -INFINITY; v3 = -INFINITY; }
            int my_e = 0; float my_s = 0.f;
#pragma unroll
            for (int k = 0; k < TOPK; ++k) {
                const float m = wave_max_f(v0);
                const unsigned long long mk = __ballot(v0 == m);
                const int wl = (int)__builtin_ctzll(mk);
                const int ek = __builtin_amdgcn_readlane(i0, wl); const float sk = __int_as_float(__builtin_amdgcn_readlane(__float_as_int(s0), wl));
                if (lane == wl) { v0 = v1; i0 = i1; s0 = s1; v1 = v2; i1 = i2; s1 = s2; v2 = v3; i2 = i3; s2 = s3; v3 = -INFINITY; }
                if (lane == k) { my_e = ek; my_s = sk; }
            }
            float tot = (lane < 8) ? my_s : 0.f;
            tot += __shfl_xor(tot, 1); tot += __shfl_xor(tot, 2); tot += __shfl_xor(tot, 4);
            if (lane < 8) { const int lr = __hip_atomic_fetch_add(&hist[my_e], 1, __ATOMIC_RELAXED, __HIP_MEMORY_SCOPE_WORKGROUP); asg_e[lt * 8 + lane] = (unsigned short)my_e; asg_r[lt * 8 + lane] = (unsigned short)lr; gates[(size_t)tok * 8 + lane] = my_s / tot * 2.5f; }
        }
        __syncthreads();
        if (c.tid < 256) { const int n = hist[c.tid]; base[c.tid] = n ? atomicAdd(&cnt[c.tid * 64], n) : 0; }
        __syncthreads();
        for (int sl = c.tid; sl < 1024; sl += 512) { const int e = asg_e[sl]; bins[(size_t)e * T + base[e] + asg_r[sl]] = chunk * 1024 + sl; }
    }
    __syncthreads();
}
#undef CSWAP

__device__ __forceinline__ int build_tables(const Args& a, const Ctx& c) {
    const int* cnt = (const int*)(a.ws + WS_CTL);
    LAS unsigned short* te = (LAS unsigned short*)(c.lds + TE_OFF); LAS int* tb = (LAS int*)(c.lds + TB_OFF); LAS int* cn = (LAS int*)(c.lds + CN_OFF);
    __syncthreads();
    if (c.tid < NE) cn[c.tid] = __hip_atomic_load(cnt + c.tid * 64, __ATOMIC_RELAXED, __HIP_MEMORY_SCOPE_AGENT);
    __syncthreads();
    if (c.tid == 0) { int run = 0; for (int e = 0; e < NE; ++e) { tb[e] = run; run += (cn[e] + 255) >> 8; } tb[NE] = run; }
    __syncthreads();
    if (c.tid < NE) { const int n = (cn[c.tid] + 255) >> 8, b0 = tb[c.tid]; for (int jt = 0; jt < n; ++jt) te[b0 + jt] = (unsigned short)c.tid; }
    __syncthreads();
    return tb[NE];
}

__device__ __forceinline__ void p9_combine(const Args& a, const Ctx& c) {
    const bf16_t* X1B = (const bf16_t*)(a.ws + WS_X1B); const bf16_t* Y = (const bf16_t*)(a.ws + WS_Y); const int gw = c.vcu * 8 + c.wave, NGW = c.G * 8;
    f32x4 g4[4], b4[4];
#pragma unroll
    for (int j = 0; j < 4; ++j) { g4[j] = *((const f32x4*)a.ln2_g + c.lane + 64 * j); b4[j] = *((const f32x4*)a.ln2_b + c.lane + 64 * j); }
    for (int m = gw; m < T; m += NGW) {
        f32x4* orow = (f32x4*)(a.out + (size_t)m * DM) + c.lane; f32x4 v[4]; float s = 0.f;
        const u32x2* x8 = (const u32x2*)(X1B + (size_t)m * DM) + c.lane;
        const u32x2* s8 = (const u32x2*)(a.out + (size_t)m * DM) + c.lane;
#pragma unroll
        for (int j = 0; j < 4; ++j) { const u32x2 xw = x8[64 * j], sw = s8[64 * j]; v[j] = (f32x4){bflo(sw.x), bfhi(sw.x), bflo(sw.y), bfhi(sw.y)} + (f32x4){bflo(xw.x), bfhi(xw.x), bflo(xw.y), bfhi(xw.y)} * ALPHA; }
#pragma unroll
        for (int k = 0; k < TOPK; ++k) { const u32x2* y8 = (const u32x2*)(Y + ((size_t)m * TOPK + k) * DM) + c.lane;
#pragma unroll
            for (int j = 0; j < 4; ++j) { const u32x2 yw = y8[64 * j]; v[j] += (f32x4){bflo(yw.x), bfhi(yw.x), bflo(yw.y), bfhi(yw.y)}; } }
#pragma unroll
        for (int j = 0; j < 4; ++j) s += (v[j].x + v[j].y) + (v[j].z + v[j].w);
        const float mean = wave_sum(s) * (1.f / DM); float s2 = 0.f;
#pragma unroll
        for (int j = 0; j < 4; ++j) { v[j] = v[j] - mean; s2 += (v[j].x * v[j].x + v[j].y * v[j].y) + (v[j].z * v[j].z + v[j].w * v[j].w); }
        const float rstd = 1.f / sqrtf(wave_sum(s2) * (1.f / DM) + LN_EPS);
#pragma unroll
        for (int j = 0; j < 4; ++j) orow[64 * j] = v[j] * rstd * g4[j] + b4[j];
    }
}

constexpr int NPHASE = 10;

__global__ void __launch_bounds__(512, 2) mk_fwd(Args a) {
    extern __shared__ __attribute__((aligned(16))) unsigned char lds_raw[];
    cg::grid_group grid = cg::this_grid();
    Ctx c; c.lds = (LAS unsigned char*)lds_raw; c.tid = threadIdx.x; c.lane = c.tid & 63; c.wave = __builtin_amdgcn_readfirstlane(c.tid >> 6); c.G = gridDim.x;
    { const int bx = blockIdx.x; c.vcu = (c.G % 8 == 0) ? (bx % 8) * (c.G / 8) + bx / 8 : bx; }
    unsigned char* ws = a.ws; const int lo = a.ph_lo, hi = a.ph_hi;
#define IN(k) (lo <= (k) && (k) < hi)
    for (int u = c.tid; u < 32; u += 512) ((volatile LAS unsigned*)(c.lds + MISC_OFF))[u] = 0u;
    __syncthreads();
    XcdBarrier bar = xcd_barrier_post((unsigned*)(ws + WS_CTL) + CW_BAR + a.li * XCD_BAR_WORDS, (volatile LAS unsigned*)(c.lds + MISC_OFF) + 8);
    if (a.ph_lo < 0) grid.sync();
    unsigned long long pt_acc = 0ull;
#define PT_ON(id) (PROBE_T == (id))
#define SEAM(k) do { if (IN(k) && IN((k) + 1)) { if (PT_ON(10 + (k)) || PT_ON(30)) { const unsigned long long t0_ = __builtin_amdgcn_s_memrealtime(); xcd_barrier(bar); pt_acc += __builtin_amdgcn_s_memrealtime() - t0_; } else xcd_barrier(bar); } } while (0)
#define PH_BEGIN(k) unsigned long long pt0_##k = 0ull; if (PT_ON(k)) pt0_##k = __builtin_amdgcn_s_memrealtime();
#define PH_END(k) if (PT_ON(k)) { asm volatile("s_waitcnt vmcnt(0)" ::: "memory"); __syncthreads(); pt_acc += __builtin_amdgcn_s_memrealtime() - pt0_##k; }
    { PH_BEGIN(0) if (IN(0)) p0_prologue(a, c); PH_END(0) }
    SEAM(0);
    { PH_BEGIN(1) if (IN(1)) {
        p1_fscan(a, c);
        { pg8::DenseSched S; S.init(T, 2048, DM, c.G, (int)blockIdx.x, ws + WS_WIN);
          pg8::EpiInProj E{(bf16_t*)(ws + WS_Q), (bf16_t*)(ws + WS_K), (bf16_t*)(ws + WS_V), (bf16_t*)(ws + WS_U), (bf16_t*)(ws + WS_QM), (unsigned*)(ws + WS_CTL) + CW_NRM};
          pg8::gemm_phase(c.lds, (const char*)(ws + WS_XB), DM, S, E); }
        { pg8::DenseSched S; S.init(NB * 256, 512, DM, c.G, (int)blockIdx.x, ws + WS_WMKV);
          pg8::EpiBf16 E{(bf16_t*)(ws + WS_KVM), 512};
          pg8::gemm_phase(c.lds, (const char*)(ws + WS_MEMB), DM, S, E); }
    } PH_END(1) }
    SEAM(1);
    { PH_BEGIN(2) if (IN(2)) p2_mixers(a, c); PH_END(2) }
    SEAM(2);
    { PH_BEGIN(3) if (IN(3)) { pg8::DenseSched S; S.init(T, DM, DM, c.G, (int)blockIdx.x, ws + WS_WOUT);
        pg8::EpiRes16 E{(bf16_t*)a.out, a.x, ALPHA};
        pg8::gemm_phase<PT_ON(23)>(c.lds, (const char*)(ws + WS_YMIX), DM, S, E, &pt_acc); } PH_END(3) }
    SEAM(3);
    { PH_BEGIN(4) if (IN(4)) p4_ln1(a, c); PH_END(4) }
    SEAM(4);
    { PH_BEGIN(5) if (IN(5)) { pg8::DenseSched S; S.init(T, NE, DM, c.G, (int)blockIdx.x, ws + WS_WR);
        pg8::EpiF32 E{(float*)(ws + WS_LOG), NE, nullptr, 0.f};
        pg8::gemm_phase(c.lds, (const char*)(ws + WS_X1B), DM, S, E); } PH_END(5) }
    SEAM(5);
    { PH_BEGIN(6) if (IN(6)) p6_route(a, c); PH_END(6) }
    SEAM(6);
    { PH_BEGIN(7) if (IN(7)) { const int NTR = build_tables(a, c);
        pg8::GroupSched S; S.nunits = (NTR + 128) * 2; S.G = c.G; S.c = (int)blockIdx.x; S.shift = 1; S.NTR = NTR; S.mode = 0; S.K = DM;
        S.tile_e = (const LAS unsigned short*)(c.lds + TE_OFF); S.tbase = (const LAS int*)(c.lds + TB_OFF); S.cnt = (const LAS int*)(c.lds + CN_OFF);
        S.bins = (const int*)(ws + WS_BINS); S.Bt = (const char*)(ws + WS_WGU); S.estride = (size_t)512 * DM * 2;
        pg8::EpiGateUp E{(bf16_t*)(ws + WS_HB)};
        pg8::gemm_phase<PT_ON(27)>(c.lds, (const char*)(ws + WS_X1B), DM, S, E, &pt_acc); } PH_END(7) }
    SEAM(7);
    { PH_BEGIN(8) if (IN(8)) { const int NTR = build_tables(a, c);
        pg8::GroupSched S; S.nunits = (NTR + 128) * 4; S.G = c.G; S.c = (int)blockIdx.x; S.shift = 2; S.NTR = NTR; S.mode = 1; S.K = EH;
        S.tile_e = (const LAS unsigned short*)(c.lds + TE_OFF); S.tbase = (const LAS int*)(c.lds + TB_OFF); S.cnt = (const LAS int*)(c.lds + CN_OFF);
        S.bins = (const int*)(ws + WS_BINS); S.Bt = (const char*)(ws + WS_WD); S.estride = (size_t)DM * EH * 2;
        pg8::EpiDown E{(bf16_t*)(ws + WS_Y), a.out, (const int*)(ws + WS_BINS), (const float*)(ws + WS_GATES)};
        pg8::gemm_phase<PT_ON(28)>(c.lds, (const char*)(ws + WS_HB), EH, S, E, &pt_acc); } PH_END(8) }
    SEAM(8);
    { PH_BEGIN(9) if (IN(9)) p9_combine(a, c); PH_END(9) }
    if (PROBE_T >= 0) {
        unsigned* pw = (unsigned*)(ws + WS_CTL) + CW_PROBE;
        if (c.tid == 0) { if (PROBE_MODE == 0) atomicMax(pw, (unsigned)pt_acc); else atomicAdd(pw, (unsigned)pt_acc); }
        xcd_barrier(bar);
        if (blockIdx.x == 0 && c.tid == 0) { unsigned v = __hip_atomic_load(pw, __ATOMIC_RELAXED, __HIP_MEMORY_SCOPE_AGENT); if (PROBE_MODE == 1) v /= (unsigned)c.G;
            const unsigned long long t0 = __builtin_amdgcn_s_memrealtime(); while (__builtin_amdgcn_s_memrealtime() - t0 < (unsigned long long)v * PROBE_MULT) __builtin_amdgcn_s_sleep(8); }
    }
#undef IN
#undef SEAM
}

#ifndef MK_N_LAUNCHES
#define MK_N_LAUNCHES 1
#endif
extern "C" void kernel_launch(void* const* d_in, const int* in_sizes, int n_in, void* d_out, int out_size, void* d_ws, size_t ws_size, hipStream_t stream) {
    static int grid = 0;
    if (grid == 0) {
        if (n_in != 20 || out_size != T * DM || ws_size < WS_END) { fprintf(stderr, "kernel_launch: unexpected shapes (n_in %d out %d ws %zu)\n", n_in, out_size, ws_size); grid = -1; return; }
        int dev = 0, cus = 0, per_cu = 0;
        (void)hipGetDevice(&dev); (void)hipDeviceGetAttribute(&cus, hipDeviceAttributeMultiprocessorCount, dev);
        if (hipFuncSetAttribute((const void*)mk_fwd, hipFuncAttributeMaxDynamicSharedMemorySize, LDS_BYTES) != hipSuccess) { fprintf(stderr, "kernel_launch: hipFuncSetAttribute failed\n"); grid = -1; return; }
        (void)hipOccupancyMaxActiveBlocksPerMultiprocessor(&per_cu, (const void*)mk_fwd, 512, LDS_BYTES);
        if (per_cu < 1) { fprintf(stderr, "kernel_launch: occupancy query says %d blocks per CU\n", per_cu); grid = -1; return; }
        grid = cus;
        if (grid != 256) fprintf(stderr, "kernel_launch: %d CUs (built for 256)\n", grid);
    }
    if (grid < 0) return;
    (void)hipMemsetAsync((char*)d_ws + WS_CTL, 0, CTL_ZERO_BYTES, stream);
    Args a{};
    const float** p = (const float**)&a;
    for (int i = 0; i < 20; ++i) p[i] = (const float*)d_in[i];
    a.out = (float*)d_out; a.ws = (unsigned char*)d_ws;
    const int nl = MK_N_LAUNCHES;
    for (int li = 0; li < nl; ++li) {
        a.ph_lo = (nl == 1) ? 0 : li; a.ph_hi = (nl == 1) ? NPHASE : li + 1; a.li = li;
        void* args[] = {&a};
        const hipError_t e = hipLaunchCooperativeKernel((void*)mk_fwd, dim3(grid), dim3(512), args, LDS_BYTES, stream);
        if (e != hipSuccess) { fprintf(stderr, "kernel_launch: cooperative launch failed: %s\n", hipGetErrorString(e)); break; }
    }
}
```

```cpp
#include <hip/hip_runtime.h>
#include <hip/hip_cooperative_groups.h>
#include <cstdio>
#include <cstdint>
namespace cg = cooperative_groups;
#ifndef PROBE_T
#define PROBE_T -1
#endif
#ifndef PROBE_MODE
#define PROBE_MODE 0
#endif
#define PROBE_MULT 4
constexpr int CW_PROBE = 20000;
#define PT_BEGIN(id) unsigned long long ptb_##id = 0ull; if (PROBE_T == (id)) ptb_##id = __builtin_amdgcn_s_memrealtime();
#define PT_END(id, tacc) if (PROBE_T == (id)) { asm volatile("s_waitcnt vmcnt(0)" ::: "memory"); __syncthreads(); *(tacc) += __builtin_amdgcn_s_memrealtime() - ptb_##id; }

#define LAS __attribute__((address_space(3)))
typedef unsigned short bf16_t;
typedef short bf16x8 __attribute__((ext_vector_type(8)));
typedef short s16x4 __attribute__((ext_vector_type(4)));
typedef float f32x4 __attribute__((ext_vector_type(4)));
typedef float f32x2 __attribute__((ext_vector_type(2)));
typedef float f32x16 __attribute__((ext_vector_type(16)));
typedef unsigned u32x4 __attribute__((ext_vector_type(4)));
typedef unsigned u32x2 __attribute__((ext_vector_type(2)));

constexpr int NB = 8, SEQ = 4096, T = NB * SEQ, DM = 1024;
constexpr int INC = 2056;
constexpr int NE = 256, TOPK = 8, EH = 256;
constexpr float ALPHA = 1.189207115002721f;
constexpr float LN_EPS = 1e-5f;
constexpr float LOG2E = 1.4426950408889634f;
constexpr float C2 = 0.125f * LOG2E;
constexpr int MAXTILES = 1280 + 128;

constexpr size_t MiB = 1u << 20;
constexpr size_t WS_CTL = 0, WS_WD = 1 * MiB, WS_HB = 130 * MiB, WS_X1B = 306 * MiB, WS_BINS = 370 * MiB, WS_GATES = 402 * MiB, WS_FC = 403 * MiB, WS_FLOG = 404 * MiB,
                 WS_KVM = 405 * MiB, WS_Y = 408 * MiB, WS_WGU = 408 * MiB, WS_WIN = 665 * MiB, WS_WMKV = 669 * MiB, WS_WOUT = 670 * MiB, WS_WR = 672 * MiB, WS_MEMB = 673 * MiB,
                 WS_XB = 677 * MiB, WS_Q = 741 * MiB, WS_K = 773 * MiB, WS_V = 805 * MiB, WS_QM = 837 * MiB, WS_U = 853 * MiB, WS_YMIX = 869 * MiB, WS_LOG = 933 * MiB, WS_END = 965 * MiB;
constexpr size_t CTL_ZERO_BYTES = 1 * MiB;
constexpr int CW_NRM = 16384;

constexpr int RING_BYTES = 131072;
constexpr int TE_OFF = 131072, TB_OFF = 135168, CN_OFF = 137216, BG_OFF = 83968  , MISC_OFF = 155648, LDS_BYTES = 156672;

struct Args {
    const float *x, *mem, *w_in, *b_f, *w_pool, *pool_scale, *w_mem_kv, *w_out, *ln1_g, *ln1_b, *w_router, *router_bias, *w_gate, *w_up, *w_down, *ws_gate, *ws_up, *ws_down, *ln2_g, *ln2_b;
    float* out; unsigned char* ws; int ph_lo, ph_hi, li, pad;
};

__device__ __forceinline__ unsigned f2bf(float f) { unsigned u = __float_as_uint(f); return (u + 0x7fffu + ((u >> 16) & 1u)) >> 16; }
__device__ __forceinline__ unsigned pk2(float lo, float hi) { return f2bf(lo) | (f2bf(hi) << 16); }
__device__ __forceinline__ float bflo(unsigned w) { return __uint_as_float(w << 16); }
__device__ __forceinline__ float bfhi(unsigned w) { return __uint_as_float(w & 0xffff0000u); }
__device__ __forceinline__ float wave_sum(float v) {
#pragma unroll
    for (int o = 1; o < 64; o <<= 1) v += __shfl_xor(v, o);
    return v;
}
#define LDS_WAIT() asm volatile("s_waitcnt lgkmcnt(0)" ::: "memory")

namespace pg8 {
constexpr int BM = 256, BK = 64, HALF = 128, HTB = HALF * BK * 2, NXCD = 8, WGM = 8;
__device__ __forceinline__ int lds_byte(int r, int c) { const int st = (r >> 4) * 2 + (c >> 5), rr = r & 15, cc = c & 31, ob = rr * 64 + cc * 2; return st * 1024 + (ob ^ (((ob >> 9) & 1) << 5)); }
__device__ __forceinline__ void stage_rc(int b, int& R, int& C) { const int st = b / 1024, sb = b % 1024, swz = sb ^ (((sb >> 9) & 1) << 5); R = (st >> 1) * 16 + swz / 64; C = (st & 1) * 32 + (swz % 64) / 2; }
__device__ __forceinline__ int perm32(int rho) { const int n = rho >> 4, i = rho & 15; return 8 * (i >> 2) + 4 * n + (i & 3); }
__device__ __forceinline__ int xcd_remap(int L, int nwg) { const int q = nwg / NXCD, r = nwg % NXCD, xcd = L % NXCD, off = L / NXCD; return (xcd < r ? xcd * (q + 1) : r * (q + 1) + (xcd - r) * q) + off; }

struct Unit { int pm, pn, e, rows, mt; };

struct DenseSched {
    int nM, nN, nwg, G, c, K; const char* Bt;
    __device__ __forceinline__ void init(int M, int N, int K_, int G_, int c_, const void* Bt_) { nM = M / BM; nN = N / BM; nwg = nM * nN; G = G_; c = c_; K = K_; Bt = (const char*)Bt_; }
    __device__ __forceinline__ bool next(int i, Unit& u) const {
        const long L = (long)i * G + c; if (L >= nwg) return false;
        const int wgid = xcd_remap((int)L, nwg);
        const int nig = WGM * nN, gid = wgid / nig, fm = gid * WGM, gsz = (nM - fm) < WGM ? (nM - fm) : WGM;
        u.pm = fm + ((wgid % nig) % gsz); u.pn = (wgid % nig) / gsz; u.e = 0; u.rows = 256; u.mt = u.pm; return true;
    }
    __device__ __forceinline__ unsigned a_off(const Unit& u, int h, int R, int C) const { return (unsigned)(((u.pm * BM + h * HALF + R) * K + C) * 2); }
    __device__ __forceinline__ const char* b_ptr(const Unit& u) const { return Bt + (size_t)u.pn * BM * K * 2; }
};

struct GroupSched {
    int nunits, G, c, shift, NTR, mode, K; const LAS unsigned short* tile_e; const LAS int* tbase; const LAS int* cnt; const int* bins; const char* Bt; size_t estride;
    __device__ __forceinline__ bool next(int i, Unit& u) const {
        const long L = (long)i * G + c; if (L >= nunits) return false;
        const int wgid = xcd_remap((int)L, nunits);
        const int tau = wgid >> shift; u.pn = wgid & ((1 << shift) - 1); u.pm = tau;
        if (tau < NTR) { const int e = tile_e[tau]; u.e = e; u.mt = tau - tbase[e]; const int left = cnt[e] - u.mt * 256; u.rows = left < 256 ? left : 256; }
        else { u.e = NE; u.mt = tau - NTR; u.rows = 256; }
        return true;
    }
    __device__ __forceinline__ unsigned a_off(const Unit& u, int h, int R, int C) const {
        if (mode == 0) { const int rl = h * HALF + R; int tok;
            if (u.e < NE) tok = (rl < u.rows) ? (bins[(size_t)u.e * T + u.mt * 256 + rl] >> 3) : 0; else tok = u.mt * 256 + rl;
            return (unsigned)((tok * 1024 + C) * 2); }
        return (unsigned)(((u.pm * BM + h * HALF + R) * 256 + C) * 2);
    }
    __device__ __forceinline__ const char* b_ptr(const Unit& u) const { return Bt + (size_t)u.e * estride + (size_t)u.pn * BM * K * 2; }
};

__device__ __forceinline__ unsigned cvt_pk_bf16(float lo, float hi) { unsigned r; asm volatile("v_cvt_pk_bf16_f32 %0, %1, %2" : "=v"(r) : "v"(lo), "v"(hi)); return r; }

template <bool TIME = false, class Epi, class Sched>
__device__ __forceinline__ void gemm_phase(LAS unsigned char* lds, const char* Abase, int K, const Sched& S, const Epi& E, unsigned long long* tacc = nullptr) {
    const int tid = threadIdx.x, wid = __builtin_amdgcn_readfirstlane(tid >> 6), lane = tid & 63, wr = wid >> 2, wc = wid & 3, fr = lane & 15, fq = lane >> 4;
    const int nt = K / BK;
    int RA[2], CA[2]; unsigned voffB[2];
#pragma unroll
    for (int i = 0; i < 2; ++i) { int R, C; stage_rc(tid * 16 + i * 8192, R, C); const int Rb = Epi::PERM ? ((R & ~31) + perm32(R & 31)) : R; RA[i] = R; CA[i] = C; voffB[i] = (unsigned)(Rb * K + C) * 2u; }
    const size_t kstep = (size_t)(BK * 2);
    const size_t hstep = (size_t)HALF * K * 2;
    const unsigned ldsw = (unsigned)wid * 1024u;
    const int aoff = lds_byte(wr * 64 + fr, fq * 8), boff = lds_byte(wc * 32 + fr, fq * 8);
#define PG8_SA(b, h) (((b) * 2 + (h)) * HTB)
#define PG8_SB(b, h) ((4 + (b) * 2 + (h)) * HTB)
#define PG8_STAGEB(bufoff, gbase) do { _Pragma("unroll") for (int _i = 0; _i < 2; ++_i) \
        __builtin_amdgcn_global_load_lds((const unsigned*)((const char*)(gbase) + voffB[_i]), (LAS unsigned*)(lds + (bufoff) + ldsw + _i * 8192), 16, 0, 0); } while (0)
#define PG8_STAGEA(bufoff, koff, v0, v1) do { \
        __builtin_amdgcn_global_load_lds((const unsigned*)(Abase + (koff) + (v0)), (LAS unsigned*)(lds + (bufoff) + ldsw), 16, 0, 0); \
        __builtin_amdgcn_global_load_lds((const unsigned*)(Abase + (koff) + (v1)), (LAS unsigned*)(lds + (bufoff) + ldsw + 8192), 16, 0, 0); } while (0)
#define PG8_LDA(dst, b, h) do { _Pragma("unroll") for (int m = 0; m < 4; ++m) _Pragma("unroll") for (int k = 0; k < 2; ++k) dst[m][k] = *(const LAS bf16x8*)(lds + PG8_SA(b, h) + aoff + m * 2048 + k * 1024); } while (0)
#define PG8_LDB(dst, b, h) do { _Pragma("unroll") for (int n = 0; n < 2; ++n) _Pragma("unroll") for (int k = 0; k < 2; ++k) dst[n][k] = *(const LAS bf16x8*)(lds + PG8_SB(b, h) + boff + n * 2048 + k * 1024); } while (0)
#define PG8_MMA(ai, bj, At, Bt) do { __builtin_amdgcn_s_setprio(1); _Pragma("unroll") for (int m = 0; m < 4; ++m) _Pragma("unroll") for (int n = 0; n < 2; ++n) _Pragma("unroll") for (int k = 0; k < 2; ++k) \
        acc[ai][bj][m][n] = __builtin_amdgcn_mfma_f32_16x16x32_bf16(Bt[n][k], At[m][k], acc[ai][bj][m][n], 0, 0, 0); __builtin_amdgcn_s_setprio(0); } while (0)
#define PG8_WAIT_V(n) asm volatile("s_waitcnt vmcnt(" #n ")" ::: "memory")
#define PG8_WAIT_L(n) asm volatile("s_waitcnt lgkmcnt(" #n ")" ::: "memory")
#define PG8_BAR __builtin_amdgcn_s_barrier()
#define PG8_SCHED __builtin_amdgcn_sched_barrier(0)
    Unit cur, nxt; int ui = 0;
    if (!S.next(0, cur)) return;
    unsigned vc00 = S.a_off(cur, 0, RA[0], CA[0]), vc01 = S.a_off(cur, 0, RA[1], CA[1]), vc10 = S.a_off(cur, 1, RA[0], CA[0]), vc11 = S.a_off(cur, 1, RA[1], CA[1]);
    asm volatile("" : "+v"(vc00), "+v"(vc01), "+v"(vc10), "+v"(vc11));
    f32x4 acc[2][2][4][2];
#pragma unroll
    for (int a = 0; a < 2; ++a)
#pragma unroll
        for (int b = 0; b < 2; ++b)
#pragma unroll
            for (int m = 0; m < 4; ++m)
#pragma unroll
                for (int n = 0; n < 2; ++n) acc[a][b][m][n] = (f32x4){0.f, 0.f, 0.f, 0.f};
    bf16x8 At[4][2], B0[2][2], B1[2][2];
    const char* cB = S.b_ptr(cur);
    PG8_STAGEB(PG8_SB(0, 0), cB); PG8_STAGEB(PG8_SB(0, 1), cB + hstep); PG8_STAGEA(PG8_SA(0, 0), 0, vc00, vc01); PG8_STAGEA(PG8_SA(0, 1), 0, vc10, vc11);
    if (wr == 1) PG8_BAR;
    PG8_WAIT_V(2); PG8_BAR;
    PG8_STAGEB(PG8_SB(1, 0), cB + kstep); PG8_STAGEA(PG8_SA(1, 0), kstep, vc00, vc01); PG8_STAGEB(PG8_SB(1, 1), cB + hstep + kstep);
    PG8_WAIT_V(6); PG8_BAR;
    for (;;) {
        const bool has_next = S.next(ui + 1, nxt);
        unsigned vn00 = vc00, vn01 = vc01, vn10 = vc10, vn11 = vc11;
        if (has_next) { vn00 = S.a_off(nxt, 0, RA[0], CA[0]); vn01 = S.a_off(nxt, 0, RA[1], CA[1]); vn10 = S.a_off(nxt, 1, RA[0], CA[0]); vn11 = S.a_off(nxt, 1, RA[1], CA[1]); }
        asm volatile("" : "+v"(vn00), "+v"(vn01), "+v"(vn10), "+v"(vn11));
        const char* nB = has_next ? S.b_ptr(nxt) : cB;
        for (int t = 0; t < nt; t += 2) {
            const bool last = (t == nt - 2);
            const size_t k1 = (size_t)(t + 1) * kstep;
            const size_t k2 = last ? 0 : (size_t)(t + 2) * kstep, k3 = k2 + kstep;
            const char* b2 = last ? nB : cB + (size_t)(t + 2) * kstep; const char* b3 = b2 + kstep;
            const unsigned s00 = last ? vn00 : vc00, s01 = last ? vn01 : vc01, s10 = last ? vn10 : vc10, s11 = last ? vn11 : vc11;
            PG8_LDB(B0, 0, 0); PG8_LDB(B1, 0, 1); PG8_SCHED; PG8_LDA(At, 0, 0); PG8_STAGEA(PG8_SA(1, 1), k1, vc10, vc11);
            PG8_WAIT_V(8); PG8_WAIT_L(0); PG8_BAR; PG8_MMA(0, 0, At, B0); PG8_MMA(0, 1, At, B1); PG8_BAR; PG8_SCHED;
            PG8_LDA(At, 0, 1); PG8_STAGEB(PG8_SB(0, 0), b2); PG8_STAGEB(PG8_SB(0, 1), b2 + hstep); PG8_STAGEA(PG8_SA(0, 0), k2, s00, s01);
            PG8_WAIT_V(8); PG8_WAIT_L(0); PG8_BAR; PG8_MMA(1, 0, At, B0); PG8_MMA(1, 1, At, B1); PG8_BAR; PG8_SCHED;
            PG8_LDB(B0, 1, 0); PG8_LDB(B1, 1, 1); PG8_SCHED; PG8_LDA(At, 1, 0); PG8_STAGEA(PG8_SA(0, 1), k2, s10, s11);
            PG8_WAIT_V(8); PG8_WAIT_L(0); PG8_BAR; PG8_MMA(0, 0, At, B0); PG8_MMA(0, 1, At, B1); PG8_BAR; PG8_SCHED;
            PG8_LDA(At, 1, 1); PG8_STAGEB(PG8_SB(1, 0), b3); PG8_STAGEB(PG8_SB(1, 1), b3 + hstep); PG8_STAGEA(PG8_SA(1, 0), k3, s00, s01);
            PG8_WAIT_V(8); PG8_WAIT_L(0); PG8_BAR; PG8_MMA(1, 0, At, B0); PG8_MMA(1, 1, At, B1); PG8_BAR; PG8_SCHED;
        }
        if (wr == 0) PG8_BAR;
        if constexpr (TIME) { const unsigned long long t0_ = __builtin_amdgcn_s_memrealtime(); E(acc, cur, wr, wc, fr, fq); asm volatile("s_waitcnt vmcnt(0)" ::: "memory"); *tacc += __builtin_amdgcn_s_memrealtime() - t0_; }
        else E(acc, cur, wr, wc, fr, fq);
        if (!has_next) break;
#pragma unroll
        for (int a = 0; a < 2; ++a)
#pragma unroll
            for (int b = 0; b < 2; ++b)
#pragma unroll
                for (int m = 0; m < 4; ++m)
#pragma unroll
                    for (int n = 0; n < 2; ++n) acc[a][b][m][n] = (f32x4){0.f, 0.f, 0.f, 0.f};
        cur = nxt; cB = nB; vc00 = vn00; vc01 = vn01; vc10 = vn10; vc11 = vn11; ++ui;
        if (wr == 1) PG8_BAR;
    }
    PG8_WAIT_V(0);
    PG8_BAR;
#undef PG8_SA
#undef PG8_SB
#undef PG8_STAGEA
#undef PG8_STAGEB
#undef PG8_LDA
#undef PG8_LDB
#undef PG8_MMA
#undef PG8_WAIT_V
#undef PG8_WAIT_L
#undef PG8_BAR
#undef PG8_SCHED
}

struct EpiInProj {
    static constexpr bool PERM = true;
    bf16_t *Q, *Kb, *V, *U, *QM; unsigned* nrm;
    __device__ __forceinline__ void operator()(const f32x4 (&acc)[2][2][4][2], const Unit& u, int wr, int wc, int fr, int fq) const {
        bf16_t* base; int ldc, colt; float sc = 1.f; const int pn = u.pn;
        float nmax[2] = {0.f, 0.f};
        if (pn < 2) { base = Q; ldc = 512; colt = pn * 256; sc = C2; } else if (pn < 4) { base = Kb; ldc = 512; colt = (pn - 2) * 256; } else if (pn < 6) { base = V; ldc = 512; colt = (pn - 4) * 256; }
        else if (pn == 6) { base = U; ldc = 256; colt = 0; } else { base = QM; ldc = 256; colt = 0; sc = C2; }
        const int row0 = u.pm * BM + wr * 64 + fr, col0 = colt + wc * 32 + 8 * fq;
#pragma unroll
        for (int ai = 0; ai < 2; ++ai)
#pragma unroll
            for (int m = 0; m < 4; ++m) { bf16_t* rowp = base + (size_t)(row0 + ai * HALF + m * 16) * ldc + col0;
#pragma unroll
                for (int bj = 0; bj < 2; ++bj) { const f32x4 v0 = acc[ai][bj][m][0] * sc, v1 = acc[ai][bj][m][1] * sc;
                    u32x4 w; w.x = cvt_pk_bf16(v0[0], v0[1]); w.y = cvt_pk_bf16(v0[2], v0[3]); w.z = cvt_pk_bf16(v1[0], v1[1]); w.w = cvt_pk_bf16(v1[2], v1[3]);
                    *(u32x4*)(rowp + bj * HALF) = w;
                    if (pn < 4) { float q = (v0[0] * v0[0] + v0[1] * v0[1]) + (v0[2] * v0[2] + v0[3] * v0[3]) + (v1[0] * v1[0] + v1[1] * v1[1]) + (v1[2] * v1[2] + v1[3] * v1[3]);
                        q += __shfl_xor(q, 16); q += __shfl_xor(q, 32); nmax[bj] = fmaxf(nmax[bj], q); } } }
        if (pn < 4) {
#pragma unroll
            for (int bj = 0; bj < 2; ++bj) { float q = nmax[bj];
#pragma unroll
                for (int o = 1; o < 16; o <<= 1) q = fmaxf(q, __shfl_xor(q, o));
                if (fr == 0 && fq == 0) { const int b = (u.pm * BM) / SEQ, h = (pn & 1) * 4 + 2 * bj + (wc >> 1), kind = pn >> 1;
                    atomicMax(nrm + ((b * 8 + h) * 2 + kind) * 2 + (wc & 1), __float_as_uint(q)); } }
        }
    }
};
struct EpiBf16 {
    static constexpr bool PERM = true;
    bf16_t* O; int ldc;
    __device__ __forceinline__ void operator()(const f32x4 (&acc)[2][2][4][2], const Unit& u, int wr, int wc, int fr, int fq) const {
        const int row0 = u.pm * BM + wr * 64 + fr, col0 = u.pn * BM + wc * 32 + 8 * fq;
#pragma unroll
        for (int ai = 0; ai < 2; ++ai)
#pragma unroll
            for (int m = 0; m < 4; ++m) { bf16_t* rowp = O + (size_t)(row0 + ai * HALF + m * 16) * ldc + col0;
#pragma unroll
                for (int bj = 0; bj < 2; ++bj) { const f32x4 v0 = acc[ai][bj][m][0], v1 = acc[ai][bj][m][1];
                    u32x4 w; w.x = cvt_pk_bf16(v0[0], v0[1]); w.y = cvt_pk_bf16(v0[2], v0[3]); w.z = cvt_pk_bf16(v1[0], v1[1]); w.w = cvt_pk_bf16(v1[2], v1[3]);
                    *(u32x4*)(rowp + bj * HALF) = w; } }
    }
};
struct EpiRes16 {
    static constexpr bool PERM = true;
    bf16_t* O; const float* R; float rs;
    __device__ __forceinline__ void operator()(const f32x4 (&acc)[2][2][4][2], const Unit& u, int wr, int wc, int fr, int fq) const {
        const int row0 = u.pm * BM + wr * 64 + fr, col0 = u.pn * BM + wc * 32 + 8 * fq;
#pragma unroll
        for (int ai = 0; ai < 2; ++ai)
#pragma unroll
            for (int m = 0; m < 4; ++m) { const size_t row = (size_t)(row0 + ai * HALF + m * 16);
#pragma unroll
                for (int bj = 0; bj < 2; ++bj) { const float* rp = R + row * DM + col0 + bj * HALF;
                    const f32x4 v0 = acc[ai][bj][m][0] + *(const f32x4*)rp * rs, v1 = acc[ai][bj][m][1] + *(const f32x4*)(rp + 4) * rs;
                    u32x4 w; w.x = cvt_pk_bf16(v0[0], v0[1]); w.y = cvt_pk_bf16(v0[2], v0[3]); w.z = cvt_pk_bf16(v1[0], v1[1]); w.w = cvt_pk_bf16(v1[2], v1[3]);
                    *(u32x4*)(O + row * (2 * DM) + col0 + bj * HALF) = w; }
                if (m & 1) asm volatile("" ::: "memory"); }
    }
};
struct EpiF32 {
    static constexpr bool PERM = false;
    float* C; int ldc; const float* R; float rs;
    __device__ __forceinline__ void operator()(const f32x4 (&acc)[2][2][4][2], const Unit& u, int wr, int wc, int fr, int fq) const {
        const int row0 = u.pm * BM + wr * 64 + fr, col0 = u.pn * BM + wc * 32 + 4 * fq;
#pragma unroll
        for (int ai = 0; ai < 2; ++ai)
#pragma unroll
            for (int m = 0; m < 4; ++m) { const size_t off = (size_t)(row0 + ai * HALF + m * 16) * ldc + col0;
#pragma unroll
                for (int bj = 0; bj < 2; ++bj)
#pragma unroll
                    for (int n = 0; n < 2; ++n) { f32x4 v = acc[ai][bj][m][n]; if (R) v += *(const f32x4*)(R + off + bj * HALF + n * 16) * rs; *(f32x4*)(C + off + bj * HALF + n * 16) = v; }
                if (m & 1) asm volatile("" ::: "memory"); }
    }
};
struct EpiGateUp {
    static constexpr bool PERM = true;
    bf16_t* H;
    __device__ __forceinline__ void operator()(const f32x4 (&acc)[2][2][4][2], const Unit& u, int wr, int wc, int fr, int fq) const {
        const int row0 = u.pm * BM + wr * 64 + fr, col0 = u.pn * 128 + wc * 32 + 8 * fq;
#pragma unroll
        for (int ai = 0; ai < 2; ++ai)
#pragma unroll
            for (int m = 0; m < 4; ++m) { bf16_t* rowp = H + (size_t)(row0 + ai * HALF + m * 16) * EH + col0; float hv[8];
#pragma unroll
                for (int n = 0; n < 2; ++n)
#pragma unroll
                    for (int j = 0; j < 4; ++j) { const float g = acc[ai][0][m][n][j], up = acc[ai][1][m][n][j]; hv[n * 4 + j] = g * __builtin_amdgcn_rcpf(1.f + __builtin_amdgcn_exp2f(-g * LOG2E)) * up; }
                u32x4 w; w.x = cvt_pk_bf16(hv[0], hv[1]); w.y = cvt_pk_bf16(hv[2], hv[3]); w.z = cvt_pk_bf16(hv[4], hv[5]); w.w = cvt_pk_bf16(hv[6], hv[7]);
                *(u32x4*)rowp = w; }
    }
};
struct EpiDown {
    static constexpr bool PERM = true;
    bf16_t* Y; float* SH; const int* bins; const float* gates;
    __device__ __forceinline__ void operator()(const f32x4 (&acc)[2][2][4][2], const Unit& u, int wr, int wc, int fr, int fq) const {
        const int col0 = u.pn * BM + wc * 32 + 8 * fq;
        if (u.e == NE) {
#pragma unroll
            for (int ai = 0; ai < 2; ++ai)
#pragma unroll
                for (int m = 0; m < 4; ++m) { const int tok = u.mt * 256 + ai * HALF + wr * 64 + m * 16 + fr; bf16_t* rowp = (bf16_t*)(SH + (size_t)tok * DM) + col0;
#pragma unroll
                    for (int bj = 0; bj < 2; ++bj) { const f32x4 v0 = acc[ai][bj][m][0], v1 = acc[ai][bj][m][1];
                        u32x4 w; w.x = cvt_pk_bf16(v0[0], v0[1]); w.y = cvt_pk_bf16(v0[2], v0[3]); w.z = cvt_pk_bf16(v1[0], v1[1]); w.w = cvt_pk_bf16(v1[2], v1[3]);
                        *(u32x4*)(rowp + bj * HALF) = w; } }
        } else {
            const int* bp = bins + (size_t)u.e * T + u.mt * 256;
            int av[8]; float gv[8];
#pragma unroll
            for (int i = 0; i < 8; ++i) { const int rl = (i >> 2) * HALF + wr * 64 + (i & 3) * 16 + fr; av[i] = bp[rl < u.rows ? rl : u.rows - 1]; }
#pragma unroll
            for (int i = 0; i < 8; ++i) gv[i] = gates[av[i]];
#pragma unroll
            for (int ai = 0; ai < 2; ++ai)
#pragma unroll
                for (int m = 0; m < 4; ++m) { const int rl = ai * HALF + wr * 64 + m * 16 + fr;
                    if (rl < u.rows) { const int a = av[ai * 4 + m]; const float g = gv[ai * 4 + m]; bf16_t* rowp = Y + (size_t)a * DM + col0;
#pragma unroll
                        for (int bj = 0; bj < 2; ++bj) { const f32x4 v0 = acc[ai][bj][m][0] * g, v1 = acc[ai][bj][m][1] * g;
                            u32x4 w; w.x = cvt_pk_bf16(v0[0], v0[1]); w.y = cvt_pk_bf16(v0[2], v0[3]); w.z = cvt_pk_bf16(v1[0], v1[1]); w.w = cvt_pk_bf16(v1[2], v1[3]);
                            *(u32x4*)(rowp + bj * HALF) = w; } } }
        }
    }
};
}


__device__ __forceinline__ unsigned cvtpk_bg(float lo, float hi) { unsigned r; asm volatile("v_cvt_pk_bf16_f32 %0, %1, %2" : "=v"(r) : "v"(lo), "v"(hi)); return r; }
struct ConvBg {
    const float *w_gate, *w_up, *w_down, *ws_gate, *ws_up, *ws_down; bf16_t *WGU, *WD;
    LAS float* scr; int lane, it, it0, end, stride, nl; bool pend; f32x4 v[8]; bf16_t* dst; int ldt;
    static constexpr int NIT = (NE + 1) * 384;
    __device__ __forceinline__ void decode(int r, const float*& src, int& ldw) {
        const int e = r / 384; r -= e * 384;
        if (r < 256) { const int up = r >> 7; r &= 127; const int kb = r >> 3, nb = r & 7, n0 = nb * 32;
            src = ((e < NE) ? ((up ? w_up : w_gate) + (size_t)e * DM * EH) : (up ? ws_up : ws_gate)) + (size_t)kb * 64 * EH + n0; ldw = EH;
            const int drow = (n0 >> 7) * 256 + up * 128 + (n0 & 127); dst = WGU + ((size_t)e * 512 + drow) * DM + kb * 64; ldt = DM;
        } else { r -= 256; const int kb = r >> 5, nb = r & 31;
            src = ((e < NE) ? (w_down + (size_t)e * EH * DM) : ws_down) + (size_t)kb * 64 * DM + nb * 32; ldw = DM;
            dst = WD + ((size_t)e * DM + nb * 32) * EH + kb * 64; ldt = EH; }
    }
    __device__ __forceinline__ void finish() {
        if (!pend) return;
        const int kq = lane >> 3, n4 = (lane & 7) * 4;
#pragma unroll
        for (int i = 0; i < 8; ++i) { LAS float* p = scr + (8 * i + kq) * 33 + n4; p[0] = v[i].x; p[1] = v[i].y; p[2] = v[i].z; p[3] = v[i].w; }
        LDS_WAIT(); asm volatile("" ::: "memory");
        const int c8 = lane & 7;
#pragma unroll
        for (int j = 0; j < 4; ++j) { const int n = (lane >> 3) + 8 * j; const LAS float* s = scr + (8 * c8) * 33 + n;
            u32x4 o; o.x = cvtpk_bg(s[0 * 33], s[1 * 33]); o.y = cvtpk_bg(s[2 * 33], s[3 * 33]); o.z = cvtpk_bg(s[4 * 33], s[5 * 33]); o.w = cvtpk_bg(s[6 * 33], s[7 * 33]);
            *(u32x4*)(dst + (size_t)n * ldt + 8 * c8) = o; }
        LDS_WAIT(); asm volatile("" ::: "memory");
        pend = false;
    }
    __device__ __forceinline__ void issue() {
        const bool valid = it < end; const float* src; int ldw; decode(valid ? it : it0, src, ldw);
        const int kq = lane >> 3, n4 = (lane & 7) * 4;
#pragma unroll
        for (int i = 0; i < 8; ++i) v[i] = __builtin_nontemporal_load((const f32x4*)(src + (size_t)(8 * i + kq) * ldw + n4));
        pend = valid; if (valid) it += stride; nl = 8;
    }
    __device__ __forceinline__ bool busy() const { return pend || it < end; }
};
struct NoBg { int nl; __device__ __forceinline__ void finish() {} __device__ __forceinline__ void issue() { nl = 0; } };

namespace att {
constexpr int SLOTB = 8192, L_K = 0, L_V = 2 * SLOTB, L_WS = 4 * SLOTB, L_OST = L_WS + 8 * 256, L_FK = L_OST + 8 * 4096, L_END = L_FK + 16384;
#define SBAR() __builtin_amdgcn_sched_barrier(0)
__device__ __forceinline__ int crow(int r, int hi) { return (r & 3) + 8 * (r >> 2) + 4 * hi; }
__device__ __forceinline__ void glds16(const void* gsrc, unsigned lds_dst) { unsigned keep;
    asm volatile("s_mov_b32 %0, m0\n\ts_mov_b32 m0, %2\n\ts_nop 0\n\tglobal_load_lds_dwordx4 %1, off\n\ts_mov_b32 m0, %0" : "=&s"(keep) : "v"(gsrc), "s"(lds_dst) : "memory"); }
__device__ __forceinline__ unsigned cvtpk(float lo, float hi) { unsigned r; asm("v_cvt_pk_bf16_f32 %0, %1, %2" : "=v"(r) : "v"(lo), "v"(hi)); return r; }
#define ATT_WAIT_BAR() asm volatile("s_waitcnt vmcnt(0) lgkmcnt(0)\n\ts_barrier" ::: "memory")

struct Job { const bf16_t* Q; int qpitch; const bf16_t* K; const bf16_t* V; int kvpitch; bf16_t* O; int nt; int causal; const float* FC; int q0; float qk2; };
constexpr float SKIP_LOG2 = 36.f;

template <bool FOX, class Bg> __device__ __forceinline__ void unit(const Job& j, LAS unsigned char* shm, Bg& bg) {
    const int tid = threadIdx.x, lane = tid & 63, r32 = lane & 31, hi = lane >> 5; const int wid = __builtin_amdgcn_readfirstlane(tid >> 6);
    const unsigned lds0 = (unsigned)(uintptr_t)shm;
    LAS float* wsf = (LAS float*)(shm + L_WS) + wid * 64;
    LAS float* fk = (LAS float*)(shm + L_FK);
    const int NT = j.nt;
    float fq = 0.f; int tlo = 0;
    if (FOX) {
        const float fq0 = j.FC[j.q0];
        const bool keep = (lane < NT) ? (j.qk2 + fq0 - j.FC[64 * lane + 63] >= -SKIP_LOG2) : false;
        const unsigned long long mk = __ballot(keep);
        tlo = (mk != 0ull) ? (int)__builtin_ctzll(mk) : NT - 1; tlo = __builtin_amdgcn_readfirstlane(tlo);
        for (int i = tlo * 16 + tid; i < NT * 16; i += 512) *(LAS f32x4*)(fk + 4 * i) = *(const f32x4*)(j.FC + 4 * i);
        fq = j.FC[j.q0 + wid * 32 + r32];
    }
    const int NTE = NT - tlo;
    const bf16_t* ksrc = j.K + (size_t)lane * j.kvpitch + wid * 8;
    const bf16_t* vsrc = j.V + (size_t)(16 * (wid & 3) + (lane >> 2)) * j.kvpitch + (wid >> 2) * 32 + (lane & 3) * 8;
    const unsigned kdst = lds0 + L_K + wid * 1024, vdst = lds0 + L_V + wid * 1024;
#define DMA_K(t, slot) glds16(ksrc + (size_t)(t) * 64 * j.kvpitch, (unsigned)__builtin_amdgcn_readfirstlane(kdst + (slot) * SLOTB))
#define DMA_V(t, slot) glds16(vsrc + (size_t)(t) * 64 * j.kvpitch, (unsigned)__builtin_amdgcn_readfirstlane(vdst + (slot) * SLOTB))
    const bf16_t* Qw = j.Q + (size_t)(wid * 32) * j.qpitch;
    bf16x8 qr[4];
#pragma unroll
    for (int d0 = 0; d0 < 4; ++d0) qr[d0] = *reinterpret_cast<const bf16x8*>(Qw + (size_t)r32 * j.qpitch + d0 * 16 + hi * 8);
    asm volatile("s_waitcnt vmcnt(0) lgkmcnt(0)" ::: "memory");
    bg.nl = 0;
    { const int t0 = FOX ? NT - 1 : 0; DMA_K(t0, 0); DMA_V(t0, 0); }
    float mrun = -1e30f, l_reg = 0.f; f32x16 o[2]; o[0] = f32x16{}; o[1] = f32x16{};
    const int qrel = wid * 32 + r32;
    for (int it = 0; it < NTE; ++it) {
        const int tcur = FOX ? NT - 1 - it : it, slot = it & 1;
        if (bg.nl == 8) asm volatile("s_waitcnt vmcnt(8) lgkmcnt(0)\n\ts_barrier" ::: "memory");
        else ATT_WAIT_BAR();
        bg.finish();
        if (it + 1 < NTE) { const int tn = FOX ? tcur - 1 : tcur + 1; DMA_K(tn, slot ^ 1); DMA_V(tn, slot ^ 1); }
        bg.issue();
        f32x16 p0, p1;
        if (FOX) {
#pragma unroll
            for (int g = 0; g < 4; ++g) { const f32x4 a = *(const LAS f32x4*)(fk + 64 * tcur + 8 * g + 4 * hi), b = *(const LAS f32x4*)(fk + 64 * tcur + 32 + 8 * g + 4 * hi);
#pragma unroll
                for (int i = 0; i < 4; ++i) { p0[4 * g + i] = fq - a[i]; p1[4 * g + i] = fq - b[i]; } }
        } else { p0 = f32x16{}; p1 = f32x16{}; }
        { const LAS unsigned char* kb = shm + L_K + slot * SLOTB + hi * 1024 + r32 * 16;
#pragma unroll
          for (int d0 = 0; d0 < 4; ++d0) { const bf16x8 b0 = *(const LAS bf16x8*)(kb + d0 * 2048), b1 = *(const LAS bf16x8*)(kb + d0 * 2048 + 512);
              p0 = __builtin_amdgcn_mfma_f32_32x32x16_bf16(b0, qr[d0], p0, 0, 0, 0); p1 = __builtin_amdgcn_mfma_f32_32x32x16_bf16(b1, qr[d0], p1, 0, 0, 0); } }
        if (j.causal && tcur >= NT - 4) { const int kb0 = 64 * (tcur - (NT - 4)) + 4 * hi;
#pragma unroll
            for (int r = 0; r < 16; ++r) { const int kv = kb0 + (r & 3) + 8 * (r >> 2); if (kv > qrel) p0[r] = -INFINITY; if (kv + 32 > qrel) p1[r] = -INFINITY; } }
        float rm = p0[0];
#pragma unroll
        for (int r = 1; r < 16; ++r) rm = fmaxf(rm, p0[r]);
#pragma unroll
        for (int r = 0; r < 16; ++r) rm = fmaxf(rm, p1[r]);
        rm = fmaxf(rm, __shfl_xor(rm, 32));
        const float mn = fmaxf(mrun, rm), alpha = __builtin_amdgcn_exp2f(mrun - mn); mrun = mn;
        float rs = 0.f;
#pragma unroll
        for (int r = 0; r < 16; ++r) { p0[r] = __builtin_amdgcn_exp2f(p0[r] - mn); p1[r] = __builtin_amdgcn_exp2f(p1[r] - mn); rs += p0[r] + p1[r]; }
        l_reg = l_reg * alpha + rs;
        if (hi == 0) wsf[r32] = alpha;
        LDS_WAIT();
#pragma unroll
        for (int r = 0; r < 16; ++r) { const float f = wsf[crow(r, hi)]; o[0][r] *= f; o[1][r] *= f; }
        u32x4 pw0, pw1, pw2, pw3;
        pw0 = (u32x4){cvtpk(p0[0], p0[1]), cvtpk(p0[2], p0[3]), cvtpk(p0[4], p0[5]), cvtpk(p0[6], p0[7])};
        pw1 = (u32x4){cvtpk(p0[8], p0[9]), cvtpk(p0[10], p0[11]), cvtpk(p0[12], p0[13]), cvtpk(p0[14], p0[15])};
        pw2 = (u32x4){cvtpk(p1[0], p1[1]), cvtpk(p1[2], p1[3]), cvtpk(p1[4], p1[5]), cvtpk(p1[6], p1[7])};
        pw3 = (u32x4){cvtpk(p1[8], p1[9]), cvtpk(p1[10], p1[11]), cvtpk(p1[12], p1[13]), cvtpk(p1[14], p1[15])};
        const bf16x8 pa0 = __builtin_bit_cast(bf16x8, pw0), pa1 = __builtin_bit_cast(bf16x8, pw1), pa2 = __builtin_bit_cast(bf16x8, pw2), pa3 = __builtin_bit_cast(bf16x8, pw3);
        const int vb = (int)(lds0 + L_V + slot * SLOTB) + ((lane >> 4) & 1) * 32 + (lane & 3) * 8 + (4 * hi + ((lane & 15) >> 2)) * 64;
#pragma unroll
        for (int d0 = 0; d0 < 2; ++d0) { s16x4 lo[4], hh[4];
#pragma unroll
            for (int ks = 0; ks < 4; ++ks) {
                asm volatile("ds_read_b64_tr_b16 %0,%1 offset:%c2" : "=&v"(lo[ks]) : "v"(vb), "i"(d0 * 4096 + ks * 1024) : "memory");
                asm volatile("ds_read_b64_tr_b16 %0,%1 offset:%c2" : "=&v"(hh[ks]) : "v"(vb), "i"(d0 * 4096 + ks * 1024 + 512) : "memory"); }
            asm volatile("s_waitcnt lgkmcnt(0)" ::: "memory"); SBAR();
#define PK(k) (bf16x8){lo[k][0], lo[k][1], lo[k][2], lo[k][3], hh[k][0], hh[k][1], hh[k][2], hh[k][3]}
            o[d0] = __builtin_amdgcn_mfma_f32_32x32x16_bf16(pa0, PK(0), o[d0], 0, 0, 0);
            o[d0] = __builtin_amdgcn_mfma_f32_32x32x16_bf16(pa1, PK(1), o[d0], 0, 0, 0);
            o[d0] = __builtin_amdgcn_mfma_f32_32x32x16_bf16(pa2, PK(2), o[d0], 0, 0, 0);
            o[d0] = __builtin_amdgcn_mfma_f32_32x32x16_bf16(pa3, PK(3), o[d0], 0, 0, 0);
#undef PK
        }
    }
    l_reg += __shfl_xor(l_reg, 32);
    if (hi == 0) wsf[32 + r32] = l_reg;
    LDS_WAIT();
    float rli[16];
#pragma unroll
    for (int r = 0; r < 16; ++r) rli[r] = 1.0f / wsf[32 + crow(r, hi)];
    bf16_t* Ow = j.O + (size_t)(wid * 32) * DM;
    { LAS bf16_t* stg = (LAS bf16_t*)(shm + L_OST) + wid * 2048;
#pragma unroll
      for (int r = 0; r < 16; ++r) { const int orow = crow(r, hi);
#pragma unroll
          for (int d0 = 0; d0 < 2; ++d0) stg[orow * 64 + d0 * 32 + r32] = (bf16_t)f2bf(o[d0][r] * rli[r]); }
      LDS_WAIT();
#pragma unroll
      for (int i = 0; i < 4; ++i) { const int row = i * 8 + (lane >> 3), ch = lane & 7; const u32x4 v = *(const LAS u32x4*)(stg + row * 64 + ch * 8); *(u32x4*)(Ow + (size_t)row * DM + ch * 8) = v; } }
    asm volatile("s_waitcnt vmcnt(0) lgkmcnt(0)\n\ts_barrier" ::: "memory");
#undef DMA_K
#undef DMA_V
}
#undef SBAR
}

#define XB_TMO      128
#define XB_XCNT(j)  (256  + 64 * (j))
#define XB_XSUB(j)  (1280 + 64 * (j))
#define XB_XGEN(j)  (2304 + 64 * (j))
#define XB_TOP      3328
#define XB_TOPGEN   3392
#define XCD_BAR_WORDS 3456
#define XB_SPIN_CAP (1u << 18)
constexpr int CW_BAR = 32768;
__device__ __forceinline__ unsigned xb_ld(unsigned* p)              { return __hip_atomic_load(p, __ATOMIC_RELAXED, __HIP_MEMORY_SCOPE_AGENT); }
__device__ __forceinline__ unsigned xb_add(unsigned* p, unsigned v) { return __hip_atomic_fetch_add(p, v, __ATOMIC_RELAXED, __HIP_MEMORY_SCOPE_AGENT); }
__device__ __forceinline__ unsigned xb_xcc_id() { return (unsigned)__builtin_amdgcn_s_getreg((3 << 11) | 20) & 0xFu; }
#define XB_SPIN(cond, bar) do { unsigned _sp = 0; while (cond) { __builtin_amdgcn_s_sleep(1); \
    if ((++_sp & 255u) == 0u) { if (xb_ld(&(bar)[XB_TMO])) break; if (_sp > XB_SPIN_CAP) { atomicAdd(&(bar)[XB_TMO], 1u); break; } } } } while (0)
struct XcdBarrier { unsigned* bar; unsigned x; volatile LAS unsigned* st; };
__device__ __forceinline__ XcdBarrier xcd_barrier_post(unsigned* bar, volatile LAS unsigned* st) {
    XcdBarrier b; b.bar = bar; b.x = xb_xcc_id(); b.st = st;
    if (threadIdx.x == 0) (void)xb_add(&bar[XB_XCNT(b.x)], 1u);
    return b;
}
__device__ __forceinline__ void xcd_barrier_complete(unsigned* bar, unsigned x, unsigned& nloc, unsigned& nx) {
    const unsigned G = gridDim.x * gridDim.y * gridDim.z;
    unsigned sum, cnt, mine, sp = 0u;
    for (;;) {
        sum = 0u; cnt = 0u; mine = 0u;
#pragma unroll
        for (unsigned j = 0; j < 16; ++j) { const unsigned c = xb_ld(&bar[XB_XCNT(j)]); sum += c; cnt += (c > 0u) ? 1u : 0u; mine = (j == x) ? c : mine; }
        if (sum == G) break;
        __builtin_amdgcn_s_sleep(1);
        if ((++sp & 255u) == 0u) { if (xb_ld(&bar[XB_TMO])) break; if (sp > XB_SPIN_CAP) { atomicAdd(&bar[XB_TMO], 1u); break; } }
    }
    nloc = mine > 0u ? mine : 1u; nx = cnt > 0u ? cnt : 1u;
}
__device__ __forceinline__ void xcd_barrier(const XcdBarrier& b) {
    asm volatile("s_waitcnt vmcnt(0)" ::: "memory");
    __syncthreads();
    if (threadIdx.x == 0) {
        unsigned* bar = b.bar;
        __builtin_amdgcn_s_waitcnt(0);
        unsigned nloc = b.st[0], nx = b.st[1];
        if (nloc == 0u) { xcd_barrier_complete(bar, b.x, nloc, nx); b.st[0] = nloc; b.st[1] = nx; }
        const unsigned old = xb_add(&bar[XB_XSUB(b.x)], 1u);
        const unsigned gen = old / nloc;
        if (old + 1u == (gen + 1u) * nloc) {
            __builtin_amdgcn_fence(__ATOMIC_RELEASE, "agent");
            asm volatile("s_waitcnt vmcnt(0)" ::: "memory");
            const unsigned og = xb_add(&bar[XB_TOP], 1u);
            const unsigned tg = og / nx;
            if (og + 1u == (tg + 1u) * nx) xb_add(&bar[XB_TOPGEN], 1u);
            else XB_SPIN(xb_ld(&bar[XB_TOPGEN]) == tg, bar);
            __builtin_amdgcn_fence(__ATOMIC_ACQUIRE, "agent");
            xb_add(&bar[XB_XGEN(b.x)], 1u);
            asm volatile("s_waitcnt vmcnt(0)" ::: "memory");
        } else {
            XB_SPIN(xb_ld(&bar[XB_XGEN(b.x)]) == gen, bar);
            __builtin_amdgcn_fence(__ATOMIC_ACQUIRE, "agent");
            asm volatile("s_waitcnt vmcnt(0)" ::: "memory");
        }
    }
    __syncthreads();
}

struct Ctx { int tid, lane, wave, vcu, G; LAS unsigned char* lds; };

__device__ __forceinline__ unsigned cvtpk_hw(float lo, float hi) { unsigned r; asm volatile("v_cvt_pk_bf16_f32 %0, %1, %2" : "=v"(r) : "v"(lo), "v"(hi)); return r; }
__device__ __forceinline__ void tr_item64(const float* W, int ldw, bf16_t* WT, int ldt, LAS float* scr, int lane) {
    const int kr = lane >> 4, n4 = (lane & 15) * 4;
#pragma unroll
    for (int hb = 0; hb < 2; ++hb) { f32x4 v[8];
#pragma unroll
        for (int i = 0; i < 8; ++i) v[i] = __builtin_nontemporal_load((const f32x4*)(W + (size_t)(4 * (8 * hb + i) + kr) * ldw + n4));
#pragma unroll
        for (int i = 0; i < 8; ++i) { LAS float* p = scr + (4 * (8 * hb + i) + kr) * 65 + n4; p[0] = v[i].x; p[1] = v[i].y; p[2] = v[i].z; p[3] = v[i].w; } }
    LDS_WAIT(); asm volatile("" ::: "memory");
    const int kc = lane & 7;
#pragma unroll
    for (int j = 0; j < 8; ++j) { const int n = (lane >> 3) + 8 * j; const LAS float* s = scr + (8 * kc) * 65 + n;
        u32x4 o; o.x = cvtpk_hw(s[0 * 65], s[1 * 65]); o.y = cvtpk_hw(s[2 * 65], s[3 * 65]); o.z = cvtpk_hw(s[4 * 65], s[5 * 65]); o.w = cvtpk_hw(s[6 * 65], s[7 * 65]);
        *(u32x4*)(WT + (size_t)n * ldt + 8 * kc) = o; }
    LDS_WAIT(); asm volatile("" ::: "memory");
}

__device__ __forceinline__ void p0_prologue(const Args& a, const Ctx& c) {
    unsigned char* ws = a.ws;
    bf16_t* WGU = (bf16_t*)(ws + WS_WGU); bf16_t* WD = (bf16_t*)(ws + WS_WD); bf16_t* WIN = (bf16_t*)(ws + WS_WIN); bf16_t* WMKV = (bf16_t*)(ws + WS_WMKV);
    bf16_t* WOUT = (bf16_t*)(ws + WS_WOUT); bf16_t* WR = (bf16_t*)(ws + WS_WR);
    LAS float* WfT = (LAS float*)c.lds;
    LAS float* scr = (LAS float*)(c.lds + c.wave * 16640);
    const int gw = c.vcu * 8 + c.wave, NGW = c.G * 8;
    constexpr int NEXP_ITEMS = 0;
    constexpr int I_WIN = 512, I_MKV = 128, I_OUT = 192, I_R = 64;
    constexpr int NITEMS = NEXP_ITEMS + I_WIN + I_MKV + I_OUT + I_R;
    for (int it = gw; it < NITEMS; it += NGW) {
        int r = it;
        if (r < NEXP_ITEMS) { const int e = r / 192; r -= e * 192;
            if (r < 128) { const int up = r >> 6; r &= 63; const int kb = r >> 2, nb = r & 3, n0 = nb * 64;
                const float* src = (e < NE) ? ((up ? a.w_up : a.w_gate) + (size_t)e * DM * EH) : (up ? a.ws_up : a.ws_gate);
                const int drow = (n0 >> 7) * 256 + up * 128 + (n0 & 127);
                tr_item64(src + (size_t)kb * 64 * EH + n0, EH, WGU + ((size_t)e * 512 + drow) * DM + kb * 64, DM, scr, c.lane);
            } else { r -= 128; const int kb = r >> 4, nb = r & 15;
                const float* src = (e < NE) ? (a.w_down + (size_t)e * EH * DM) : a.ws_down;
                tr_item64(src + (size_t)kb * 64 * DM + nb * 64, DM, WD + ((size_t)e * DM + nb * 64) * EH + kb * 64, EH, scr, c.lane); }
            continue; }
        r -= NEXP_ITEMS;
        if (r < I_WIN) {
            int col0, drow0, nbw;
            if (r < 128) { col0 = 256; drow0 = 0; nbw = 8; } else if (r < 256) { r -= 128; col0 = 768; drow0 = 512; nbw = 8; } else if (r < 384) { r -= 256; col0 = 1280; drow0 = 1024; nbw = 8; }
            else if (r < 448) { r -= 384; col0 = 0; drow0 = 1536; nbw = 4; } else { r -= 448; col0 = 1800; drow0 = 1792; nbw = 4; }
            const int kb = r / nbw, nb = r % nbw;
            tr_item64(a.w_in + (size_t)kb * 64 * INC + col0 + nb * 64, INC, WIN + (size_t)(drow0 + nb * 64) * DM + kb * 64, DM, scr, c.lane);
            continue; }
        r -= I_WIN;
        if (r < I_MKV) { const int kb = r >> 3, nb = r & 7; tr_item64(a.w_mem_kv + (size_t)kb * 64 * 512 + nb * 64, 512, WMKV + (size_t)(nb * 64) * DM + kb * 64, DM, scr, c.lane); continue; }
        r -= I_MKV;
        if (r < I_OUT) { const int kb = r >> 4, nb = r & 15; tr_item64(a.w_out + (size_t)(256 + kb * 64) * DM + nb * 64, DM, WOUT + (size_t)(nb * 64) * DM + 256 + kb * 64, DM, scr, c.lane); continue; }
        r -= I_OUT;
        { const int kb = r >> 2, nb = r & 3; tr_item64(a.w_router + (size_t)kb * 64 * NE + nb * 64, NE, WR + (size_t)(nb * 64) * DM + kb * 64, DM, scr, c.lane); }
    }
    __syncthreads();
    for (int idx = c.tid; idx < 8192; idx += 512) { const int h = idx & 7, k = idx >> 3; WfT[h * 1024 + k] = a.w_in[(size_t)k * INC + 1792 + h]; }
    for (int idx = (c.vcu * 512 + c.tid); idx < 256 * 1024; idx += c.G * 512) { const int k = idx >> 10, n = idx & 1023, g = k >> 6, cc = k & 63; float s = 0.f;
        for (int d = 0; d < 64; ++d) s += a.w_pool[g * 4096 + cc * 64 + d] * a.pool_scale[g * 64 + d] * a.w_out[(size_t)(g * 64 + d) * DM + n];
        WOUT[(size_t)n * DM + k] = (bf16_t)f2bf(s); }
    __syncthreads();
    bf16_t* XB = (bf16_t*)(ws + WS_XB); float* FLOG = (float*)(ws + WS_FLOG);
    for (int m = gw; m < T; m += NGW) {
        const f32x4* xr = (const f32x4*)(a.x + (size_t)m * DM) + c.lane; f32x4 v[4];
#pragma unroll
        for (int j = 0; j < 4; ++j) v[j] = xr[64 * j];
        u32x2* o8 = (u32x2*)(XB + (size_t)m * DM) + c.lane;
#pragma unroll
        for (int j = 0; j < 4; ++j) o8[64 * j] = (u32x2){pk2(v[j].x, v[j].y), pk2(v[j].z, v[j].w)};
        float acc[8];
#pragma unroll
        for (int h = 0; h < 8; ++h) { float s = 0.f;
#pragma unroll
            for (int j = 0; j < 4; ++j) { const f32x4 w = *(const LAS f32x4*)(WfT + h * 1024 + 4 * c.lane + 256 * j); s += (v[j].x * w.x + v[j].y * w.y) + (v[j].z * w.z + v[j].w * w.w); }
            acc[h] = s; }
        float b4[4], b2[2], z;
        { const bool up = (c.lane & 32) != 0;
#pragma unroll
          for (int i = 0; i < 4; ++i) { const float keep = up ? acc[4 + i] : acc[i], give = up ? acc[i] : acc[4 + i]; b4[i] = keep + __shfl_xor(give, 32); } }
        { const bool up = (c.lane & 16) != 0;
#pragma unroll
          for (int i = 0; i < 2; ++i) { const float keep = up ? b4[2 + i] : b4[i], give = up ? b4[i] : b4[2 + i]; b2[i] = keep + __shfl_xor(give, 16); } }
        { const bool up = (c.lane & 8) != 0; const float keep = up ? b2[1] : b2[0], give = up ? b2[0] : b2[1]; z = keep + __shfl_xor(give, 8); }
        z += __shfl_xor(z, 4); z += __shfl_xor(z, 2); z += __shfl_xor(z, 1);
        if ((c.lane & 7) == 0) { const int h = ((c.lane >> 5) & 1) * 4 + ((c.lane >> 4) & 1) * 2 + ((c.lane >> 3) & 1); z += a.b_f[h];
            const float lf = (z >= 0.f) ? -log1pf(expf(-z)) : (z - log1pf(expf(z))); FLOG[(size_t)m * 8 + h] = lf; }
    }
    bf16_t* MEMB = (bf16_t*)(ws + WS_MEMB);
    for (int m = gw; m < NB * 256; m += NGW) {
        const f32x4* xr = (const f32x4*)(a.mem + (size_t)m * DM) + c.lane; u32x2* o8 = (u32x2*)(MEMB + (size_t)m * DM) + c.lane;
#pragma unroll
        for (int j = 0; j < 4; ++j) { const f32x4 v = xr[64 * j]; o8[64 * j] = (u32x2){pk2(v.x, v.y), pk2(v.z, v.w)}; }
    }
}

__device__ __forceinline__ void p1_fscan(const Args& a, const Ctx& c) {
    if (c.vcu >= 64) return;
    const float* FLOG = (const float*)(a.ws + WS_FLOG); float* FC = (float*)(a.ws + WS_FC);
    LAS float* wtot = (LAS float*)c.lds;
    const int bh = c.vcu, b = bh >> 3, h = bh & 7; float p[8]; float run = 0.f;
#pragma unroll
    for (int i = 0; i < 8; ++i) { run += FLOG[((size_t)b * SEQ + c.tid * 8 + i) * 8 + h]; p[i] = run; }
    float inc = run;
#pragma unroll
    for (int o = 1; o < 64; o <<= 1) { const float t = __shfl_up(inc, o); if (c.lane >= o) inc += t; }
    if (c.lane == 63) wtot[c.wave] = inc;
    __syncthreads();
    float base = inc - run;
    for (int w = 0; w < c.wave; ++w) base += wtot[w];
#pragma unroll
    for (int i = 0; i < 8; ++i) FC[(size_t)bh * SEQ + c.tid * 8 + i] = (base + p[i]) * LOG2E;
    __syncthreads();
}

__device__ __forceinline__ void p2_mixers(const Args& a, const Ctx& c) {
    unsigned char* ws = a.ws;
    const bf16_t* Q = (const bf16_t*)(ws + WS_Q); const bf16_t* Kb = (const bf16_t*)(ws + WS_K); const bf16_t* V = (const bf16_t*)(ws + WS_V); const bf16_t* QM = (const bf16_t*)(ws + WS_QM);
    const bf16_t* U = (const bf16_t*)(ws + WS_U); const bf16_t* KVM = (const bf16_t*)(ws + WS_KVM); bf16_t* YMIX = (bf16_t*)(ws + WS_YMIX); const float* FC = (const float*)(ws + WS_FC);
    { const int cp = c.tid & 127, rg = c.tid >> 7, ch = 2 * cp, w = 2 << (ch >> 6);
      for (int i = 0; i < 32; ++i) { const int t = c.vcu * 128 + rg * 32 + i; if (t >= T) break; const int pos = t & (SEQ - 1), cnt = (pos + 1 < w) ? pos + 1 : w;
          float s0 = 0.f, s1 = 0.f, u0 = 0.f, u1 = 0.f;
          for (int jw = 0; jw < cnt; ++jw) { const unsigned wv = *(const unsigned*)(U + (size_t)(t - jw) * 256 + ch); const float x0 = bflo(wv), x1 = bfhi(wv); s0 += x0; s1 += x1; if (jw == 0) { u0 = x0; u1 = x1; } }
          const float inv = 1.0f / (float)cnt;
          *(unsigned*)(YMIX + (size_t)t * DM + ch) = pk2(s0 * inv - u0, s1 * inv - u1); } }
    __syncthreads();
    ConvBg bg; bg.w_gate = a.w_gate; bg.w_up = a.w_up; bg.w_down = a.w_down; bg.ws_gate = a.ws_gate; bg.ws_up = a.ws_up; bg.ws_down = a.ws_down;
    bg.WGU = (bf16_t*)(ws + WS_WGU); bg.WD = (bf16_t*)(ws + WS_WD); bg.scr = (LAS float*)(c.lds + BG_OFF + c.wave * 8448); bg.lane = c.lane;
    bg.it = c.vcu * 8 + c.wave; bg.end = ConvBg::NIT; bg.stride = c.G * 8; bg.it0 = bg.it; bg.nl = 0; bg.pend = false; bg.dst = nullptr; bg.ldt = 0;
#pragma unroll
    for (int i = 0; i < 8; ++i) bg.v[i] = (f32x4){0.f, 0.f, 0.f, 0.f};
    { const int s = c.vcu >> 6, r = c.vcu & 63; const float* nrm = (const float*)(ws + WS_CTL) + CW_NRM;
      for (int i = 0; i < 4; ++i) { const int qb = (i == 0) ? s : (i == 1) ? 15 - s : (i == 2) ? 7 - s : 8 + s; const int bh = (r + 17 * i) & 63, b = bh >> 3, h = bh & 7;
          att::Job j; const size_t row0 = (size_t)b * SEQ;
          { const float q2 = nrm[bh * 4 + 0] + nrm[bh * 4 + 1], k2 = nrm[bh * 4 + 2] + nrm[bh * 4 + 3]; j.qk2 = 2.02f * sqrtf(q2 * k2); }
          j.Q = Q + (row0 + qb * 256) * 512 + h * 64; j.qpitch = 512; j.K = Kb + row0 * 512 + h * 64; j.V = V + row0 * 512 + h * 64; j.kvpitch = 512;
          j.O = YMIX + (row0 + qb * 256) * DM + 256 + h * 64; j.nt = 4 * qb + 4; j.causal = 1; j.FC = FC + (size_t)bh * SEQ; j.q0 = qb * 256;
          att::unit<true>(j, c.lds, bg); } }
    for (int i = 0; i < 2; ++i) { const int mu = c.vcu * 2 + i, b = mu >> 6, hm = (mu >> 4) & 3, qb = mu & 15;
        att::Job j; const size_t row0 = (size_t)b * SEQ + qb * 256;
        j.Q = QM + row0 * 256 + hm * 64; j.qpitch = 256; j.K = KVM + (size_t)b * 256 * 512 + hm * 64; j.V = KVM + (size_t)b * 256 * 512 + 256 + hm * 64; j.kvpitch = 512;
        j.O = YMIX + row0 * DM + 768 + hm * 64; j.nt = 4; j.causal = 0; j.FC = nullptr; j.q0 = 0; j.qk2 = 0.f;
        att::unit<false>(j, c.lds, bg); }
    while (bg.busy()) { bg.finish(); bg.issue(); }
}

__device__ __forceinline__ void p4_ln1(const Args& a, const Ctx& c) {
    bf16_t* X1B = (bf16_t*)(a.ws + WS_X1B); const int gw = c.vcu * 8 + c.wave, NGW = c.G * 8;
    f32x4 g4[4], b4[4];
#pragma unroll
    for (int j = 0; j < 4; ++j) { g4[j] = *((const f32x4*)a.ln1_g + c.lane + 64 * j); b4[j] = *((const f32x4*)a.ln1_b + c.lane + 64 * j); }
    for (int m = gw; m < T; m += NGW) {
        const u32x2* xr = (const u32x2*)(a.out + (size_t)m * DM) + c.lane; f32x4 v[4]; float s = 0.f;
#pragma unroll
        for (int j = 0; j < 4; ++j) { const u32x2 hw = xr[64 * j]; v[j] = (f32x4){bflo(hw.x), bfhi(hw.x), bflo(hw.y), bfhi(hw.y)}; s += (v[j].x + v[j].y) + (v[j].z + v[j].w); }
        const float mean = wave_sum(s) * (1.f / DM); float s2 = 0.f;
#pragma unroll
        for (int j = 0; j < 4; ++j) { v[j] = v[j] - mean; s2 += (v[j].x * v[j].x + v[j].y * v[j].y) + (v[j].z * v[j].z + v[j].w * v[j].w); }
        const float rstd = 1.f / sqrtf(wave_sum(s2) * (1.f / DM) + LN_EPS);
        u32x2* o8 = (u32x2*)(X1B + (size_t)m * DM) + c.lane;
#pragma unroll
        for (int j = 0; j < 4; ++j) { const f32x4 y = v[j] * rstd * g4[j] + b4[j]; o8[64 * j] = (u32x2){pk2(y.x, y.y), pk2(y.z, y.w)}; }
    }
}

__device__ __forceinline__ float wave_max_f(float v) {
    int x = __float_as_int(v);  v = fmaxf(v, __int_as_float(__builtin_amdgcn_update_dpp(x, x, 0x121, 0xf, 0xf, false)));
    x = __float_as_int(v);      v = fmaxf(v, __int_as_float(__builtin_amdgcn_update_dpp(x, x, 0x122, 0xf, 0xf, false)));
    x = __float_as_int(v);      v = fmaxf(v, __int_as_float(__builtin_amdgcn_update_dpp(x, x, 0x124, 0xf, 0xf, false)));
    x = __float_as_int(v);      v = fmaxf(v, __int_as_float(__builtin_amdgcn_update_dpp(x, x, 0x128, 0xf, 0xf, false)));
    x = __float_as_int(v);
    const float a = __int_as_float(__builtin_amdgcn_readlane(x, 0)), b = __int_as_float(__builtin_amdgcn_readlane(x, 16)), c = __int_as_float(__builtin_amdgcn_readlane(x, 32)), d = __int_as_float(__builtin_amdgcn_readlane(x, 48));
    return fmaxf(fmaxf(a, b), fmaxf(c, d));
}
#define CSWAP(va, ia, sa, vb, ib, sb) do { const bool sw_ = (vb > va) || (vb == va && ib < ia); const float tv_ = sw_ ? vb : va, tw_ = sw_ ? va : vb; const int ti_ = sw_ ? ib : ia, tj_ = sw_ ? ia : ib; \
    const float ts_ = sw_ ? sb : sa, tt_ = sw_ ? sa : sb; va = tv_; vb = tw_; ia = ti_; ib = tj_; sa = ts_; sb = tt_; } while (0)
__device__ __forceinline__ void p6_route(const Args& a, const Ctx& c) {
    const float* LOG = (const float*)(a.ws + WS_LOG); int* cnt = (int*)(a.ws + WS_CTL); int* bins = (int*)(a.ws + WS_BINS); float* gates = (float*)(a.ws + WS_GATES);
    LAS int* hist = (LAS int*)c.lds; LAS int* base = hist + 256; LAS unsigned short* asg_e = (LAS unsigned short*)(base + 256); LAS unsigned short* asg_r = asg_e + 1024;
    const int lane = c.lane;
    const f32x4 bs = *((const f32x4*)a.router_bias + lane);
    for (int chunk = c.vcu; chunk < T / 128; chunk += c.G) {
        __syncthreads();
        if (c.tid < 256) hist[c.tid] = 0;
        __syncthreads();
        for (int i = 0; i < 16; ++i) {
            const int lt = c.wave * 16 + i, tok = chunk * 128 + lt;
            const f32x4 lg = *((const f32x4*)(LOG + (size_t)tok * NE) + lane);
            float s0 = 1.f / (1.f + expf(-lg.x)), s1 = 1.f / (1.f + expf(-lg.y)), s2 = 1.f / (1.f + expf(-lg.z)), s3 = 1.f / (1.f + expf(-lg.w));
            float v0 = s0 + bs.x, v1 = s1 + bs.y, v2 = s2 + bs.z, v3 = s3 + bs.w;
            int i0 = 4 * lane, i1 = i0 + 1, i2 = i0 + 2, i3 = i0 + 3;
            CSWAP(v0, i0, s0, v1, i1, s1); CSWAP(v2, i2, s2, v3, i3, s3); CSWAP(v0, i0, s0, v2, i2, s2); CSWAP(v1, i1, s1, v3, i3, s3); CSWAP(v1, i1, s1, v2, i2, s2);
            float m1 = v0, m2 = v1;
#pragma unroll
            for (int o = 1; o < 8; o <<= 1) { const float o1 = __shfl_xor(m1, o), o2 = __shfl_xor(m2, o); const float n1 = fmaxf(m1, o1), n2 = fmaxf(fminf(m1, o1), fmaxf(m2, o2)); m1 = n1; m2 = n2; }
            const float gs = m1 + m2; const int g = lane >> 3; int rank = 0; const int gsx = __float_as_int(gs);
#pragma unroll
            for (int jg = 0; jg < 8; ++jg) { const float gj = __int_as_float(__builtin_amdgcn_readlane(gsx, 8 * jg)); rank += (gj > gs || (gj == gs && jg < g)) ? 1 : 0; }
            if (rank >= 4) { v0 = -INFINITY; v1 = -INFINITY; v2 = -INFINITY; v3 = -INFINITY; }
            int my_e = 0; float my_s = 0.f;
#pragma unroll
            for (int k = 0; k < TOPK; ++k) {
                const float m = wave_max_f(v0);
                const unsigned long long mk = __ballot(v0 == m);
                const int wl = (int)__builtin_ctzll(mk);
                const int ek = __builtin_amdgcn_readlane(i0, wl); const float sk = __int_as_float(__builtin_amdgcn_readlane(__float_as_int(s0), wl));
                if (lane == wl) { v0 = v1; i0 = i1; s0 = s1; v1 = v2; i1 = i2; s1 = s2; v2 = v3; i2 = i3; s2 = s3; v3 = -INFINITY; }
                if (lane == k) { my_e = ek; my_s = sk; }
            }
            float tot = (lane < 8) ? my_s : 0.f;
            tot += __shfl_xor(tot, 1); tot += __shfl_xor(tot, 2); tot += __shfl_xor(tot, 4);
            if (lane < 8) { const int lr = __hip_atomic_fetch_add(&hist[my_e], 1, __ATOMIC_RELAXED, __HIP_MEMORY_SCOPE_WORKGROUP); asg_e[lt * 8 + lane] = (unsigned short)my_e; asg_r[lt * 8 + lane] = (unsigned short)lr; gates[(size_t)tok * 8 + lane] = my_s / tot * 2.5f; }
        }
        __syncthreads();
        if (c.tid < 256) { const int n = hist[c.tid]; base[c.tid] = n ? atomicAdd(&cnt[c.tid * 64], n) : 0; }
        __syncthreads();
        for (int sl = c.tid; sl < 1024; sl += 512) { const int e = asg_e[sl]; bins[(size_t)e * T + base[e] + asg_r[sl]] = chunk * 1024 + sl; }
    }
    __syncthreads();
}
#undef CSWAP

__device__ __forceinline__ int build_tables(const Args& a, const Ctx& c) {
    const int* cnt = (const int*)(a.ws + WS_CTL);
    LAS unsigned short* te = (LAS unsigned short*)(c.lds + TE_OFF); LAS int* tb = (LAS int*)(c.lds + TB_OFF); LAS int* cn = (LAS int*)(c.lds + CN_OFF);
    __syncthreads();
    if (c.tid < NE) cn[c.tid] = __hip_atomic_load(cnt + c.tid * 64, __ATOMIC_RELAXED, __HIP_MEMORY_SCOPE_AGENT);
    __syncthreads();
    if (c.tid == 0) { int run = 0; for (int e = 0; e < NE; ++e) { tb[e] = run; run += (cn[e] + 255) >> 8; } tb[NE] = run; }
    __syncthreads();
    if (c.tid < NE) { const int n = (cn[c.tid] + 255) >> 8, b0 = tb[c.tid]; for (int jt = 0; jt < n; ++jt) te[b0 + jt] = (unsigned short)c.tid; }
    __syncthreads();
    return tb[NE];
}

__device__ __forceinline__ void p9_combine(const Args& a, const Ctx& c) {
    const bf16_t* X1B = (const bf16_t*)(a.ws + WS_X1B); const bf16_t* Y = (const bf16_t*)(a.ws + WS_Y); const int gw = c.vcu * 8 + c.wave, NGW = c.G * 8;
    f32x4 g4[4], b4[4];
#pragma unroll
    for (int j = 0; j < 4; ++j) { g4[j] = *((const f32x4*)a.ln2_g + c.lane + 64 * j); b4[j] = *((const f32x4*)a.ln2_b + c.lane + 64 * j); }
    for (int m = gw; m < T; m += NGW) {
        f32x4* orow = (f32x4*)(a.out + (size_t)m * DM) + c.lane; f32x4 v[4]; float s = 0.f;
        const u32x2* x8 = (const u32x2*)(X1B + (size_t)m * DM) + c.lane;
        const u32x2* s8 = (const u32x2*)(a.out + (size_t)m * DM) + c.lane;
#pragma unroll
        for (int j = 0; j < 4; ++j) { const u32x2 xw = x8[64 * j], sw = s8[64 * j]; v[j] = (f32x4){bflo(sw.x), bfhi(sw.x), bflo(sw.y), bfhi(sw.y)} + (f32x4){bflo(xw.x), bfhi(xw.x), bflo(xw.y), bfhi(xw.y)} * ALPHA; }
#pragma unroll
        for (int k = 0; k < TOPK; ++k) { const u32x2* y8 = (const u32x2*)(Y + ((size_t)m * TOPK + k) * DM) + c.lane;
#pragma unroll
            for (int j = 0; j < 4; ++j) { const u32x2 yw = y8[64 * j]; v[j] += (f32x4){bflo(yw.x), bfhi(yw.x), bflo(yw.y), bfhi(yw.y)}; } }
#pragma unroll
        for (int j = 0; j < 4; ++j) s += (v[j].x + v[j].y) + (v[j].z + v[j].w);
        const float mean = wave_sum(s) * (1.f / DM); float s2 = 0.f;
#pragma unroll
        for (int j = 0; j < 4; ++j) { v[j] = v[j] - mean; s2 += (v[j].x * v[j].x + v[j].y * v[j].y) + (v[j].z * v[j].z + v[j].w * v[j].w); }
        const float rstd = 1.f / sqrtf(wave_sum(s2) * (1.f / DM) + LN_EPS);
#pragma unroll
        for (int j = 0; j < 4; ++j) orow[64 * j] = v[j] * rstd * g4[j] + b4[j];
    }
}

constexpr int NPHASE = 10;

__global__ void __launch_bounds__(512, 2) mk_fwd(Args a) {
    extern __shared__ __attribute__((aligned(16))) unsigned char lds_raw[];
    cg::grid_group grid = cg::this_grid();
    Ctx c; c.lds = (LAS unsigned char*)lds_raw; c.tid = threadIdx.x; c.lane = c.tid & 63; c.wave = __builtin_amdgcn_readfirstlane(c.tid >> 6); c.G = gridDim.x;
    { const int bx = blockIdx.x; c.vcu = (c.G % 8 == 0) ? (bx % 8) * (c.G / 8) + bx / 8 : bx; }
    unsigned char* ws = a.ws; const int lo = a.ph_lo, hi = a.ph_hi;
#define IN(k) (lo <= (k) && (k) < hi)
    for (int u = c.tid; u < 32; u += 512) ((volatile LAS unsigned*)(c.lds + MISC_OFF))[u] = 0u;
    __syncthreads();
    XcdBarrier bar = xcd_barrier_post((unsigned*)(ws + WS_CTL) + CW_BAR + a.li * XCD_BAR_WORDS, (volatile LAS unsigned*)(c.lds + MISC_OFF) + 8);
    if (a.ph_lo < 0) grid.sync();
    unsigned long long pt_acc = 0ull;
#define PT_ON(id) (PROBE_T == (id))
#define SEAM(k) do { if (IN(k) && IN((k) + 1)) { if (PT_ON(10 + (k)) || PT_ON(30)) { const unsigned long long t0_ = __builtin_amdgcn_s_memrealtime(); xcd_barrier(bar); pt_acc += __builtin_amdgcn_s_memrealtime() - t0_; } else xcd_barrier(bar); } } while (0)
#define PH_BEGIN(k) unsigned long long pt0_##k = 0ull; if (PT_ON(k)) pt0_##k = __builtin_amdgcn_s_memrealtime();
#define PH_END(k) if (PT_ON(k)) { asm volatile("s_waitcnt vmcnt(0)" ::: "memory"); __syncthreads(); pt_acc += __builtin_amdgcn_s_memrealtime() - pt0_##k; }
    { PH_BEGIN(0) if (IN(0)) p0_prologue(a, c); PH_END(0) }
    SEAM(0);
    { PH_BEGIN(1) if (IN(1)) {
        p1_fscan(a, c);
        { pg8::DenseSched S; S.init(T, 2048, DM, c.G, (int)blockIdx.x, ws + WS_WIN);
          pg8::EpiInProj E{(bf16_t*)(ws + WS_Q), (bf16_t*)(ws + WS_K), (bf16_t*)(ws + WS_V), (bf16_t*)(ws + WS_U), (bf16_t*)(ws + WS_QM), (unsigned*)(ws + WS_CTL) + CW_NRM};
          pg8::gemm_phase(c.lds, (const char*)(ws + WS_XB), DM, S, E); }
        { pg8::DenseSched S; S.init(NB * 256, 512, DM, c.G, (int)blockIdx.x, ws + WS_WMKV);
          pg8::EpiBf16 E{(bf16_t*)(ws + WS_KVM), 512};
          pg8::gemm_phase(c.lds, (const char*)(ws + WS_MEMB), DM, S, E); }
    } PH_END(1) }
    SEAM(1);
    { PH_BEGIN(2) if (IN(2)) p2_mixers(a, c); PH_END(2) }
    SEAM(2);
    { PH_BEGIN(3) if (IN(3)) { pg8::DenseSched S; S.init(T, DM, DM, c.G, (int)blockIdx.x, ws + WS_WOUT);
        pg8::EpiRes16 E{(bf16_t*)a.out, a.x, ALPHA};
        pg8::gemm_phase<PT_ON(23)>(c.lds, (const char*)(ws + WS_YMIX), DM, S, E, &pt_acc); } PH_END(3) }
    SEAM(3);
    { PH_BEGIN(4) if (IN(4)) p4_ln1(a, c); PH_END(4) }
    SEAM(4);
    { PH_BEGIN(5) if (IN(5)) { pg8::DenseSched S; S.init(T, NE, DM, c.G, (int)blockIdx.x, ws + WS_WR);
        pg8::EpiF32 E{(float*)(ws + WS_LOG), NE, nullptr, 0.f};
        pg8::gemm_phase(c.lds, (const char*)(ws + WS_X1B), DM, S, E); } PH_END(5) }
    SEAM(5);
    { PH_BEGIN(6) if (IN(6)) p6_route(a, c); PH_END(6) }
    SEAM(6);
    { PH_BEGIN(7) if (IN(7)) { const int NTR = build_tables(a, c);
        pg8::GroupSched S; S.nunits = (NTR + 128) * 2; S.G = c.G; S.c = (int)blockIdx.x; S.shift = 1; S.NTR = NTR; S.mode = 0; S.K = DM;
        S.tile_e = (const LAS unsigned short*)(c.lds + TE_OFF); S.tbase = (const LAS int*)(c.lds + TB_OFF); S.cnt = (const LAS int*)(c.lds + CN_OFF);
        S.bins = (const int*)(ws + WS_BINS); S.Bt = (const char*)(ws + WS_WGU); S.estride = (size_t)512 * DM * 2;
        pg8::EpiGateUp E{(bf16_t*)(ws + WS_HB)};
        pg8::gemm_phase<PT_ON(27)>(c.lds, (const char*)(ws + WS_X1B), DM, S, E, &pt_acc); } PH_END(7) }
    SEAM(7);
    { PH_BEGIN(8) if (IN(8)) { const int NTR = build_tables(a, c);
        pg8::GroupSched S; S.nunits = (NTR + 128) * 4; S.G = c.G; S.c = (int)blockIdx.x; S.shift = 2; S.NTR = NTR; S.mode = 1; S.K = EH;
        S.tile_e = (const LAS unsigned short*)(c.lds + TE_OFF); S.tbase = (const LAS int*)(c.lds + TB_OFF); S.cnt = (const LAS int*)(c.lds + CN_OFF);
        S.bins = (const int*)(ws + WS_BINS); S.Bt = (const char*)(ws + WS_WD); S.estride = (size_t)DM * EH * 2;
        pg8::EpiDown E{(bf16_t*)(ws + WS_Y), a.out, (const int*)(ws + WS_BINS), (const float*)(ws + WS_GATES)};
        pg8::gemm_phase<PT_ON(28)>(c.lds, (const char*)(ws + WS_HB), EH, S, E, &pt_acc); } PH_END(8) }
    SEAM(8);
    { PH_BEGIN(9) if (IN(9)) p9_combine(a, c); PH_END(9) }
    if (PROBE_T >= 0) {
        unsigned* pw = (unsigned*)(ws + WS_CTL) + CW_PROBE;
        if (c.tid == 0) { if (PROBE_MODE == 0) atomicMax(pw, (unsigned)pt_acc); else atomicAdd(pw, (unsigned)pt_acc); }
        xcd_barrier(bar);
        if (blockIdx.x == 0 && c.tid == 0) { unsigned v = __hip_atomic_load(pw, __ATOMIC_RELAXED, __HIP_MEMORY_SCOPE_AGENT); if (PROBE_MODE == 1) v /= (unsigned)c.G;
            const unsigned long long t0 = __builtin_amdgcn_s_memrealtime(); while (__builtin_amdgcn_s_memrealtime() - t0 < (unsigned long long)v * PROBE_MULT) __builtin_amdgcn_s_sleep(8); }
    }
#undef IN
#undef SEAM
}

#ifndef MK_N_LAUNCHES
#define MK_N_LAUNCHES 1
#endif
extern "C" void kernel_launch(void* const* d_in, const int* in_sizes, int n_in, void* d_out, int out_size, void* d_ws, size_t ws_size, hipStream_t stream) {
    static int grid = 0;
    if (grid == 0) {
        if (n_in != 20 || out_size != T * DM || ws_size < WS_END) { fprintf(stderr, "kernel_launch: unexpected shapes (n_in %d out %d ws %zu)\n", n_in, out_size, ws_size); grid = -1; return; }
        int dev = 0, cus = 0, per_cu = 0;
        (void)hipGetDevice(&dev); (void)hipDeviceGetAttribute(&cus, hipDeviceAttributeMultiprocessorCount, dev);
        if (hipFuncSetAttribute((const void*)mk_fwd, hipFuncAttributeMaxDynamicSharedMemorySize, LDS_BYTES) != hipSuccess) { fprintf(stderr, "kernel_launch: hipFuncSetAttribute failed\n"); grid = -1; return; }
        (void)hipOccupancyMaxActiveBlocksPerMultiprocessor(&per_cu, (const void*)mk_fwd, 512, LDS_BYTES);
        if (per_cu < 1) { fprintf(stderr, "kernel_launch: occupancy query says %d blocks per CU\n", per_cu); grid = -1; return; }
        grid = cus;
        if (grid != 256) fprintf(stderr, "kernel_launch: %d CUs (built for 256)\n", grid);
    }
    if (grid < 0) return;
    (void)hipMemsetAsync((char*)d_ws + WS_CTL, 0, CTL_ZERO_BYTES, stream);
    Args a{};
    const float** p = (const float**)&a;
    for (int i = 0; i < 20; ++i) p[i] = (const float*)d_in[i];
    a.out = (float*)d_out; a.ws = (unsigned char*)d_ws;
    const int nl = MK_N_LAUNCHES;
    for (int li = 0; li < nl; ++li) {
        a.ph_lo = (nl == 1) ? 0 : li; a.ph_hi = (nl == 1) ? NPHASE : li + 1; a.li = li;
        void* args[] = {&a};
        const hipError_t e = hipLaunchCooperativeKernel((void*)mk_fwd, dim3(grid), dim3(512), args, LDS_BYTES, stream);
        if (e != hipSuccess) { fprintf(stderr, "kernel_launch: cooperative launch failed: %s\n", hipGetErrorString(e)); break; }
    }
}
```

```cpp
#include <hip/hip_runtime.h>
#include <hip/hip_cooperative_groups.h>
#include <cstdio>
#include <cstdint>
namespace cg = cooperative_groups;
#ifndef PROBE_T
#define PROBE_T -1
#endif
#ifndef PROBE_MODE
#define PROBE_MODE 0
#endif
#define PROBE_MULT 4
constexpr int CW_PROBE = 20000;
#define PT_BEGIN(id) unsigned long long ptb_##id = 0ull; if (PROBE_T == (id)) ptb_##id = __builtin_amdgcn_s_memrealtime();
#define PT_END(id, tacc) if (PROBE_T == (id)) { asm volatile("s_waitcnt vmcnt(0)" ::: "memory"); __syncthreads(); *(tacc) += __builtin_amdgcn_s_memrealtime() - ptb_##id; }

#define LAS __attribute__((address_space(3)))
typedef unsigned short bf16_t;
typedef short bf16x8 __attribute__((ext_vector_type(8)));
typedef short s16x4 __attribute__((ext_vector_type(4)));
typedef float f32x4 __attribute__((ext_vector_type(4)));
typedef float f32x2 __attribute__((ext_vector_type(2)));
typedef float f32x16 __attribute__((ext_vector_type(16)));
typedef unsigned u32x4 __attribute__((ext_vector_type(4)));
typedef unsigned u32x2 __attribute__((ext_vector_type(2)));

constexpr int NB = 8, SEQ = 4096, T = NB * SEQ, DM = 1024;
constexpr int INC = 2056;
constexpr int NE = 256, TOPK = 8, EH = 256;
constexpr float ALPHA = 1.189207115002721f;
constexpr float LN_EPS = 1e-5f;
constexpr float LOG2E = 1.4426950408889634f;
constexpr float C2 = 0.125f * LOG2E;
constexpr int MAXTILES = 1280 + 128;
constexpr float YSCALE = 32.f, YINV = 1.f / 32.f;

constexpr size_t MiB = 1u << 20;
constexpr size_t WS_CTL = 0, WS_WD = 1 * MiB, WS_HB = 130 * MiB, WS_X1B = 306 * MiB, WS_BINS = 370 * MiB, WS_GATES = 402 * MiB, WS_FC = 403 * MiB, WS_FLOG = 404 * MiB,
                 WS_KVM = 405 * MiB, WS_Y = 408 * MiB, WS_WGU = 408 * MiB, WS_WIN = 665 * MiB, WS_WMKV = 669 * MiB, WS_WOUT = 670 * MiB, WS_WR = 672 * MiB, WS_MEMB = 673 * MiB,
                 WS_XB = 677 * MiB, WS_Q = 741 * MiB, WS_K = 773 * MiB, WS_V = 805 * MiB, WS_QM = 837 * MiB, WS_U = 853 * MiB, WS_YMIX = 869 * MiB, WS_LOG = 933 * MiB, WS_END = 965 * MiB;
constexpr size_t CTL_ZERO_BYTES = 1 * MiB;
constexpr size_t WS_ROWIDX = WS_FLOG;
constexpr int CW_NRM = 16384;

constexpr int RING_BYTES = 131072;
constexpr int TE_OFF = 131072, TB_OFF = 135168, CN_OFF = 137216, BG_OFF = 83968  , MISC_OFF = 155648, LDS_BYTES = 156672;

struct Args {
    const float *x, *mem, *w_in, *b_f, *w_pool, *pool_scale, *w_mem_kv, *w_out, *ln1_g, *ln1_b, *w_router, *router_bias, *w_gate, *w_up, *w_down, *ws_gate, *ws_up, *ws_down, *ln2_g, *ln2_b;
    float* out; unsigned char* ws; int ph_lo, ph_hi, li, pad;
};

__device__ __forceinline__ unsigned f2bf(float f) { unsigned u = __float_as_uint(f); return (u + 0x7fffu + ((u >> 16) & 1u)) >> 16; }
__device__ __forceinline__ unsigned pk2(float lo, float hi) { return f2bf(lo) | (f2bf(hi) << 16); }
__device__ __forceinline__ float bflo(unsigned w) { return __uint_as_float(w << 16); }
__device__ __forceinline__ float bfhi(unsigned w) { return __uint_as_float(w & 0xffff0000u); }
__device__ __forceinline__ float wave_sum(float v) {
#pragma unroll
    for (int o = 1; o < 64; o <<= 1) v += __shfl_xor(v, o);
    return v;
}
#define LDS_WAIT() asm volatile("s_waitcnt lgkmcnt(0)" ::: "memory")

namespace pg8 {
constexpr int BM = 256, BK = 64, HALF = 128, HTB = HALF * BK * 2, NXCD = 8, WGM = 8;
__device__ __forceinline__ int lds_byte(int r, int c) { const int st = (r >> 4) * 2 + (c >> 5), rr = r & 15, cc = c & 31, ob = rr * 64 + cc * 2; return st * 1024 + (ob ^ (((ob >> 9) & 1) << 5)); }
__device__ __forceinline__ void stage_rc(int b, int& R, int& C) { const int st = b / 1024, sb = b % 1024, swz = sb ^ (((sb >> 9) & 1) << 5); R = (st >> 1) * 16 + swz / 64; C = (st & 1) * 32 + (swz % 64) / 2; }
__device__ __forceinline__ int perm32(int rho) { const int n = rho >> 4, i = rho & 15; return 8 * (i >> 2) + 4 * n + (i & 3); }
__device__ __forceinline__ int xcd_remap(int L, int nwg) { const int q = nwg / NXCD, r = nwg % NXCD, xcd = L % NXCD, off = L / NXCD; return (xcd < r ? xcd * (q + 1) : r * (q + 1) + (xcd - r) * q) + off; }

struct Unit { int pm, pn, e, rows, mt; };

struct DenseSched {
    int nM, nN, nwg, G, c, K; const char* Bt;
    __device__ __forceinline__ void init(int M, int N, int K_, int G_, int c_, const void* Bt_) { nM = M / BM; nN = N / BM; nwg = nM * nN; G = G_; c = c_; K = K_; Bt = (const char*)Bt_; }
    __device__ __forceinline__ bool next(int i, Unit& u) const {
        const long L = (long)i * G + c; if (L >= nwg) return false;
        const int wgid = xcd_remap((int)L, nwg);
        const int nig = WGM * nN, gid = wgid / nig, fm = gid * WGM, gsz = (nM - fm) < WGM ? (nM - fm) : WGM;
        u.pm = fm + ((wgid % nig) % gsz); u.pn = (wgid % nig) / gsz; u.e = 0; u.rows = 256; u.mt = u.pm; return true;
    }
    __device__ __forceinline__ unsigned a_off(const Unit& u, int h, int R, int C) const { return (unsigned)(((u.pm * BM + h * HALF + R) * K + C) * 2); }
    __device__ __forceinline__ const char* b_ptr(const Unit& u) const { return Bt + (size_t)u.pn * BM * K * 2; }
};

struct GroupSched {
    int nunits, G, c, shift, NTR, mode, K; const LAS unsigned short* tile_e; const LAS int* tbase; const LAS int* cnt; const int* bins; const char* Bt; size_t estride; int* rowidx;
    __device__ __forceinline__ bool next(int i, Unit& u) const {
        const long L = (long)i * G + c; if (L >= nunits) return false;
        const int wgid = xcd_remap((int)L, nunits);
        const int tau = wgid >> shift; u.pn = wgid & ((1 << shift) - 1); u.pm = tau;
        if (tau < NTR) { const int e = tile_e[tau]; u.e = e; u.mt = tau - tbase[e]; const int left = cnt[e] - u.mt * 256; u.rows = left < 256 ? left : 256; }
        else { u.e = NE; u.mt = tau - NTR; u.rows = 256; }
        return true;
    }
    __device__ __forceinline__ unsigned a_off(const Unit& u, int h, int R, int C) const {
        if (mode == 0) { const int rl = h * HALF + R; int tok;
            if (u.e < NE) { if (rl < u.rows) { const int a = bins[(size_t)u.e * T + u.mt * 256 + rl]; tok = a >> 3; if (C == 0 && u.pn == 0) rowidx[a] = u.pm * 256 + rl; } else tok = 0; }
            else tok = u.mt * 256 + rl;
            return (unsigned)((tok * 1024 + C) * 2); }
        return (unsigned)(((u.pm * BM + h * HALF + R) * 256 + C) * 2);
    }
    __device__ __forceinline__ const char* b_ptr(const Unit& u) const { return Bt + (size_t)u.e * estride + (size_t)u.pn * BM * K * 2; }
};

__device__ __forceinline__ unsigned cvt_pk_bf16(float lo, float hi) { unsigned r; asm volatile("v_cvt_pk_bf16_f32 %0, %1, %2" : "=v"(r) : "v"(lo), "v"(hi)); return r; }

template <bool TIME = false, class Epi, class Sched>
__device__ __forceinline__ void gemm_phase(LAS unsigned char* lds, const char* Abase, int K, const Sched& S, const Epi& E, unsigned long long* tacc = nullptr) {
    const int tid = threadIdx.x, wid = __builtin_amdgcn_readfirstlane(tid >> 6), lane = tid & 63, wr = wid >> 2, wc = wid & 3, fr = lane & 15, fq = lane >> 4;
    const int nt = K / BK;
    int RA[2], CA[2]; unsigned voffB[2];
#pragma unroll
    for (int i = 0; i < 2; ++i) { int R, C; stage_rc(tid * 16 + i * 8192, R, C); const int Rb = Epi::PERM ? ((R & ~31) + perm32(R & 31)) : R; RA[i] = R; CA[i] = C; voffB[i] = (unsigned)(Rb * K + C) * 2u; }
    const size_t kstep = (size_t)(BK * 2);
    const size_t hstep = (size_t)HALF * K * 2;
    const unsigned ldsw = (unsigned)wid * 1024u;
    const int aoff = lds_byte(wr * 64 + fr, fq * 8), boff = lds_byte(wc * 32 + fr, fq * 8);
#define PG8_SA(b, h) (((b) * 2 + (h)) * HTB)
#define PG8_SB(b, h) ((4 + (b) * 2 + (h)) * HTB)
#define PG8_STAGEB(bufoff, gbase) do { _Pragma("unroll") for (int _i = 0; _i < 2; ++_i) \
        __builtin_amdgcn_global_load_lds((const unsigned*)((const char*)(gbase) + voffB[_i]), (LAS unsigned*)(lds + (bufoff) + ldsw + _i * 8192), 16, 0, 0); } while (0)
#define PG8_STAGEA(bufoff, koff, v0, v1) do { \
        __builtin_amdgcn_global_load_lds((const unsigned*)(Abase + (koff) + (v0)), (LAS unsigned*)(lds + (bufoff) + ldsw), 16, 0, 0); \
        __builtin_amdgcn_global_load_lds((const unsigned*)(Abase + (koff) + (v1)), (LAS unsigned*)(lds + (bufoff) + ldsw + 8192), 16, 0, 0); } while (0)
#define PG8_LDA(dst, b, h) do { _Pragma("unroll") for (int m = 0; m < 4; ++m) _Pragma("unroll") for (int k = 0; k < 2; ++k) dst[m][k] = *(const LAS bf16x8*)(lds + PG8_SA(b, h) + aoff + m * 2048 + k * 1024); } while (0)
#define PG8_LDB(dst, b, h) do { _Pragma("unroll") for (int n = 0; n < 2; ++n) _Pragma("unroll") for (int k = 0; k < 2; ++k) dst[n][k] = *(const LAS bf16x8*)(lds + PG8_SB(b, h) + boff + n * 2048 + k * 1024); } while (0)
#define PG8_MMA(ai, bj, At, Bt) do { __builtin_amdgcn_s_setprio(1); _Pragma("unroll") for (int m = 0; m < 4; ++m) _Pragma("unroll") for (int n = 0; n < 2; ++n) _Pragma("unroll") for (int k = 0; k < 2; ++k) \
        acc[ai][bj][m][n] = __builtin_amdgcn_mfma_f32_16x16x32_bf16(Bt[n][k], At[m][k], acc[ai][bj][m][n], 0, 0, 0); __builtin_amdgcn_s_setprio(0); } while (0)
#define PG8_WAIT_V(n) asm volatile("s_waitcnt vmcnt(" #n ")" ::: "memory")
#define PG8_WAIT_L(n) asm volatile("s_waitcnt lgkmcnt(" #n ")" ::: "memory")
#define PG8_BAR __builtin_amdgcn_s_barrier()
#define PG8_SCHED __builtin_amdgcn_sched_barrier(0)
    Unit cur, nxt; int ui = 0;
    if (!S.next(0, cur)) return;
    unsigned vc00 = S.a_off(cur, 0, RA[0], CA[0]), vc01 = S.a_off(cur, 0, RA[1], CA[1]), vc10 = S.a_off(cur, 1, RA[0], CA[0]), vc11 = S.a_off(cur, 1, RA[1], CA[1]);
    asm volatile("" : "+v"(vc00), "+v"(vc01), "+v"(vc10), "+v"(vc11));
    f32x4 acc[2][2][4][2];
#pragma unroll
    for (int a = 0; a < 2; ++a)
#pragma unroll
        for (int b = 0; b < 2; ++b)
#pragma unroll
            for (int m = 0; m < 4; ++m)
#pragma unroll
                for (int n = 0; n < 2; ++n) acc[a][b][m][n] = (f32x4){0.f, 0.f, 0.f, 0.f};
    bf16x8 At[4][2], B0[2][2], B1[2][2];
    const char* cB = S.b_ptr(cur);
    PG8_STAGEB(PG8_SB(0, 0), cB); PG8_STAGEB(PG8_SB(0, 1), cB + hstep); PG8_STAGEA(PG8_SA(0, 0), 0, vc00, vc01); PG8_STAGEA(PG8_SA(0, 1), 0, vc10, vc11);
    if (wr == 1) PG8_BAR;
    PG8_WAIT_V(2); PG8_BAR;
    PG8_STAGEB(PG8_SB(1, 0), cB + kstep); PG8_STAGEA(PG8_SA(1, 0), kstep, vc00, vc01); PG8_STAGEB(PG8_SB(1, 1), cB + hstep + kstep);
    PG8_WAIT_V(6); PG8_BAR;
    for (;;) {
        const bool has_next = S.next(ui + 1, nxt);
        unsigned vn00 = vc00, vn01 = vc01, vn10 = vc10, vn11 = vc11;
        if (has_next) { vn00 = S.a_off(nxt, 0, RA[0], CA[0]); vn01 = S.a_off(nxt, 0, RA[1], CA[1]); vn10 = S.a_off(nxt, 1, RA[0], CA[0]); vn11 = S.a_off(nxt, 1, RA[1], CA[1]); }
        asm volatile("" : "+v"(vn00), "+v"(vn01), "+v"(vn10), "+v"(vn11));
        const char* nB = has_next ? S.b_ptr(nxt) : cB;
        const bool full = cur.rows > HALF;
        for (int t = 0; t < nt; t += 2) {
            const bool last = (t == nt - 2);
            const size_t k1 = (size_t)(t + 1) * kstep;
            const size_t k2 = last ? 0 : (size_t)(t + 2) * kstep, k3 = k2 + kstep;
            const char* b2 = last ? nB : cB + (size_t)(t + 2) * kstep; const char* b3 = b2 + kstep;
            const unsigned s00 = last ? vn00 : vc00, s01 = last ? vn01 : vc01, s10 = last ? vn10 : vc10, s11 = last ? vn11 : vc11;
            PG8_LDB(B0, 0, 0); PG8_LDB(B1, 0, 1); PG8_SCHED; PG8_LDA(At, 0, 0); PG8_STAGEA(PG8_SA(1, 1), k1, vc10, vc11);
            PG8_WAIT_V(8); PG8_WAIT_L(0); PG8_BAR; PG8_MMA(0, 0, At, B0); PG8_MMA(0, 1, At, B1); PG8_BAR; PG8_SCHED;
            PG8_LDA(At, 0, 1); PG8_STAGEB(PG8_SB(0, 0), b2); PG8_STAGEB(PG8_SB(0, 1), b2 + hstep); PG8_STAGEA(PG8_SA(0, 0), k2, s00, s01);
            PG8_WAIT_V(8); PG8_WAIT_L(0); PG8_BAR; if (full) { PG8_MMA(1, 0, At, B0); PG8_MMA(1, 1, At, B1); } PG8_BAR; PG8_SCHED;
            PG8_LDB(B0, 1, 0); PG8_LDB(B1, 1, 1); PG8_SCHED; PG8_LDA(At, 1, 0); PG8_STAGEA(PG8_SA(0, 1), k2, s10, s11);
            PG8_WAIT_V(8); PG8_WAIT_L(0); PG8_BAR; PG8_MMA(0, 0, At, B0); PG8_MMA(0, 1, At, B1); PG8_BAR; PG8_SCHED;
            PG8_LDA(At, 1, 1); PG8_STAGEB(PG8_SB(1, 0), b3); PG8_STAGEB(PG8_SB(1, 1), b3 + hstep); PG8_STAGEA(PG8_SA(1, 0), k3, s00, s01);
            PG8_WAIT_V(8); PG8_WAIT_L(0); PG8_BAR; if (full) { PG8_MMA(1, 0, At, B0); PG8_MMA(1, 1, At, B1); } PG8_BAR; PG8_SCHED;
        }
        if (wr == 0) PG8_BAR;
        if constexpr (TIME) { const unsigned long long t0_ = __builtin_amdgcn_s_memrealtime(); E(acc, cur, wr, wc, fr, fq); asm volatile("s_waitcnt vmcnt(0)" ::: "memory"); *tacc += __builtin_amdgcn_s_memrealtime() - t0_; }
        else E(acc, cur, wr, wc, fr, fq);
        if (!has_next) break;
#pragma unroll
        for (int a = 0; a < 2; ++a)
#pragma unroll
            for (int b = 0; b < 2; ++b)
#pragma unroll
                for (int m = 0; m < 4; ++m)
#pragma unroll
                    for (int n = 0; n < 2; ++n) acc[a][b][m][n] = (f32x4){0.f, 0.f, 0.f, 0.f};
        cur = nxt; cB = nB; vc00 = vn00; vc01 = vn01; vc10 = vn10; vc11 = vn11; ++ui;
        if (wr == 1) PG8_BAR;
    }
    PG8_WAIT_V(0);
    PG8_BAR;
#undef PG8_SA
#undef PG8_SB
#undef PG8_STAGEA
#undef PG8_STAGEB
#undef PG8_LDA
#undef PG8_LDB
#undef PG8_MMA
#undef PG8_WAIT_V
#undef PG8_WAIT_L
#undef PG8_BAR
#undef PG8_SCHED
}

struct EpiInProj {
    static constexpr bool PERM = true;
    bf16_t *Q, *Kb, *V, *U, *QM; unsigned* nrm;
    __device__ __forceinline__ void operator()(const f32x4 (&acc)[2][2][4][2], const Unit& u, int wr, int wc, int fr, int fq) const {
        bf16_t* base; int ldc, colt; float sc = 1.f; const int pn = u.pn;
        float nmax[2] = {0.f, 0.f};
        if (pn < 2) { base = Q; ldc = 512; colt = pn * 256; sc = C2; } else if (pn < 4) { base = Kb; ldc = 512; colt = (pn - 2) * 256; } else if (pn < 6) { base = V; ldc = 512; colt = (pn - 4) * 256; }
        else if (pn == 6) { base = U; ldc = 256; colt = 0; } else { base = QM; ldc = 256; colt = 0; sc = C2; }
        const int row0 = u.pm * BM + wr * 64 + fr, col0 = colt + wc * 32 + 8 * fq;
#pragma unroll
        for (int ai = 0; ai < 2; ++ai)
#pragma unroll
            for (int m = 0; m < 4; ++m) { bf16_t* rowp = base + (size_t)(row0 + ai * HALF + m * 16) * ldc + col0;
#pragma unroll
                for (int bj = 0; bj < 2; ++bj) { const f32x4 v0 = acc[ai][bj][m][0] * sc, v1 = acc[ai][bj][m][1] * sc;
                    u32x4 w; w.x = cvt_pk_bf16(v0[0], v0[1]); w.y = cvt_pk_bf16(v0[2], v0[3]); w.z = cvt_pk_bf16(v1[0], v1[1]); w.w = cvt_pk_bf16(v1[2], v1[3]);
                    *(u32x4*)(rowp + bj * HALF) = w;
                    if (pn < 4) { float q = (v0[0] * v0[0] + v0[1] * v0[1]) + (v0[2] * v0[2] + v0[3] * v0[3]) + (v1[0] * v1[0] + v1[1] * v1[1]) + (v1[2] * v1[2] + v1[3] * v1[3]);
                        q += __shfl_xor(q, 16); q += __shfl_xor(q, 32); nmax[bj] = fmaxf(nmax[bj], q); } } }
        if (pn < 4) {
#pragma unroll
            for (int bj = 0; bj < 2; ++bj) { float q = nmax[bj];
#pragma unroll
                for (int o = 1; o < 16; o <<= 1) q = fmaxf(q, __shfl_xor(q, o));
                if (fr == 0 && fq == 0) { const int b = (u.pm * BM) / SEQ, h = (pn & 1) * 4 + 2 * bj + (wc >> 1), kind = pn >> 1;
                    atomicMax(nrm + ((b * 8 + h) * 2 + kind) * 2 + (wc & 1), __float_as_uint(q)); } }
        }
    }
};
struct EpiBf16 {
    static constexpr bool PERM = true;
    bf16_t* O; int ldc;
    __device__ __forceinline__ void operator()(const f32x4 (&acc)[2][2][4][2], const Unit& u, int wr, int wc, int fr, int fq) const {
        const int row0 = u.pm * BM + wr * 64 + fr, col0 = u.pn * BM + wc * 32 + 8 * fq;
#pragma unroll
        for (int ai = 0; ai < 2; ++ai)
#pragma unroll
            for (int m = 0; m < 4; ++m) { bf16_t* rowp = O + (size_t)(row0 + ai * HALF + m * 16) * ldc + col0;
#pragma unroll
                for (int bj = 0; bj < 2; ++bj) { const f32x4 v0 = acc[ai][bj][m][0], v1 = acc[ai][bj][m][1];
                    u32x4 w; w.x = cvt_pk_bf16(v0[0], v0[1]); w.y = cvt_pk_bf16(v0[2], v0[3]); w.z = cvt_pk_bf16(v1[0], v1[1]); w.w = cvt_pk_bf16(v1[2], v1[3]);
                    *(u32x4*)(rowp + bj * HALF) = w; } }
    }
};
struct EpiRes16 {
    static constexpr bool PERM = true;
    bf16_t* O; const float* R; float rs;
    __device__ __forceinline__ void operator()(const f32x4 (&acc)[2][2][4][2], const Unit& u, int wr, int wc, int fr, int fq) const {
        const int row0 = u.pm * BM + wr * 64 + fr, col0 = u.pn * BM + wc * 32 + 8 * fq;
#pragma unroll
        for (int ai = 0; ai < 2; ++ai)
#pragma unroll
            for (int m = 0; m < 4; ++m) { const size_t row = (size_t)(row0 + ai * HALF + m * 16);
#pragma unroll
                for (int bj = 0; bj < 2; ++bj) { const float* rp = R + row * DM + col0 + bj * HALF;
                    const f32x4 v0 = acc[ai][bj][m][0] + *(const f32x4*)rp * rs, v1 = acc[ai][bj][m][1] + *(const f32x4*)(rp + 4) * rs;
                    u32x4 w; w.x = cvt_pk_bf16(v0[0], v0[1]); w.y = cvt_pk_bf16(v0[2], v0[3]); w.z = cvt_pk_bf16(v1[0], v1[1]); w.w = cvt_pk_bf16(v1[2], v1[3]);
                    *(u32x4*)(O + row * (2 * DM) + col0 + bj * HALF) = w; }
                if (m & 1) asm volatile("" ::: "memory"); }
    }
};
struct EpiF32 {
    static constexpr bool PERM = false;
    float* C; int ldc; const float* R; float rs;
    __device__ __forceinline__ void operator()(const f32x4 (&acc)[2][2][4][2], const Unit& u, int wr, int wc, int fr, int fq) const {
        const int row0 = u.pm * BM + wr * 64 + fr, col0 = u.pn * BM + wc * 32 + 4 * fq;
#pragma unroll
        for (int ai = 0; ai < 2; ++ai)
#pragma unroll
            for (int m = 0; m < 4; ++m) { const size_t off = (size_t)(row0 + ai * HALF + m * 16) * ldc + col0;
#pragma unroll
                for (int bj = 0; bj < 2; ++bj)
#pragma unroll
                    for (int n = 0; n < 2; ++n) { f32x4 v = acc[ai][bj][m][n]; if (R) v += *(const f32x4*)(R + off + bj * HALF + n * 16) * rs; *(f32x4*)(C + off + bj * HALF + n * 16) = v; }
                if (m & 1) asm volatile("" ::: "memory"); }
    }
};
struct EpiGateUp {
    static constexpr bool PERM = true;
    bf16_t* H;
    __device__ __forceinline__ void operator()(const f32x4 (&acc)[2][2][4][2], const Unit& u, int wr, int wc, int fr, int fq) const {
        const int row0 = u.pm * BM + wr * 64 + fr, col0 = u.pn * 128 + wc * 32 + 8 * fq;
#pragma unroll
        for (int ai = 0; ai < 2; ++ai)
#pragma unroll
            for (int m = 0; m < 4; ++m) { bf16_t* rowp = H + (size_t)(row0 + ai * HALF + m * 16) * EH + col0; float hv[8];
#pragma unroll
                for (int n = 0; n < 2; ++n)
#pragma unroll
                    for (int j = 0; j < 4; ++j) { const float g = acc[ai][0][m][n][j], up = acc[ai][1][m][n][j]; hv[n * 4 + j] = g * __builtin_amdgcn_rcpf(1.f + __builtin_amdgcn_exp2f(-g * LOG2E)) * up; }
                u32x4 w; w.x = cvt_pk_bf16(hv[0], hv[1]); w.y = cvt_pk_bf16(hv[2], hv[3]); w.z = cvt_pk_bf16(hv[4], hv[5]); w.w = cvt_pk_bf16(hv[6], hv[7]);
                *(u32x4*)rowp = w; }
    }
};
struct EpiDown {
    static constexpr bool PERM = true;
    bf16_t* Y; float* SH; const int* bins; const float* gates;
    __device__ __forceinline__ void operator()(const f32x4 (&acc)[2][2][4][2], const Unit& u, int wr, int wc, int fr, int fq) const {
        const int col0 = u.pn * BM + wc * 32 + 8 * fq;
        if (u.e == NE) {
#pragma unroll
            for (int ai = 0; ai < 2; ++ai)
#pragma unroll
                for (int m = 0; m < 4; ++m) { const int tok = u.mt * 256 + ai * HALF + wr * 64 + m * 16 + fr; bf16_t* rowp = (bf16_t*)(SH + (size_t)tok * DM) + col0;
#pragma unroll
                    for (int bj = 0; bj < 2; ++bj) { const f32x4 v0 = acc[ai][bj][m][0], v1 = acc[ai][bj][m][1];
                        u32x4 w; w.x = cvt_pk_bf16(v0[0], v0[1]); w.y = cvt_pk_bf16(v0[2], v0[3]); w.z = cvt_pk_bf16(v1[0], v1[1]); w.w = cvt_pk_bf16(v1[2], v1[3]);
                        *(u32x4*)(rowp + bj * HALF) = w; } }
        } else {
#pragma unroll
            for (int ai = 0; ai < 2; ++ai)
#pragma unroll
                for (int m = 0; m < 4; ++m) { const int rl = ai * HALF + wr * 64 + m * 16 + fr; if (rl >= u.rows) continue;
                    unsigned char* rowp = (unsigned char*)Y + (size_t)(u.pm * 256 + rl) * DM + col0;
#pragma unroll
                    for (int bj = 0; bj < 2; ++bj) { const f32x4 v0 = acc[ai][bj][m][0] * YSCALE, v1 = acc[ai][bj][m][1] * YSCALE;
                        int w0 = 0, w1 = 0; w0 = __builtin_amdgcn_cvt_pk_fp8_f32(v0[0], v0[1], w0, false); w0 = __builtin_amdgcn_cvt_pk_fp8_f32(v0[2], v0[3], w0, true);
                        w1 = __builtin_amdgcn_cvt_pk_fp8_f32(v1[0], v1[1], w1, false); w1 = __builtin_amdgcn_cvt_pk_fp8_f32(v1[2], v1[3], w1, true);
                        *(u32x2*)(rowp + bj * HALF) = (u32x2){(unsigned)w0, (unsigned)w1}; } }
        }
    }
};
}


__device__ __forceinline__ unsigned cvtpk_bg(float lo, float hi) { unsigned r; asm volatile("v_cvt_pk_bf16_f32 %0, %1, %2" : "=v"(r) : "v"(lo), "v"(hi)); return r; }
struct ConvBg {
    const float *w_gate, *w_up, *w_down, *ws_gate, *ws_up, *ws_down; bf16_t *WGU, *WD;
    LAS float* scr; int lane, it, it0, end, stride, nl; bool pend; f32x4 v[8]; bf16_t* dst; int ldt;
    static constexpr int NIT = (NE + 1) * 384;
    __device__ __forceinline__ void decode(int r, const float*& src, int& ldw) {
        const int e = r / 384; r -= e * 384;
        if (r < 256) { const int up = r >> 7; r &= 127; const int kb = r >> 3, nb = r & 7, n0 = nb * 32;
            src = ((e < NE) ? ((up ? w_up : w_gate) + (size_t)e * DM * EH) : (up ? ws_up : ws_gate)) + (size_t)kb * 64 * EH + n0; ldw = EH;
            const int drow = (n0 >> 7) * 256 + up * 128 + (n0 & 127); dst = WGU + ((size_t)e * 512 + drow) * DM + kb * 64; ldt = DM;
        } else { r -= 256; const int kb = r >> 5, nb = r & 31;
            src = ((e < NE) ? (w_down + (size_t)e * EH * DM) : ws_down) + (size_t)kb * 64 * DM + nb * 32; ldw = DM;
            dst = WD + ((size_t)e * DM + nb * 32) * EH + kb * 64; ldt = EH; }
    }
    __device__ __forceinline__ void finish() {
        if (!pend) return;
        const int kq = lane >> 3, n4 = (lane & 7) * 4;
#pragma unroll
        for (int i = 0; i < 8; ++i) { LAS float* p = scr + (8 * i + kq) * 33 + n4; p[0] = v[i].x; p[1] = v[i].y; p[2] = v[i].z; p[3] = v[i].w; }
        LDS_WAIT(); asm volatile("" ::: "memory");
        const int c8 = lane & 7;
#pragma unroll
        for (int j = 0; j < 4; ++j) { const int n = (lane >> 3) + 8 * j; const LAS float* s = scr + (8 * c8) * 33 + n;
            u32x4 o; o.x = cvtpk_bg(s[0 * 33], s[1 * 33]); o.y = cvtpk_bg(s[2 * 33], s[3 * 33]); o.z = cvtpk_bg(s[4 * 33], s[5 * 33]); o.w = cvtpk_bg(s[6 * 33], s[7 * 33]);
            *(u32x4*)(dst + (size_t)n * ldt + 8 * c8) = o; }
        LDS_WAIT(); asm volatile("" ::: "memory");
        pend = false;
    }
    __device__ __forceinline__ void issue() {
        const bool valid = it < end; const float* src; int ldw; decode(valid ? it : it0, src, ldw);
        const int kq = lane >> 3, n4 = (lane & 7) * 4;
#pragma unroll
        for (int i = 0; i < 8; ++i) v[i] = __builtin_nontemporal_load((const f32x4*)(src + (size_t)(8 * i + kq) * ldw + n4));
        pend = valid; if (valid) it += stride; nl = 8;
    }
    __device__ __forceinline__ bool busy() const { return pend || it < end; }
};
struct NoBg { int nl; __device__ __forceinline__ void finish() {} __device__ __forceinline__ void issue() { nl = 0; } };

namespace att {
constexpr int SLOTB = 8192, L_K = 0, L_V = 2 * SLOTB, L_WS = 4 * SLOTB, L_OST = L_WS + 8 * 256, L_FK = L_OST + 8 * 4096, L_END = L_FK + 16384;
#define SBAR() __builtin_amdgcn_sched_barrier(0)
__device__ __forceinline__ int crow(int r, int hi) { return (r & 3) + 8 * (r >> 2) + 4 * hi; }
__device__ __forceinline__ void glds16(const void* gsrc, unsigned lds_dst) { unsigned keep;
    asm volatile("s_mov_b32 %0, m0\n\ts_mov_b32 m0, %2\n\ts_nop 0\n\tglobal_load_lds_dwordx4 %1, off\n\ts_mov_b32 m0, %0" : "=&s"(keep) : "v"(gsrc), "s"(lds_dst) : "memory"); }
__device__ __forceinline__ unsigned cvtpk(float lo, float hi) { unsigned r; asm("v_cvt_pk_bf16_f32 %0, %1, %2" : "=v"(r) : "v"(lo), "v"(hi)); return r; }
#define ATT_WAIT_BAR() asm volatile("s_waitcnt vmcnt(0) lgkmcnt(0)\n\ts_barrier" ::: "memory")

struct Job { const bf16_t* Q; int qpitch; const bf16_t* K; const bf16_t* V; int kvpitch; bf16_t* O; int nt; int causal; const float* FC; int q0; float qk2; };
constexpr float SKIP_LOG2 = 36.f;

template <bool FOX, class Bg> __device__ __forceinline__ void unit(const Job& j, LAS unsigned char* shm, Bg& bg) {
    const int tid = threadIdx.x, lane = tid & 63, r32 = lane & 31, hi = lane >> 5; const int wid = __builtin_amdgcn_readfirstlane(tid >> 6);
    const unsigned lds0 = (unsigned)(uintptr_t)shm;
    LAS float* wsf = (LAS float*)(shm + L_WS) + wid * 64;
    LAS float* fk = (LAS float*)(shm + L_FK);
    const int NT = j.nt;
    float fq = 0.f; int tlo = 0;
    if (FOX) {
        const float fq0 = j.FC[j.q0];
        const bool keep = (lane < NT) ? (j.qk2 + fq0 - j.FC[64 * lane + 63] >= -SKIP_LOG2) : false;
        const unsigned long long mk = __ballot(keep);
        tlo = (mk != 0ull) ? (int)__builtin_ctzll(mk) : NT - 1; tlo = __builtin_amdgcn_readfirstlane(tlo);
        for (int i = tlo * 16 + tid; i < NT * 16; i += 512) *(LAS f32x4*)(fk + 4 * i) = *(const f32x4*)(j.FC + 4 * i);
        fq = j.FC[j.q0 + wid * 32 + r32];
    }
    const int NTE = NT - tlo;
    const bf16_t* ksrc = j.K + (size_t)lane * j.kvpitch + wid * 8;
    const bf16_t* vsrc = j.V + (size_t)(16 * (wid & 3) + (lane >> 2)) * j.kvpitch + (wid >> 2) * 32 + (lane & 3) * 8;
    const unsigned kdst = lds0 + L_K + wid * 1024, vdst = lds0 + L_V + wid * 1024;
#define DMA_K(t, slot) glds16(ksrc + (size_t)(t) * 64 * j.kvpitch, (unsigned)__builtin_amdgcn_readfirstlane(kdst + (slot) * SLOTB))
#define DMA_V(t, slot) glds16(vsrc + (size_t)(t) * 64 * j.kvpitch, (unsigned)__builtin_amdgcn_readfirstlane(vdst + (slot) * SLOTB))
    const bf16_t* Qw = j.Q + (size_t)(wid * 32) * j.qpitch;
    bf16x8 qr[4];
#pragma unroll
    for (int d0 = 0; d0 < 4; ++d0) qr[d0] = *reinterpret_cast<const bf16x8*>(Qw + (size_t)r32 * j.qpitch + d0 * 16 + hi * 8);
    asm volatile("s_waitcnt vmcnt(0) lgkmcnt(0)" ::: "memory");
    bg.nl = 0;
    { const int t0 = FOX ? NT - 1 : 0; DMA_K(t0, 0); DMA_V(t0, 0); }
    float mrun = -1e30f, l_reg = 0.f; f32x16 o[2]; o[0] = f32x16{}; o[1] = f32x16{};
    const int qrel = wid * 32 + r32;
    for (int it = 0; it < NTE; ++it) {
        const int tcur = FOX ? NT - 1 - it : it, slot = it & 1;
        if (bg.nl == 8) asm volatile("s_waitcnt vmcnt(8) lgkmcnt(0)\n\ts_barrier" ::: "memory");
        else ATT_WAIT_BAR();
        bg.finish();
        if (it + 1 < NTE) { const int tn = FOX ? tcur - 1 : tcur + 1; DMA_K(tn, slot ^ 1); DMA_V(tn, slot ^ 1); }
        bg.issue();
        f32x16 p0, p1;
        if (FOX) {
#pragma unroll
            for (int g = 0; g < 4; ++g) { const f32x4 a = *(const LAS f32x4*)(fk + 64 * tcur + 8 * g + 4 * hi), b = *(const LAS f32x4*)(fk + 64 * tcur + 32 + 8 * g + 4 * hi);
#pragma unroll
                for (int i = 0; i < 4; ++i) { p0[4 * g + i] = fq - a[i]; p1[4 * g + i] = fq - b[i]; } }
        } else { p0 = f32x16{}; p1 = f32x16{}; }
        { const LAS unsigned char* kb = shm + L_K + slot * SLOTB + hi * 1024 + r32 * 16;
#pragma unroll
          for (int d0 = 0; d0 < 4; ++d0) { const bf16x8 b0 = *(const LAS bf16x8*)(kb + d0 * 2048), b1 = *(const LAS bf16x8*)(kb + d0 * 2048 + 512);
              p0 = __builtin_amdgcn_mfma_f32_32x32x16_bf16(b0, qr[d0], p0, 0, 0, 0); p1 = __builtin_amdgcn_mfma_f32_32x32x16_bf16(b1, qr[d0], p1, 0, 0, 0); } }
        if (j.causal && tcur >= NT - 4) { const int kb0 = 64 * (tcur - (NT - 4)) + 4 * hi;
#pragma unroll
            for (int r = 0; r < 16; ++r) { const int kv = kb0 + (r & 3) + 8 * (r >> 2); if (kv > qrel) p0[r] = -INFINITY; if (kv + 32 > qrel) p1[r] = -INFINITY; } }
        float rm = p0[0];
#pragma unroll
        for (int r = 1; r < 16; ++r) rm = fmaxf(rm, p0[r]);
#pragma unroll
        for (int r = 0; r < 16; ++r) rm = fmaxf(rm, p1[r]);
        rm = fmaxf(rm, __shfl_xor(rm, 32));
        const float mn = fmaxf(mrun, rm), alpha = __builtin_amdgcn_exp2f(mrun - mn); mrun = mn;
        float rs = 0.f;
#pragma unroll
        for (int r = 0; r < 16; ++r) { p0[r] = __builtin_amdgcn_exp2f(p0[r] - mn); p1[r] = __builtin_amdgcn_exp2f(p1[r] - mn); rs += p0[r] + p1[r]; }
        l_reg = l_reg * alpha + rs;
        if (hi == 0) wsf[r32] = alpha;
        LDS_WAIT();
#pragma unroll
        for (int r = 0; r < 16; ++r) { const float f = wsf[crow(r, hi)]; o[0][r] *= f; o[1][r] *= f; }
        u32x4 pw0, pw1, pw2, pw3;
        pw0 = (u32x4){cvtpk(p0[0], p0[1]), cvtpk(p0[2], p0[3]), cvtpk(p0[4], p0[5]), cvtpk(p0[6], p0[7])};
        pw1 = (u32x4){cvtpk(p0[8], p0[9]), cvtpk(p0[10], p0[11]), cvtpk(p0[12], p0[13]), cvtpk(p0[14], p0[15])};
        pw2 = (u32x4){cvtpk(p1[0], p1[1]), cvtpk(p1[2], p1[3]), cvtpk(p1[4], p1[5]), cvtpk(p1[6], p1[7])};
        pw3 = (u32x4){cvtpk(p1[8], p1[9]), cvtpk(p1[10], p1[11]), cvtpk(p1[12], p1[13]), cvtpk(p1[14], p1[15])};
        const bf16x8 pa0 = __builtin_bit_cast(bf16x8, pw0), pa1 = __builtin_bit_cast(bf16x8, pw1), pa2 = __builtin_bit_cast(bf16x8, pw2), pa3 = __builtin_bit_cast(bf16x8, pw3);
        const int vb = (int)(lds0 + L_V + slot * SLOTB) + ((lane >> 4) & 1) * 32 + (lane & 3) * 8 + (4 * hi + ((lane & 15) >> 2)) * 64;
#pragma unroll
        for (int d0 = 0; d0 < 2; ++d0) { s16x4 lo[4], hh[4];
#pragma unroll
            for (int ks = 0; ks < 4; ++ks) {
                asm volatile("ds_read_b64_tr_b16 %0,%1 offset:%c2" : "=&v"(lo[ks]) : "v"(vb), "i"(d0 * 4096 + ks * 1024) : "memory");
                asm volatile("ds_read_b64_tr_b16 %0,%1 offset:%c2" : "=&v"(hh[ks]) : "v"(vb), "i"(d0 * 4096 + ks * 1024 + 512) : "memory"); }
            asm volatile("s_waitcnt lgkmcnt(0)" ::: "memory"); SBAR();
#define PK(k) (bf16x8){lo[k][0], lo[k][1], lo[k][2], lo[k][3], hh[k][0], hh[k][1], hh[k][2], hh[k][3]}
            o[d0] = __builtin_amdgcn_mfma_f32_32x32x16_bf16(pa0, PK(0), o[d0], 0, 0, 0);
            o[d0] = __builtin_amdgcn_mfma_f32_32x32x16_bf16(pa1, PK(1), o[d0], 0, 0, 0);
            o[d0] = __builtin_amdgcn_mfma_f32_32x32x16_bf16(pa2, PK(2), o[d0], 0, 0, 0);
            o[d0] = __builtin_amdgcn_mfma_f32_32x32x16_bf16(pa3, PK(3), o[d0], 0, 0, 0);
#undef PK
        }
    }
    l_reg += __shfl_xor(l_reg, 32);
    if (hi == 0) wsf[32 + r32] = l_reg;
    LDS_WAIT();
    float rli[16];
#pragma unroll
    for (int r = 0; r < 16; ++r) rli[r] = 1.0f / wsf[32 + crow(r, hi)];
    bf16_t* Ow = j.O + (size_t)(wid * 32) * DM;
    { LAS bf16_t* stg = (LAS bf16_t*)(shm + L_OST) + wid * 2048;
#pragma unroll
      for (int r = 0; r < 16; ++r) { const int orow = crow(r, hi);
#pragma unroll
          for (int d0 = 0; d0 < 2; ++d0) stg[orow * 64 + d0 * 32 + r32] = (bf16_t)f2bf(o[d0][r] * rli[r]); }
      LDS_WAIT();
#pragma unroll
      for (int i = 0; i < 4; ++i) { const int row = i * 8 + (lane >> 3), ch = lane & 7; const u32x4 v = *(const LAS u32x4*)(stg + row * 64 + ch * 8); *(u32x4*)(Ow + (size_t)row * DM + ch * 8) = v; } }
    asm volatile("s_waitcnt vmcnt(0) lgkmcnt(0)\n\ts_barrier" ::: "memory");
#undef DMA_K
#undef DMA_V
}
#undef SBAR
}

#define XB_TMO      128
#define XB_XCNT(j)  (256  + 64 * (j))
#define XB_XSUB(j)  (1280 + 64 * (j))
#define XB_XGEN(j)  (2304 + 64 * (j))
#define XB_TOP      3328
#define XB_TOPGEN   3392
#define XCD_BAR_WORDS 3456
#define XB_SPIN_CAP (1u << 18)
constexpr int CW_BAR = 32768;
__device__ __forceinline__ unsigned xb_ld(unsigned* p)              { return __hip_atomic_load(p, __ATOMIC_RELAXED, __HIP_MEMORY_SCOPE_AGENT); }
__device__ __forceinline__ unsigned xb_add(unsigned* p, unsigned v) { return __hip_atomic_fetch_add(p, v, __ATOMIC_RELAXED, __HIP_MEMORY_SCOPE_AGENT); }
__device__ __forceinline__ unsigned xb_xcc_id() { return (unsigned)__builtin_amdgcn_s_getreg((3 << 11) | 20) & 0xFu; }
#define XB_SPIN(cond, bar) do { unsigned _sp = 0; while (cond) { __builtin_amdgcn_s_sleep(1); \
    if ((++_sp & 255u) == 0u) { if (xb_ld(&(bar)[XB_TMO])) break; if (_sp > XB_SPIN_CAP) { atomicAdd(&(bar)[XB_TMO], 1u); break; } } } } while (0)
struct XcdBarrier { unsigned* bar; unsigned x; volatile LAS unsigned* st; };
__device__ __forceinline__ XcdBarrier xcd_barrier_post(unsigned* bar, volatile LAS unsigned* st) {
    XcdBarrier b; b.bar = bar; b.x = xb_xcc_id(); b.st = st;
    if (threadIdx.x == 0) (void)xb_add(&bar[XB_XCNT(b.x)], 1u);
    return b;
}
__device__ __forceinline__ void xcd_barrier_complete(unsigned* bar, unsigned x, unsigned& nloc, unsigned& nx) {
    const unsigned G = gridDim.x * gridDim.y * gridDim.z;
    unsigned sum, cnt, mine, sp = 0u;
    for (;;) {
        sum = 0u; cnt = 0u; mine = 0u;
#pragma unroll
        for (unsigned j = 0; j < 16; ++j) { const unsigned c = xb_ld(&bar[XB_XCNT(j)]); sum += c; cnt += (c > 0u) ? 1u : 0u; mine = (j == x) ? c : mine; }
        if (sum == G) break;
        __builtin_amdgcn_s_sleep(1);
        if ((++sp & 255u) == 0u) { if (xb_ld(&bar[XB_TMO])) break; if (sp > XB_SPIN_CAP) { atomicAdd(&bar[XB_TMO], 1u); break; } }
    }
    nloc = mine > 0u ? mine : 1u; nx = cnt > 0u ? cnt : 1u;
}
__device__ __forceinline__ void xcd_barrier(const XcdBarrier& b) {
    asm volatile("s_waitcnt vmcnt(0)" ::: "memory");
    __syncthreads();
    if (threadIdx.x == 0) {
        unsigned* bar = b.bar;
        __builtin_amdgcn_s_waitcnt(0);
        unsigned nloc = b.st[0], nx = b.st[1];
        if (nloc == 0u) { xcd_barrier_complete(bar, b.x, nloc, nx); b.st[0] = nloc; b.st[1] = nx; }
        const unsigned old = xb_add(&bar[XB_XSUB(b.x)], 1u);
        const unsigned gen = old / nloc;
        if (old + 1u == (gen + 1u) * nloc) {
            __builtin_amdgcn_fence(__ATOMIC_RELEASE, "agent");
            asm volatile("s_waitcnt vmcnt(0)" ::: "memory");
            const unsigned og = xb_add(&bar[XB_TOP], 1u);
            const unsigned tg = og / nx;
            if (og + 1u == (tg + 1u) * nx) xb_add(&bar[XB_TOPGEN], 1u);
            else XB_SPIN(xb_ld(&bar[XB_TOPGEN]) == tg, bar);
            __builtin_amdgcn_fence(__ATOMIC_ACQUIRE, "agent");
            xb_add(&bar[XB_XGEN(b.x)], 1u);
            asm volatile("s_waitcnt vmcnt(0)" ::: "memory");
        } else {
            XB_SPIN(xb_ld(&bar[XB_XGEN(b.x)]) == gen, bar);
            __builtin_amdgcn_fence(__ATOMIC_ACQUIRE, "agent");
            asm volatile("s_waitcnt vmcnt(0)" ::: "memory");
        }
    }
    __syncthreads();
}

struct Ctx { int tid, lane, wave, vcu, G; LAS unsigned char* lds; };

__device__ __forceinline__ unsigned cvtpk_hw(float lo, float hi) { unsigned r; asm volatile("v_cvt_pk_bf16_f32 %0, %1, %2" : "=v"(r) : "v"(lo), "v"(hi)); return r; }
__device__ __forceinline__ void tr_item64(const float* W, int ldw, bf16_t* WT, int ldt, LAS float* scr, int lane) {
    const int kr = lane >> 4, n4 = (lane & 15) * 4;
#pragma unroll
    for (int hb = 0; hb < 2; ++hb) { f32x4 v[8];
#pragma unroll
        for (int i = 0; i < 8; ++i) v[i] = __builtin_nontemporal_load((const f32x4*)(W + (size_t)(4 * (8 * hb + i) + kr) * ldw + n4));
#pragma unroll
        for (int i = 0; i < 8; ++i) { LAS float* p = scr + (4 * (8 * hb + i) + kr) * 65 + n4; p[0] = v[i].x; p[1] = v[i].y; p[2] = v[i].z; p[3] = v[i].w; } }
    LDS_WAIT(); asm volatile("" ::: "memory");
    const int kc = lane & 7;
#pragma unroll
    for (int j = 0; j < 8; ++j) { const int n = (lane >> 3) + 8 * j; const LAS float* s = scr + (8 * kc) * 65 + n;
        u32x4 o; o.x = cvtpk_hw(s[0 * 65], s[1 * 65]); o.y = cvtpk_hw(s[2 * 65], s[3 * 65]); o.z = cvtpk_hw(s[4 * 65], s[5 * 65]); o.w = cvtpk_hw(s[6 * 65], s[7 * 65]);
        *(u32x4*)(WT + (size_t)n * ldt + 8 * kc) = o; }
    LDS_WAIT(); asm volatile("" ::: "memory");
}

__device__ __forceinline__ void p0_prologue(const Args& a, const Ctx& c) {
    unsigned char* ws = a.ws;
    bf16_t* WGU = (bf16_t*)(ws + WS_WGU); bf16_t* WD = (bf16_t*)(ws + WS_WD); bf16_t* WIN = (bf16_t*)(ws + WS_WIN); bf16_t* WMKV = (bf16_t*)(ws + WS_WMKV);
    bf16_t* WOUT = (bf16_t*)(ws + WS_WOUT); bf16_t* WR = (bf16_t*)(ws + WS_WR);
    LAS float* WfT = (LAS float*)c.lds;
    LAS float* scr = (LAS float*)(c.lds + c.wave * 16640);
    const int gw = c.vcu * 8 + c.wave, NGW = c.G * 8;
    constexpr int NEXP_ITEMS = 0;
    constexpr int I_WIN = 512, I_MKV = 128, I_OUT = 192, I_R = 64;
    constexpr int NITEMS = NEXP_ITEMS + I_WIN + I_MKV + I_OUT + I_R;
    for (int it = gw; it < NITEMS; it += NGW) {
        int r = it;
        if (r < NEXP_ITEMS) { const int e = r / 192; r -= e * 192;
            if (r < 128) { const int up = r >> 6; r &= 63; const int kb = r >> 2, nb = r & 3, n0 = nb * 64;
                const float* src = (e < NE) ? ((up ? a.w_up : a.w_gate) + (size_t)e * DM * EH) : (up ? a.ws_up : a.ws_gate);
                const int drow = (n0 >> 7) * 256 + up * 128 + (n0 & 127);
                tr_item64(src + (size_t)kb * 64 * EH + n0, EH, WGU + ((size_t)e * 512 + drow) * DM + kb * 64, DM, scr, c.lane);
            } else { r -= 128; const int kb = r >> 4, nb = r & 15;
                const float* src = (e < NE) ? (a.w_down + (size_t)e * EH * DM) : a.ws_down;
                tr_item64(src + (size_t)kb * 64 * DM + nb * 64, DM, WD + ((size_t)e * DM + nb * 64) * EH + kb * 64, EH, scr, c.lane); }
            continue; }
        r -= NEXP_ITEMS;
        if (r < I_WIN) {
            int col0, drow0, nbw;
            if (r < 128) { col0 = 256; drow0 = 0; nbw = 8; } else if (r < 256) { r -= 128; col0 = 768; drow0 = 512; nbw = 8; } else if (r < 384) { r -= 256; col0 = 1280; drow0 = 1024; nbw = 8; }
            else if (r < 448) { r -= 384; col0 = 0; drow0 = 1536; nbw = 4; } else { r -= 448; col0 = 1800; drow0 = 1792; nbw = 4; }
            const int kb = r / nbw, nb = r % nbw;
            tr_item64(a.w_in + (size_t)kb * 64 * INC + col0 + nb * 64, INC, WIN + (size_t)(drow0 + nb * 64) * DM + kb * 64, DM, scr, c.lane);
            continue; }
        r -= I_WIN;
        if (r < I_MKV) { const int kb = r >> 3, nb = r & 7; tr_item64(a.w_mem_kv + (size_t)kb * 64 * 512 + nb * 64, 512, WMKV + (size_t)(nb * 64) * DM + kb * 64, DM, scr, c.lane); continue; }
        r -= I_MKV;
        if (r < I_OUT) { const int kb = r >> 4, nb = r & 15; tr_item64(a.w_out + (size_t)(256 + kb * 64) * DM + nb * 64, DM, WOUT + (size_t)(nb * 64) * DM + 256 + kb * 64, DM, scr, c.lane); continue; }
        r -= I_OUT;
        { const int kb = r >> 2, nb = r & 3; tr_item64(a.w_router + (size_t)kb * 64 * NE + nb * 64, NE, WR + (size_t)(nb * 64) * DM + kb * 64, DM, scr, c.lane); }
    }
    __syncthreads();
    for (int idx = c.tid; idx < 8192; idx += 512) { const int h = idx & 7, k = idx >> 3; WfT[h * 1024 + k] = a.w_in[(size_t)k * INC + 1792 + h]; }
    for (int idx = (c.vcu * 512 + c.tid); idx < 256 * 1024; idx += c.G * 512) { const int k = idx >> 10, n = idx & 1023, g = k >> 6, cc = k & 63; float s = 0.f;
        for (int d = 0; d < 64; ++d) s += a.w_pool[g * 4096 + cc * 64 + d] * a.pool_scale[g * 64 + d] * a.w_out[(size_t)(g * 64 + d) * DM + n];
        WOUT[(size_t)n * DM + k] = (bf16_t)f2bf(s); }
    __syncthreads();
    bf16_t* XB = (bf16_t*)(ws + WS_XB); float* FLOG = (float*)(ws + WS_FLOG);
    for (int m = gw; m < T; m += NGW) {
        const f32x4* xr = (const f32x4*)(a.x + (size_t)m * DM) + c.lane; f32x4 v[4];
#pragma unroll
        for (int j = 0; j < 4; ++j) v[j] = xr[64 * j];
        u32x2* o8 = (u32x2*)(XB + (size_t)m * DM) + c.lane;
#pragma unroll
        for (int j = 0; j < 4; ++j) o8[64 * j] = (u32x2){pk2(v[j].x, v[j].y), pk2(v[j].z, v[j].w)};
        float acc[8];
#pragma unroll
        for (int h = 0; h < 8; ++h) { float s = 0.f;
#pragma unroll
            for (int j = 0; j < 4; ++j) { const f32x4 w = *(const LAS f32x4*)(WfT + h * 1024 + 4 * c.lane + 256 * j); s += (v[j].x * w.x + v[j].y * w.y) + (v[j].z * w.z + v[j].w * w.w); }
            acc[h] = s; }
        float b4[4], b2[2], z;
        { const bool up = (c.lane & 32) != 0;
#pragma unroll
          for (int i = 0; i < 4; ++i) { const float keep = up ? acc[4 + i] : acc[i], give = up ? acc[i] : acc[4 + i]; b4[i] = keep + __shfl_xor(give, 32); } }
        { const bool up = (c.lane & 16) != 0;
#pragma unroll
          for (int i = 0; i < 2; ++i) { const float keep = up ? b4[2 + i] : b4[i], give = up ? b4[i] : b4[2 + i]; b2[i] = keep + __shfl_xor(give, 16); } }
        { const bool up = (c.lane & 8) != 0; const float keep = up ? b2[1] : b2[0], give = up ? b2[0] : b2[1]; z = keep + __shfl_xor(give, 8); }
        z += __shfl_xor(z, 4); z += __shfl_xor(z, 2); z += __shfl_xor(z, 1);
        if ((c.lane & 7) == 0) { const int h = ((c.lane >> 5) & 1) * 4 + ((c.lane >> 4) & 1) * 2 + ((c.lane >> 3) & 1); z += a.b_f[h];
            const float lf = (z >= 0.f) ? -log1pf(expf(-z)) : (z - log1pf(expf(z))); FLOG[(size_t)m * 8 + h] = lf; }
    }
    bf16_t* MEMB = (bf16_t*)(ws + WS_MEMB);
    for (int m = gw; m < NB * 256; m += NGW) {
        const f32x4* xr = (const f32x4*)(a.mem + (size_t)m * DM) + c.lane; u32x2* o8 = (u32x2*)(MEMB + (size_t)m * DM) + c.lane;
#pragma unroll
        for (int j = 0; j < 4; ++j) { const f32x4 v = xr[64 * j]; o8[64 * j] = (u32x2){pk2(v.x, v.y), pk2(v.z, v.w)}; }
    }
}

__device__ __forceinline__ void p1_fscan(const Args& a, const Ctx& c) {
    if (c.vcu >= 64) return;
    const float* FLOG = (const float*)(a.ws + WS_FLOG); float* FC = (float*)(a.ws + WS_FC);
    LAS float* wtot = (LAS float*)c.lds;
    const int bh = c.vcu, b = bh >> 3, h = bh & 7; float p[8]; float run = 0.f;
#pragma unroll
    for (int i = 0; i < 8; ++i) { run += FLOG[((size_t)b * SEQ + c.tid * 8 + i) * 8 + h]; p[i] = run; }
    float inc = run;
#pragma unroll
    for (int o = 1; o < 64; o <<= 1) { const float t = __shfl_up(inc, o); if (c.lane >= o) inc += t; }
    if (c.lane == 63) wtot[c.wave] = inc;
    __syncthreads();
    float base = inc - run;
    for (int w = 0; w < c.wave; ++w) base += wtot[w];
#pragma unroll
    for (int i = 0; i < 8; ++i) FC[(size_t)bh * SEQ + c.tid * 8 + i] = (base + p[i]) * LOG2E;
    __syncthreads();
}

__device__ __forceinline__ void p2_mixers(const Args& a, const Ctx& c) {
    unsigned char* ws = a.ws;
    const bf16_t* Q = (const bf16_t*)(ws + WS_Q); const bf16_t* Kb = (const bf16_t*)(ws + WS_K); const bf16_t* V = (const bf16_t*)(ws + WS_V); const bf16_t* QM = (const bf16_t*)(ws + WS_QM);
    const bf16_t* U = (const bf16_t*)(ws + WS_U); const bf16_t* KVM = (const bf16_t*)(ws + WS_KVM); bf16_t* YMIX = (bf16_t*)(ws + WS_YMIX); const float* FC = (const float*)(ws + WS_FC);
    { const int cp = c.tid & 127, rg = c.tid >> 7, ch = 2 * cp, w = 2 << (ch >> 6);
      for (int i = 0; i < 32; ++i) { const int t = c.vcu * 128 + rg * 32 + i; if (t >= T) break; const int pos = t & (SEQ - 1), cnt = (pos + 1 < w) ? pos + 1 : w;
          float s0 = 0.f, s1 = 0.f, u0 = 0.f, u1 = 0.f;
          for (int jw = 0; jw < cnt; ++jw) { const unsigned wv = *(const unsigned*)(U + (size_t)(t - jw) * 256 + ch); const float x0 = bflo(wv), x1 = bfhi(wv); s0 += x0; s1 += x1; if (jw == 0) { u0 = x0; u1 = x1; } }
          const float inv = 1.0f / (float)cnt;
          *(unsigned*)(YMIX + (size_t)t * DM + ch) = pk2(s0 * inv - u0, s1 * inv - u1); } }
    __syncthreads();
    ConvBg bg; bg.w_gate = a.w_gate; bg.w_up = a.w_up; bg.w_down = a.w_down; bg.ws_gate = a.ws_gate; bg.ws_up = a.ws_up; bg.ws_down = a.ws_down;
    bg.WGU = (bf16_t*)(ws + WS_WGU); bg.WD = (bf16_t*)(ws + WS_WD); bg.scr = (LAS float*)(c.lds + BG_OFF + c.wave * 8448); bg.lane = c.lane;
    bg.it = c.vcu * 8 + c.wave; bg.end = ConvBg::NIT; bg.stride = c.G * 8; bg.it0 = bg.it; bg.nl = 0; bg.pend = false; bg.dst = nullptr; bg.ldt = 0;
#pragma unroll
    for (int i = 0; i < 8; ++i) bg.v[i] = (f32x4){0.f, 0.f, 0.f, 0.f};
    { const int s = c.vcu >> 6, r = c.vcu & 63; const float* nrm = (const float*)(ws + WS_CTL) + CW_NRM;
      for (int i = 0; i < 4; ++i) { const int qb = (i == 0) ? s : (i == 1) ? 15 - s : (i == 2) ? 7 - s : 8 + s; const int bh = (r + 17 * i) & 63, b = bh >> 3, h = bh & 7;
          att::Job j; const size_t row0 = (size_t)b * SEQ;
          { const float q2 = nrm[bh * 4 + 0] + nrm[bh * 4 + 1], k2 = nrm[bh * 4 + 2] + nrm[bh * 4 + 3]; j.qk2 = 2.02f * sqrtf(q2 * k2); }
          j.Q = Q + (row0 + qb * 256) * 512 + h * 64; j.qpitch = 512; j.K = Kb + row0 * 512 + h * 64; j.V = V + row0 * 512 + h * 64; j.kvpitch = 512;
          j.O = YMIX + (row0 + qb * 256) * DM + 256 + h * 64; j.nt = 4 * qb + 4; j.causal = 1; j.FC = FC + (size_t)bh * SEQ; j.q0 = qb * 256;
          att::unit<true>(j, c.lds, bg); } }
    for (int i = 0; i < 2; ++i) { const int mu = c.vcu * 2 + i, b = mu >> 6, hm = (mu >> 4) & 3, qb = mu & 15;
        att::Job j; const size_t row0 = (size_t)b * SEQ + qb * 256;
        j.Q = QM + row0 * 256 + hm * 64; j.qpitch = 256; j.K = KVM + (size_t)b * 256 * 512 + hm * 64; j.V = KVM + (size_t)b * 256 * 512 + 256 + hm * 64; j.kvpitch = 512;
        j.O = YMIX + row0 * DM + 768 + hm * 64; j.nt = 4; j.causal = 0; j.FC = nullptr; j.q0 = 0; j.qk2 = 0.f;
        att::unit<false>(j, c.lds, bg); }
    while (bg.busy()) { bg.finish(); bg.issue(); }
}

__device__ __forceinline__ void p4_ln1(const Args& a, const Ctx& c) {
    bf16_t* X1B = (bf16_t*)(a.ws + WS_X1B); const int gw = c.vcu * 8 + c.wave, NGW = c.G * 8;
    f32x4 g4[4], b4[4];
#pragma unroll
    for (int j = 0; j < 4; ++j) { g4[j] = *((const f32x4*)a.ln1_g + c.lane + 64 * j); b4[j] = *((const f32x4*)a.ln1_b + c.lane + 64 * j); }
    for (int m = gw; m < T; m += NGW) {
        const u32x2* xr = (const u32x2*)(a.out + (size_t)m * DM) + c.lane; f32x4 v[4]; float s = 0.f;
#pragma unroll
        for (int j = 0; j < 4; ++j) { const u32x2 hw = xr[64 * j]; v[j] = (f32x4){bflo(hw.x), bfhi(hw.x), bflo(hw.y), bfhi(hw.y)}; s += (v[j].x + v[j].y) + (v[j].z + v[j].w); }
        const float mean = wave_sum(s) * (1.f / DM); float s2 = 0.f;
#pragma unroll
        for (int j = 0; j < 4; ++j) { v[j] = v[j] - mean; s2 += (v[j].x * v[j].x + v[j].y * v[j].y) + (v[j].z * v[j].z + v[j].w * v[j].w); }
        const float rstd = 1.f / sqrtf(wave_sum(s2) * (1.f / DM) + LN_EPS);
        u32x2* o8 = (u32x2*)(X1B + (size_t)m * DM) + c.lane;
#pragma unroll
        for (int j = 0; j < 4; ++j) { const f32x4 y = v[j] * rstd * g4[j] + b4[j]; o8[64 * j] = (u32x2){pk2(y.x, y.y), pk2(y.z, y.w)}; }
    }
}

__device__ __forceinline__ float wave_max_f(float v) {
    int x = __float_as_int(v);  v = fmaxf(v, __int_as_float(__builtin_amdgcn_update_dpp(x, x, 0x121, 0xf, 0xf, false)));
    x = __float_as_int(v);      v = fmaxf(v, __int_as_float(__builtin_amdgcn_update_dpp(x, x, 0x122, 0xf, 0xf, false)));
    x = __float_as_int(v);      v = fmaxf(v, __int_as_float(__builtin_amdgcn_update_dpp(x, x, 0x124, 0xf, 0xf, false)));
    x = __float_as_int(v);      v = fmaxf(v, __int_as_float(__builtin_amdgcn_update_dpp(x, x, 0x128, 0xf, 0xf, false)));
    x = __float_as_int(v);
    const float a = __int_as_float(__builtin_amdgcn_readlane(x, 0)), b = __int_as_float(__builtin_amdgcn_readlane(x, 16)), c = __int_as_float(__builtin_amdgcn_readlane(x, 32)), d = __int_as_float(__builtin_amdgcn_readlane(x, 48));
    return fmaxf(fmaxf(a, b), fmaxf(c, d));
}
#define CSWAP(va, ia, sa, vb, ib, sb) do { const bool sw_ = (vb > va) || (vb == va && ib < ia); const float tv_ = sw_ ? vb : va, tw_ = sw_ ? va : vb; const int ti_ = sw_ ? ib : ia, tj_ = sw_ ? ia : ib; \
    const float ts_ = sw_ ? sb : sa, tt_ = sw_ ? sa : sb; va = tv_; vb = tw_; ia = ti_; ib = tj_; sa = ts_; sb = tt_; } while (0)
__device__ __forceinline__ void p6_route(const Args& a, const Ctx& c) {
    const float* LOG = (const float*)(a.ws + WS_LOG); int* cnt = (int*)(a.ws + WS_CTL); int* bins = (int*)(a.ws + WS_BINS); float* gates = (float*)(a.ws + WS_GATES);
    LAS int* hist = (LAS int*)c.lds; LAS int* base = hist + 256; LAS unsigned short* asg_e = (LAS unsigned short*)(base + 256); LAS unsigned short* asg_r = asg_e + 1024;
    const int lane = c.lane;
    const f32x4 bs = *((const f32x4*)a.router_bias + lane);
    for (int chunk = c.vcu; chunk < T / 128; chunk += c.G) {
        __syncthreads();
        if (c.tid < 256) hist[c.tid] = 0;
        __syncthreads();
        for (int i = 0; i < 16; ++i) {
            const int lt = c.wave * 16 + i, tok = chunk * 128 + lt;
            const f32x4 lg = *((const f32x4*)(LOG + (size_t)tok * NE) + lane);
            float s0 = 1.f / (1.f + expf(-lg.x)), s1 = 1.f / (1.f + expf(-lg.y)), s2 = 1.f / (1.f + expf(-lg.z)), s3 = 1.f / (1.f + expf(-lg.w));
            float v0 = s0 + bs.x, v1 = s1 + bs.y, v2 = s2 + bs.z, v3 = s3 + bs.w;
            int i0 = 4 * lane, i1 = i0 + 1, i2 = i0 + 2, i3 = i0 + 3;
            CSWAP(v0, i0, s0, v1, i1, s1); CSWAP(v2, i2, s2, v3, i3, s3); CSWAP(v0, i0, s0, v2, i2, s2); CSWAP(v1, i1, s1, v3, i3, s3); CSWAP(v1, i1, s1, v2, i2, s2);
            float m1 = v0, m2 = v1;
#pragma unroll
            for (int o = 1; o < 8; o <<= 1) { const float o1 = __shfl_xor(m1, o), o2 = __shfl_xor(m2, o); const float n1 = fmaxf(m1, o1), n2 = fmaxf(fminf(m1, o1), fmaxf(m2, o2)); m1 = n1; m2 = n2; }
            const float gs = m1 + m2; const int g = lane >> 3; int rank = 0; const int gsx = __float_as_int(gs);
#pragma unroll
            for (int jg = 0; jg < 8; ++jg) { const float gj = __int_as_float(__builtin_amdgcn_readlane(gsx, 8 * jg)); rank += (gj > gs || (gj == gs && jg < g)) ? 1 : 0; }
            if (rank >= 4) { v0 = -INFINITY; v1 = -INFINITY; v2 = -INFINITY; v3 = -INFINITY; }
            int my_e = 0; float my_s = 0.f;
#pragma unroll
            for (int k = 0; k < TOPK; ++k) {
                const float m = wave_max_f(v0);
                const unsigned long long mk = __ballot(v0 == m);
                const int wl = (int)__builtin_ctzll(mk);
                const int ek = __builtin_amdgcn_readlane(i0, wl); const float sk = __int_as_float(__builtin_amdgcn_readlane(__float_as_int(s0), wl));
                if (lane == wl) { v0 = v1; i0 = i1; s0 = s1; v1 = v2; i1 = i2; s1 = s2; v2 = v3; i2 = i3; s2 = s3; v3 = -INFINITY; }
                if (lane == k) { my_e = ek; my_s = sk; }
            }
            float tot = (lane < 8) ? my_s : 0.f;
            tot += __shfl_xor(tot, 1); tot += __shfl_xor(tot, 2); tot += __shfl_xor(tot, 4);
            if (lane < 8) { const int lr = __hip_atomic_fetch_add(&hist[my_e], 1, __ATOMIC_RELAXED, __HIP_MEMORY_SCOPE_WORKGROUP); asg_e[lt * 8 + lane] = (unsigned short)my_e; asg_r[lt * 8 + lane] = (unsigned short)lr; gates[(size_t)tok * 8 + lane] = my_s / tot * 2.5f; }
        }
        __syncthreads();
        if (c.tid < 256) { const int n = hist[c.tid]; base[c.tid] = n ? atomicAdd(&cnt[c.tid * 64], n) : 0; }
        __syncthreads();
        for (int sl = c.tid; sl < 1024; sl += 512) { const int e = asg_e[sl]; bins[(size_t)e * T + base[e] + asg_r[sl]] = chunk * 1024 + sl; }
    }
    __syncthreads();
}
#undef CSWAP

__device__ __forceinline__ int build_tables(const Args& a, const Ctx& c) {
    const int* cnt = (const int*)(a.ws + WS_CTL);
    LAS unsigned short* te = (LAS unsigned short*)(c.lds + TE_OFF); LAS int* tb = (LAS int*)(c.lds + TB_OFF); LAS int* cn = (LAS int*)(c.lds + CN_OFF);
    __syncthreads();
    if (c.tid < NE) cn[c.tid] = __hip_atomic_load(cnt + c.tid * 64, __ATOMIC_RELAXED, __HIP_MEMORY_SCOPE_AGENT);
    __syncthreads();
    if (c.tid == 0) { int run = 0; for (int e = 0; e < NE; ++e) { tb[e] = run; run += (cn[e] + 255) >> 8; } tb[NE] = run; }
    __syncthreads();
    if (c.tid < NE) { const int n = (cn[c.tid] + 255) >> 8, b0 = tb[c.tid]; for (int jt = 0; jt < n; ++jt) te[b0 + jt] = (unsigned short)c.tid; }
    __syncthreads();
    return tb[NE];
}

__device__ __forceinline__ void p9_combine(const Args& a, const Ctx& c) {
    const bf16_t* X1B = (const bf16_t*)(a.ws + WS_X1B); const bf16_t* Y = (const bf16_t*)(a.ws + WS_Y); const int gw = c.vcu * 8 + c.wave, NGW = c.G * 8;
    const int* ridx = (const int*)(a.ws + WS_ROWIDX); const float* gts = (const float*)(a.ws + WS_GATES);
    f32x4 g4[4], b4[4];
#pragma unroll
    for (int j = 0; j < 4; ++j) { g4[j] = *((const f32x4*)a.ln2_g + c.lane + 64 * j); b4[j] = *((const f32x4*)a.ln2_b + c.lane + 64 * j); }
    for (int m = gw; m < T; m += NGW) {
        f32x4* orow = (f32x4*)(a.out + (size_t)m * DM) + c.lane; f32x4 v[4]; float s = 0.f;
        const u32x2* x8 = (const u32x2*)(X1B + (size_t)m * DM) + c.lane;
        const u32x2* s8 = (const u32x2*)(a.out + (size_t)m * DM) + c.lane;
#pragma unroll
        for (int j = 0; j < 4; ++j) { const u32x2 xw = x8[64 * j], sw = s8[64 * j]; v[j] = (f32x4){bflo(sw.x), bfhi(sw.x), bflo(sw.y), bfhi(sw.y)} + (f32x4){bflo(xw.x), bfhi(xw.x), bflo(xw.y), bfhi(xw.y)} * ALPHA; }
        f32x4 ys[4];
#pragma unroll
        for (int j = 0; j < 4; ++j) ys[j] = (f32x4){0.f, 0.f, 0.f, 0.f};
        const int my_r = ridx[(size_t)m * TOPK + (c.lane & 7)]; const float my_g = gts[(size_t)m * TOPK + (c.lane & 7)];
#pragma unroll
        for (int k = 0; k < TOPK; ++k) { const int rr = __builtin_amdgcn_readlane(my_r, k); const float gk = __int_as_float(__builtin_amdgcn_readlane(__float_as_int(my_g), k));
            const int* y4 = (const int*)((const unsigned char*)Y + (size_t)rr * DM) + c.lane;
#pragma unroll
            for (int j = 0; j < 4; ++j) { const int yw = y4[64 * j]; const f32x2 lo = __builtin_amdgcn_cvt_pk_f32_fp8(yw, false), hi2 = __builtin_amdgcn_cvt_pk_f32_fp8(yw, true); ys[j] += (f32x4){lo.x, lo.y, hi2.x, hi2.y} * gk; } }
#pragma unroll
        for (int j = 0; j < 4; ++j) v[j] += ys[j] * YINV;
#pragma unroll
        for (int j = 0; j < 4; ++j) s += (v[j].x + v[j].y) + (v[j].z + v[j].w);
        const float mean = wave_sum(s) * (1.f / DM); float s2 = 0.f;
#pragma unroll
        for (int j = 0; j < 4; ++j) { v[j] = v[j] - mean; s2 += (v[j].x * v[j].x + v[j].y * v[j].y) + (v[j].z * v[j].z + v[j].w * v[j].w); }
        const float rstd = 1.f / sqrtf(wave_sum(s2) * (1.f / DM) + LN_EPS);
#pragma unroll
        for (int j = 0; j < 4; ++j) orow[64 * j] = v[j] * rstd * g4[j] + b4[j];
    }
}

constexpr int NPHASE = 10;

__global__ void __launch_bounds__(512, 2) mk_fwd(Args a) {
    extern __shared__ __attribute__((aligned(16))) unsigned char lds_raw[];
    cg::grid_group grid = cg::this_grid();
    Ctx c; c.lds = (LAS unsigned char*)lds_raw; c.tid = threadIdx.x; c.lane = c.tid & 63; c.wave = __builtin_amdgcn_readfirstlane(c.tid >> 6); c.G = gridDim.x;
    { const int bx = blockIdx.x; c.vcu = (c.G % 8 == 0) ? (bx % 8) * (c.G / 8) + bx / 8 : bx; }
    unsigned char* ws = a.ws; const int lo = a.ph_lo, hi = a.ph_hi;
#define IN(k) (lo <= (k) && (k) < hi)
    for (int u = c.tid; u < 32; u += 512) ((volatile LAS unsigned*)(c.lds + MISC_OFF))[u] = 0u;
    __syncthreads();
    XcdBarrier bar = xcd_barrier_post((unsigned*)(ws + WS_CTL) + CW_BAR + a.li * XCD_BAR_WORDS, (volatile LAS unsigned*)(c.lds + MISC_OFF) + 8);
    if (a.ph_lo < 0) grid.sync();
    unsigned long long pt_acc = 0ull;
#define PT_ON(id) (PROBE_T == (id))
#define SEAM(k) do { if (IN(k) && IN((k) + 1)) { if (PT_ON(10 + (k)) || PT_ON(30)) { const unsigned long long t0_ = __builtin_amdgcn_s_memrealtime(); xcd_barrier(bar); pt_acc += __builtin_amdgcn_s_memrealtime() - t0_; } else xcd_barrier(bar); } } while (0)
#define PH_BEGIN(k) unsigned long long pt0_##k = 0ull; if (PT_ON(k)) pt0_##k = __builtin_amdgcn_s_memrealtime();
#define PH_END(k) if (PT_ON(k)) { asm volatile("s_waitcnt vmcnt(0)" ::: "memory"); __syncthreads(); pt_acc += __builtin_amdgcn_s_memrealtime() - pt0_##k; }
    { PH_BEGIN(0) if (IN(0)) p0_prologue(a, c); PH_END(0) }
    SEAM(0);
    { PH_BEGIN(1) if (IN(1)) {
        p1_fscan(a, c);
        { pg8::DenseSched S; S.init(T, 2048, DM, c.G, (int)blockIdx.x, ws + WS_WIN);
          pg8::EpiInProj E{(bf16_t*)(ws + WS_Q), (bf16_t*)(ws + WS_K), (bf16_t*)(ws + WS_V), (bf16_t*)(ws + WS_U), (bf16_t*)(ws + WS_QM), (unsigned*)(ws + WS_CTL) + CW_NRM};
          pg8::gemm_phase(c.lds, (const char*)(ws + WS_XB), DM, S, E); }
        { pg8::DenseSched S; S.init(NB * 256, 512, DM, c.G, (int)blockIdx.x, ws + WS_WMKV);
          pg8::EpiBf16 E{(bf16_t*)(ws + WS_KVM), 512};
          pg8::gemm_phase(c.lds, (const char*)(ws + WS_MEMB), DM, S, E); }
    } PH_END(1) }
    SEAM(1);
    { PH_BEGIN(2) if (IN(2)) p2_mixers(a, c); PH_END(2) }
    SEAM(2);
    { PH_BEGIN(3) if (IN(3)) { pg8::DenseSched S; S.init(T, DM, DM, c.G, (int)blockIdx.x, ws + WS_WOUT);
        pg8::EpiRes16 E{(bf16_t*)a.out, a.x, ALPHA};
        pg8::gemm_phase<PT_ON(23)>(c.lds, (const char*)(ws + WS_YMIX), DM, S, E, &pt_acc); } PH_END(3) }
    SEAM(3);
    { PH_BEGIN(4) if (IN(4)) p4_ln1(a, c); PH_END(4) }
    SEAM(4);
    { PH_BEGIN(5) if (IN(5)) { pg8::DenseSched S; S.init(T, NE, DM, c.G, (int)blockIdx.x, ws + WS_WR);
        pg8::EpiF32 E{(float*)(ws + WS_LOG), NE, nullptr, 0.f};
        pg8::gemm_phase(c.lds, (const char*)(ws + WS_X1B), DM, S, E); } PH_END(5) }
    SEAM(5);
    { PH_BEGIN(6) if (IN(6)) p6_route(a, c); PH_END(6) }
    SEAM(6);
    { PH_BEGIN(7) if (IN(7)) { const int NTR = build_tables(a, c);
        pg8::GroupSched S; S.nunits = (NTR + 128) * 2; S.G = c.G; S.c = (int)blockIdx.x; S.shift = 1; S.NTR = NTR; S.mode = 0; S.K = DM;
        S.tile_e = (const LAS unsigned short*)(c.lds + TE_OFF); S.tbase = (const LAS int*)(c.lds + TB_OFF); S.cnt = (const LAS int*)(c.lds + CN_OFF);
        S.bins = (const int*)(ws + WS_BINS); S.Bt = (const char*)(ws + WS_WGU); S.estride = (size_t)512 * DM * 2; S.rowidx = (int*)(ws + WS_ROWIDX);
        pg8::EpiGateUp E{(bf16_t*)(ws + WS_HB)};
        pg8::gemm_phase<PT_ON(27)>(c.lds, (const char*)(ws + WS_X1B), DM, S, E, &pt_acc); } PH_END(7) }
    SEAM(7);
    { PH_BEGIN(8) if (IN(8)) { const int NTR = build_tables(a, c);
        pg8::GroupSched S; S.nunits = (NTR + 128) * 4; S.G = c.G; S.c = (int)blockIdx.x; S.shift = 2; S.NTR = NTR; S.mode = 1; S.K = EH;
        S.tile_e = (const LAS unsigned short*)(c.lds + TE_OFF); S.tbase = (const LAS int*)(c.lds + TB_OFF); S.cnt = (const LAS int*)(c.lds + CN_OFF);
        S.bins = (const int*)(ws + WS_BINS); S.Bt = (const char*)(ws + WS_WD); S.estride = (size_t)DM * EH * 2; S.rowidx = nullptr;
        pg8::EpiDown E{(bf16_t*)(ws + WS_Y), a.out, (const int*)(ws + WS_BINS), (const float*)(ws + WS_GATES)};
        pg8::gemm_phase<PT_ON(28)>(c.lds, (const char*)(ws + WS_HB), EH, S, E, &pt_acc); } PH_END(8) }
    SEAM(8);
    { PH_BEGIN(9) if (IN(9)) p9_combine(a, c); PH_END(9) }
    if (PROBE_T >= 0) {
        unsigned* pw = (unsigned*)(ws + WS_CTL) + CW_PROBE;
        if (c.tid == 0) { if (PROBE_MODE == 0) atomicMax(pw, (unsigned)pt_acc); else atomicAdd(pw, (unsigned)pt_acc); }
        xcd_barrier(bar);
        if (blockIdx.x == 0 && c.tid == 0) { unsigned v = __hip_atomic_load(pw, __ATOMIC_RELAXED, __HIP_MEMORY_SCOPE_AGENT); if (PROBE_MODE == 1) v /= (unsigned)c.G;
            const unsigned long long t0 = __builtin_amdgcn_s_memrealtime(); while (__builtin_amdgcn_s_memrealtime() - t0 < (unsigned long long)v * PROBE_MULT) __builtin_amdgcn_s_sleep(8); }
    }
#undef IN
#undef SEAM
}

#ifndef MK_N_LAUNCHES
#define MK_N_LAUNCHES 1
#endif
extern "C" void kernel_launch(void* const* d_in, const int* in_sizes, int n_in, void* d_out, int out_size, void* d_ws, size_t ws_size, hipStream_t stream) {
    static int grid = 0;
    if (grid == 0) {
        if (n_in != 20 || out_size != T * DM || ws_size < WS_END) { fprintf(stderr, "kernel_launch: unexpected shapes (n_in %d out %d ws %zu)\n", n_in, out_size, ws_size); grid = -1; return; }
        int dev = 0, cus = 0, per_cu = 0;
        (void)hipGetDevice(&dev); (void)hipDeviceGetAttribute(&cus, hipDeviceAttributeMultiprocessorCount, dev);
        if (hipFuncSetAttribute((const void*)mk_fwd, hipFuncAttributeMaxDynamicSharedMemorySize, LDS_BYTES) != hipSuccess) { fprintf(stderr, "kernel_launch: hipFuncSetAttribute failed\n"); grid = -1; return; }
        (void)hipOccupancyMaxActiveBlocksPerMultiprocessor(&per_cu, (const void*)mk_fwd, 512, LDS_BYTES);
        if (per_cu < 1) { fprintf(stderr, "kernel_launch: occupancy query says %d blocks per CU\n", per_cu); grid = -1; return; }
        grid = cus;
        if (grid != 256) fprintf(stderr, "kernel_launch: %d CUs (built for 256)\n", grid);
    }
    if (grid < 0) return;
    (void)hipMemsetAsync((char*)d_ws + WS_CTL, 0, CTL_ZERO_BYTES, stream);
    Args a{};
    const float** p = (const float**)&a;
    for (int i = 0; i < 20; ++i) p[i] = (const float*)d_in[i];
    a.out = (float*)d_out; a.ws = (unsigned char*)d_ws;
    const int nl = MK_N_LAUNCHES;
    for (int li = 0; li < nl; ++li) {
        a.ph_lo = (nl == 1) ? 0 : li; a.ph_hi = (nl == 1) ? NPHASE : li + 1; a.li = li;
        void* args[] = {&a};
        const hipError_t e = hipLaunchCooperativeKernel((void*)mk_fwd, dim3(grid), dim3(512), args, LDS_BYTES, stream);
        if (e != hipSuccess) { fprintf(stderr, "kernel_launch: cooperative launch failed: %s\n", hipGetErrorString(e)); break; }
    }
}
```

```cpp
#include <hip/hip_runtime.h>
#include <hip/hip_cooperative_groups.h>
#include <cstdio>
#include <cstdint>
namespace cg = cooperative_groups;
#ifndef PROBE_T
#define PROBE_T -1
#endif
#ifndef PROBE_MODE
#define PROBE_MODE 0
#endif
#define PROBE_MULT 4
constexpr int CW_PROBE = 20000;
#define PT_BEGIN(id) unsigned long long ptb_##id = 0ull; if (PROBE_T == (id)) ptb_##id = __builtin_amdgcn_s_memrealtime();
#define PT_END(id, tacc) if (PROBE_T == (id)) { asm volatile("s_waitcnt vmcnt(0)" ::: "memory"); __syncthreads(); *(tacc) += __builtin_amdgcn_s_memrealtime() - ptb_##id; }

#define LAS __attribute__((address_space(3)))
typedef unsigned short bf16_t;
typedef short bf16x8 __attribute__((ext_vector_type(8)));
typedef short s16x4 __attribute__((ext_vector_type(4)));
typedef float f32x4 __attribute__((ext_vector_type(4)));
typedef float f32x2 __attribute__((ext_vector_type(2)));
typedef float f32x16 __attribute__((ext_vector_type(16)));
typedef unsigned u32x4 __attribute__((ext_vector_type(4)));
typedef unsigned u32x2 __attribute__((ext_vector_type(2)));

constexpr int NB = 8, SEQ = 4096, T = NB * SEQ, DM = 1024;
constexpr int INC = 2056;
constexpr int NE = 256, TOPK = 8, EH = 256;
constexpr float ALPHA = 1.189207115002721f;
constexpr float LN_EPS = 1e-5f;
constexpr float LOG2E = 1.4426950408889634f;
constexpr float C2 = 0.125f * LOG2E;
constexpr int MAXTILES = 1280 + 128;
constexpr float YSCALE = 32.f, YINV = 1.f / 32.f;

constexpr size_t MiB = 1u << 20;
constexpr size_t WS_CTL = 0, WS_WD = 1 * MiB, WS_HB = 130 * MiB, WS_X1B = 306 * MiB, WS_BINS = 370 * MiB, WS_GATES = 402 * MiB, WS_FC = 403 * MiB, WS_FLOG = 404 * MiB,
                 WS_KVM = 405 * MiB, WS_Y = 408 * MiB, WS_WGU = 408 * MiB, WS_WIN = 665 * MiB, WS_WMKV = 669 * MiB, WS_WOUT = 670 * MiB, WS_WR = 672 * MiB, WS_MEMB = 673 * MiB,
                 WS_XB = 677 * MiB, WS_Q = 741 * MiB, WS_K = 773 * MiB, WS_V = 805 * MiB, WS_QM = 837 * MiB, WS_U = 853 * MiB, WS_YMIX = 869 * MiB, WS_LOG = 933 * MiB, WS_END = 965 * MiB;
constexpr size_t CTL_ZERO_BYTES = 1 * MiB;
constexpr size_t WS_ROWIDX = WS_FLOG;
constexpr int CW_NRM = 16384;

constexpr int RING_BYTES = 131072;
constexpr int TE_OFF = 131072, TB_OFF = 135168, CN_OFF = 137216, OR_OFF = 138240  , BG_OFF = 83968  , MISC_OFF = 155648, LDS_BYTES = 156672;

struct Args {
    const float *x, *mem, *w_in, *b_f, *w_pool, *pool_scale, *w_mem_kv, *w_out, *ln1_g, *ln1_b, *w_router, *router_bias, *w_gate, *w_up, *w_down, *ws_gate, *ws_up, *ws_down, *ln2_g, *ln2_b;
    float* out; unsigned char* ws; int ph_lo, ph_hi, li, pad;
};

__device__ __forceinline__ unsigned f2bf(float f) { unsigned u = __float_as_uint(f); return (u + 0x7fffu + ((u >> 16) & 1u)) >> 16; }
__device__ __forceinline__ unsigned pk2(float lo, float hi) { return f2bf(lo) | (f2bf(hi) << 16); }
__device__ __forceinline__ float bflo(unsigned w) { return __uint_as_float(w << 16); }
__device__ __forceinline__ float bfhi(unsigned w) { return __uint_as_float(w & 0xffff0000u); }
__device__ __forceinline__ float wave_sum(float v) {
#pragma unroll
    for (int o = 1; o < 64; o <<= 1) v += __shfl_xor(v, o);
    return v;
}
#define LDS_WAIT() asm volatile("s_waitcnt lgkmcnt(0)" ::: "memory")

namespace pg8 {
constexpr int BM = 256, BK = 64, HALF = 128, HTB = HALF * BK * 2, NXCD = 8, WGM = 8;
__device__ __forceinline__ int lds_byte(int r, int c) { const int st = (r >> 4) * 2 + (c >> 5), rr = r & 15, cc = c & 31, ob = rr * 64 + cc * 2; return st * 1024 + (ob ^ (((ob >> 9) & 1) << 5)); }
__device__ __forceinline__ void stage_rc(int b, int& R, int& C) { const int st = b / 1024, sb = b % 1024, swz = sb ^ (((sb >> 9) & 1) << 5); R = (st >> 1) * 16 + swz / 64; C = (st & 1) * 32 + (swz % 64) / 2; }
__device__ __forceinline__ int perm32(int rho) { const int n = rho >> 4, i = rho & 15; return 8 * (i >> 2) + 4 * n + (i & 3); }
__device__ __forceinline__ int xcd_remap(int L, int nwg) { const int q = nwg / NXCD, r = nwg % NXCD, xcd = L % NXCD, off = L / NXCD; return (xcd < r ? xcd * (q + 1) : r * (q + 1) + (xcd - r) * q) + off; }

struct Unit { int pm, pn, e, rows, mt; };

struct DenseSched {
    int nM, nN, nwg, G, c, K; const char* Bt;
    __device__ __forceinline__ void init(int M, int N, int K_, int G_, int c_, const void* Bt_) { nM = M / BM; nN = N / BM; nwg = nM * nN; G = G_; c = c_; K = K_; Bt = (const char*)Bt_; }
    __device__ __forceinline__ bool next(int i, Unit& u) const {
        const long L = (long)i * G + c; if (L >= nwg) return false;
        const int wgid = xcd_remap((int)L, nwg);
        const int nig = WGM * nN, gid = wgid / nig, fm = gid * WGM, gsz = (nM - fm) < WGM ? (nM - fm) : WGM;
        u.pm = fm + ((wgid % nig) % gsz); u.pn = (wgid % nig) / gsz; u.e = 0; u.rows = 256; u.mt = u.pm; return true;
    }
    __device__ __forceinline__ unsigned a_off(const Unit& u, int h, int R, int C) const { return (unsigned)(((u.pm * BM + h * HALF + R) * K + C) * 2); }
    __device__ __forceinline__ const char* b_ptr(const Unit& u) const { return Bt + (size_t)u.pn * BM * K * 2; }
};

struct GroupSched {
    int nunits, G, c, shift, NTR, mode, K; const LAS unsigned short* tile_e; const LAS int* tbase; const LAS int* cnt; const int* bins; const char* Bt; size_t estride; int* rowidx; const LAS unsigned short* order;
    __device__ __forceinline__ bool next(int i, Unit& u) const {
        const long L = (long)i * G + c; if (L >= nunits) return false;
        const int wgid = (int)L;
        const int tau = order[wgid >> shift]; u.pn = wgid & ((1 << shift) - 1); u.pm = tau;
        if (tau < NTR) { const int e = tile_e[tau]; u.e = e; u.mt = tau - tbase[e]; const int left = cnt[e] - u.mt * 256; u.rows = left < 256 ? left : 256; }
        else { u.e = NE; u.mt = tau - NTR; u.rows = 256; }
        return true;
    }
    __device__ __forceinline__ unsigned a_off(const Unit& u, int h, int R, int C) const {
        if (mode == 0) { const int rl = h * HALF + R; int tok;
            if (u.e < NE) { if (rl < u.rows) { const int a = bins[(size_t)u.e * T + u.mt * 256 + rl]; tok = a >> 3; if (C == 0 && u.pn == 0) rowidx[a] = u.pm * 256 + rl; } else tok = 0; }
            else tok = u.mt * 256 + rl;
            return (unsigned)((tok * 1024 + C) * 2); }
        return (unsigned)(((u.pm * BM + h * HALF + R) * 256 + C) * 2);
    }
    __device__ __forceinline__ const char* b_ptr(const Unit& u) const { return Bt + (size_t)u.e * estride + (size_t)u.pn * BM * K * 2; }
};

__device__ __forceinline__ unsigned cvt_pk_bf16(float lo, float hi) { unsigned r; asm volatile("v_cvt_pk_bf16_f32 %0, %1, %2" : "=v"(r) : "v"(lo), "v"(hi)); return r; }

template <bool TIME = false, class Epi, class Sched>
__device__ __forceinline__ void gemm_phase(LAS unsigned char* lds, const char* Abase, int K, const Sched& S, const Epi& E, unsigned long long* tacc = nullptr) {
    const int tid = threadIdx.x, wid = __builtin_amdgcn_readfirstlane(tid >> 6), lane = tid & 63, wr = wid >> 2, wc = wid & 3, fr = lane & 15, fq = lane >> 4;
    const int nt = K / BK;
    int RA[2], CA[2]; unsigned voffB[2];
#pragma unroll
    for (int i = 0; i < 2; ++i) { int R, C; stage_rc(tid * 16 + i * 8192, R, C); const int Rb = Epi::PERM ? ((R & ~31) + perm32(R & 31)) : R; RA[i] = R; CA[i] = C; voffB[i] = (unsigned)(Rb * K + C) * 2u; }
    const size_t kstep = (size_t)(BK * 2);
    const size_t hstep = (size_t)HALF * K * 2;
    const unsigned ldsw = (unsigned)wid * 1024u;
    const int aoff = lds_byte(wr * 64 + fr, fq * 8), boff = lds_byte(wc * 32 + fr, fq * 8);
#define PG8_SA(b, h) (((b) * 2 + (h)) * HTB)
#define PG8_SB(b, h) ((4 + (b) * 2 + (h)) * HTB)
#define PG8_STAGEB(bufoff, gbase) do { _Pragma("unroll") for (int _i = 0; _i < 2; ++_i) \
        __builtin_amdgcn_global_load_lds((const unsigned*)((const char*)(gbase) + voffB[_i]), (LAS unsigned*)(lds + (bufoff) + ldsw + _i * 8192), 16, 0, 0); } while (0)
#define PG8_STAGEA(bufoff, koff, v0, v1) do { \
        __builtin_amdgcn_global_load_lds((const unsigned*)(Abase + (koff) + (v0)), (LAS unsigned*)(lds + (bufoff) + ldsw), 16, 0, 0); \
        __builtin_amdgcn_global_load_lds((const unsigned*)(Abase + (koff) + (v1)), (LAS unsigned*)(lds + (bufoff) + ldsw + 8192), 16, 0, 0); } while (0)
#define PG8_LDA(dst, b, h) do { _Pragma("unroll") for (int m = 0; m < 4; ++m) _Pragma("unroll") for (int k = 0; k < 2; ++k) dst[m][k] = *(const LAS bf16x8*)(lds + PG8_SA(b, h) + aoff + m * 2048 + k * 1024); } while (0)
#define PG8_LDB(dst, b, h) do { _Pragma("unroll") for (int n = 0; n < 2; ++n) _Pragma("unroll") for (int k = 0; k < 2; ++k) dst[n][k] = *(const LAS bf16x8*)(lds + PG8_SB(b, h) + boff + n * 2048 + k * 1024); } while (0)
#define PG8_MMA(ai, bj, At, Bt) do { __builtin_amdgcn_s_setprio(1); _Pragma("unroll") for (int m = 0; m < 4; ++m) _Pragma("unroll") for (int n = 0; n < 2; ++n) _Pragma("unroll") for (int k = 0; k < 2; ++k) \
        acc[ai][bj][m][n] = __builtin_amdgcn_mfma_f32_16x16x32_bf16(Bt[n][k], At[m][k], acc[ai][bj][m][n], 0, 0, 0); __builtin_amdgcn_s_setprio(0); } while (0)
#define PG8_WAIT_V(n) asm volatile("s_waitcnt vmcnt(" #n ")" ::: "memory")
#define PG8_WAIT_L(n) asm volatile("s_waitcnt lgkmcnt(" #n ")" ::: "memory")
#define PG8_BAR __builtin_amdgcn_s_barrier()
#define PG8_SCHED __builtin_amdgcn_sched_barrier(0)
    Unit cur, nxt; int ui = 0;
    if (!S.next(0, cur)) return;
    unsigned vc00 = S.a_off(cur, 0, RA[0], CA[0]), vc01 = S.a_off(cur, 0, RA[1], CA[1]), vc10 = S.a_off(cur, 1, RA[0], CA[0]), vc11 = S.a_off(cur, 1, RA[1], CA[1]);
    asm volatile("" : "+v"(vc00), "+v"(vc01), "+v"(vc10), "+v"(vc11));
    f32x4 acc[2][2][4][2];
#pragma unroll
    for (int a = 0; a < 2; ++a)
#pragma unroll
        for (int b = 0; b < 2; ++b)
#pragma unroll
            for (int m = 0; m < 4; ++m)
#pragma unroll
                for (int n = 0; n < 2; ++n) acc[a][b][m][n] = (f32x4){0.f, 0.f, 0.f, 0.f};
    bf16x8 At[4][2], B0[2][2], B1[2][2];
    const char* cB = S.b_ptr(cur);
    PG8_STAGEB(PG8_SB(0, 0), cB); PG8_STAGEB(PG8_SB(0, 1), cB + hstep); PG8_STAGEA(PG8_SA(0, 0), 0, vc00, vc01); PG8_STAGEA(PG8_SA(0, 1), 0, vc10, vc11);
    if (wr == 1) PG8_BAR;
    PG8_WAIT_V(2); PG8_BAR;
    PG8_STAGEB(PG8_SB(1, 0), cB + kstep); PG8_STAGEA(PG8_SA(1, 0), kstep, vc00, vc01); PG8_STAGEB(PG8_SB(1, 1), cB + hstep + kstep);
    PG8_WAIT_V(6); PG8_BAR;
    for (;;) {
        const bool has_next = S.next(ui + 1, nxt);
        unsigned vn00 = vc00, vn01 = vc01, vn10 = vc10, vn11 = vc11;
        if (has_next) { vn00 = S.a_off(nxt, 0, RA[0], CA[0]); vn01 = S.a_off(nxt, 0, RA[1], CA[1]); vn10 = S.a_off(nxt, 1, RA[0], CA[0]); vn11 = S.a_off(nxt, 1, RA[1], CA[1]); }
        asm volatile("" : "+v"(vn00), "+v"(vn01), "+v"(vn10), "+v"(vn11));
        const char* nB = has_next ? S.b_ptr(nxt) : cB;
        const bool full = cur.rows > HALF;
        for (int t = 0; t < nt; t += 2) {
            const bool last = (t == nt - 2);
            const size_t k1 = (size_t)(t + 1) * kstep;
            const size_t k2 = last ? 0 : (size_t)(t + 2) * kstep, k3 = k2 + kstep;
            const char* b2 = last ? nB : cB + (size_t)(t + 2) * kstep; const char* b3 = b2 + kstep;
            const unsigned s00 = last ? vn00 : vc00, s01 = last ? vn01 : vc01, s10 = last ? vn10 : vc10, s11 = last ? vn11 : vc11;
            PG8_LDB(B0, 0, 0); PG8_LDB(B1, 0, 1); PG8_SCHED; PG8_LDA(At, 0, 0); PG8_STAGEA(PG8_SA(1, 1), k1, vc10, vc11);
            PG8_WAIT_V(8); PG8_WAIT_L(0); PG8_BAR; PG8_MMA(0, 0, At, B0); PG8_MMA(0, 1, At, B1); PG8_BAR; PG8_SCHED;
            PG8_LDA(At, 0, 1); PG8_STAGEB(PG8_SB(0, 0), b2); PG8_STAGEB(PG8_SB(0, 1), b2 + hstep); PG8_STAGEA(PG8_SA(0, 0), k2, s00, s01);
            PG8_WAIT_V(8); PG8_WAIT_L(0); PG8_BAR; if (full) { PG8_MMA(1, 0, At, B0); PG8_MMA(1, 1, At, B1); } PG8_BAR; PG8_SCHED;
            PG8_LDB(B0, 1, 0); PG8_LDB(B1, 1, 1); PG8_SCHED; PG8_LDA(At, 1, 0); PG8_STAGEA(PG8_SA(0, 1), k2, s10, s11);
            PG8_WAIT_V(8); PG8_WAIT_L(0); PG8_BAR; PG8_MMA(0, 0, At, B0); PG8_MMA(0, 1, At, B1); PG8_BAR; PG8_SCHED;
            PG8_LDA(At, 1, 1); PG8_STAGEB(PG8_SB(1, 0), b3); PG8_STAGEB(PG8_SB(1, 1), b3 + hstep); PG8_STAGEA(PG8_SA(1, 0), k3, s00, s01);
            PG8_WAIT_V(8); PG8_WAIT_L(0); PG8_BAR; if (full) { PG8_MMA(1, 0, At, B0); PG8_MMA(1, 1, At, B1); } PG8_BAR; PG8_SCHED;
        }
        if (wr == 0) PG8_BAR;
        if constexpr (TIME) { const unsigned long long t0_ = __builtin_amdgcn_s_memrealtime(); E(acc, cur, wr, wc, fr, fq); asm volatile("s_waitcnt vmcnt(0)" ::: "memory"); *tacc += __builtin_amdgcn_s_memrealtime() - t0_; }
        else E(acc, cur, wr, wc, fr, fq);
        if (!has_next) break;
#pragma unroll
        for (int a = 0; a < 2; ++a)
#pragma unroll
            for (int b = 0; b < 2; ++b)
#pragma unroll
                for (int m = 0; m < 4; ++m)
#pragma unroll
                    for (int n = 0; n < 2; ++n) acc[a][b][m][n] = (f32x4){0.f, 0.f, 0.f, 0.f};
        cur = nxt; cB = nB; vc00 = vn00; vc01 = vn01; vc10 = vn10; vc11 = vn11; ++ui;
        if (wr == 1) PG8_BAR;
    }
    PG8_WAIT_V(0);
    PG8_BAR;
#undef PG8_SA
#undef PG8_SB
#undef PG8_STAGEA
#undef PG8_STAGEB
#undef PG8_LDA
#undef PG8_LDB
#undef PG8_MMA
#undef PG8_WAIT_V
#undef PG8_WAIT_L
#undef PG8_BAR
#undef PG8_SCHED
}

struct EpiInProj {
    static constexpr bool PERM = true;
    bf16_t *Q, *Kb, *V, *U, *QM; unsigned* nrm;
    __device__ __forceinline__ void operator()(const f32x4 (&acc)[2][2][4][2], const Unit& u, int wr, int wc, int fr, int fq) const {
        bf16_t* base; int ldc, colt; float sc = 1.f; const int pn = u.pn;
        float nmax[2] = {0.f, 0.f};
        if (pn < 2) { base = Q; ldc = 512; colt = pn * 256; sc = C2; } else if (pn < 4) { base = Kb; ldc = 512; colt = (pn - 2) * 256; } else if (pn < 6) { base = V; ldc = 512; colt = (pn - 4) * 256; }
        else if (pn == 6) { base = U; ldc = 256; colt = 0; } else { base = QM; ldc = 256; colt = 0; sc = C2; }
        const int row0 = u.pm * BM + wr * 64 + fr, col0 = colt + wc * 32 + 8 * fq;
#pragma unroll
        for (int ai = 0; ai < 2; ++ai)
#pragma unroll
            for (int m = 0; m < 4; ++m) { bf16_t* rowp = base + (size_t)(row0 + ai * HALF + m * 16) * ldc + col0;
#pragma unroll
                for (int bj = 0; bj < 2; ++bj) { const f32x4 v0 = acc[ai][bj][m][0] * sc, v1 = acc[ai][bj][m][1] * sc;
                    u32x4 w; w.x = cvt_pk_bf16(v0[0], v0[1]); w.y = cvt_pk_bf16(v0[2], v0[3]); w.z = cvt_pk_bf16(v1[0], v1[1]); w.w = cvt_pk_bf16(v1[2], v1[3]);
                    *(u32x4*)(rowp + bj * HALF) = w;
                    if (pn < 4) { float q = (v0[0] * v0[0] + v0[1] * v0[1]) + (v0[2] * v0[2] + v0[3] * v0[3]) + (v1[0] * v1[0] + v1[1] * v1[1]) + (v1[2] * v1[2] + v1[3] * v1[3]);
                        q += __shfl_xor(q, 16); q += __shfl_xor(q, 32); nmax[bj] = fmaxf(nmax[bj], q); } } }
        if (pn < 4) {
#pragma unroll
            for (int bj = 0; bj < 2; ++bj) { float q = nmax[bj];
#pragma unroll
                for (int o = 1; o < 16; o <<= 1) q = fmaxf(q, __shfl_xor(q, o));
                if (fr == 0 && fq == 0) { const int b = (u.pm * BM) / SEQ, h = (pn & 1) * 4 + 2 * bj + (wc >> 1), kind = pn >> 1;
                    atomicMax(nrm + ((b * 8 + h) * 2 + kind) * 2 + (wc & 1), __float_as_uint(q)); } }
        }
    }
};
struct EpiBf16 {
    static constexpr bool PERM = true;
    bf16_t* O; int ldc;
    __device__ __forceinline__ void operator()(const f32x4 (&acc)[2][2][4][2], const Unit& u, int wr, int wc, int fr, int fq) const {
        const int row0 = u.pm * BM + wr * 64 + fr, col0 = u.pn * BM + wc * 32 + 8 * fq;
#pragma unroll
        for (int ai = 0; ai < 2; ++ai)
#pragma unroll
            for (int m = 0; m < 4; ++m) { bf16_t* rowp = O + (size_t)(row0 + ai * HALF + m * 16) * ldc + col0;
#pragma unroll
                for (int bj = 0; bj < 2; ++bj) { const f32x4 v0 = acc[ai][bj][m][0], v1 = acc[ai][bj][m][1];
                    u32x4 w; w.x = cvt_pk_bf16(v0[0], v0[1]); w.y = cvt_pk_bf16(v0[2], v0[3]); w.z = cvt_pk_bf16(v1[0], v1[1]); w.w = cvt_pk_bf16(v1[2], v1[3]);
                    *(u32x4*)(rowp + bj * HALF) = w; } }
    }
};
struct EpiRes16 {
    static constexpr bool PERM = true;
    bf16_t* O; const float* R; float rs;
    __device__ __forceinline__ void operator()(const f32x4 (&acc)[2][2][4][2], const Unit& u, int wr, int wc, int fr, int fq) const {
        const int row0 = u.pm * BM + wr * 64 + fr, col0 = u.pn * BM + wc * 32 + 8 * fq;
#pragma unroll
        for (int ai = 0; ai < 2; ++ai)
#pragma unroll
            for (int m = 0; m < 4; ++m) { const size_t row = (size_t)(row0 + ai * HALF + m * 16);
#pragma unroll
                for (int bj = 0; bj < 2; ++bj) { const float* rp = R + row * DM + col0 + bj * HALF;
                    const f32x4 v0 = acc[ai][bj][m][0] + *(const f32x4*)rp * rs, v1 = acc[ai][bj][m][1] + *(const f32x4*)(rp + 4) * rs;
                    u32x4 w; w.x = cvt_pk_bf16(v0[0], v0[1]); w.y = cvt_pk_bf16(v0[2], v0[3]); w.z = cvt_pk_bf16(v1[0], v1[1]); w.w = cvt_pk_bf16(v1[2], v1[3]);
                    *(u32x4*)(O + row * (2 * DM) + col0 + bj * HALF) = w; }
                if (m & 1) asm volatile("" ::: "memory"); }
    }
};
struct EpiF32 {
    static constexpr bool PERM = false;
    float* C; int ldc; const float* R; float rs;
    __device__ __forceinline__ void operator()(const f32x4 (&acc)[2][2][4][2], const Unit& u, int wr, int wc, int fr, int fq) const {
        const int row0 = u.pm * BM + wr * 64 + fr, col0 = u.pn * BM + wc * 32 + 4 * fq;
#pragma unroll
        for (int ai = 0; ai < 2; ++ai)
#pragma unroll
            for (int m = 0; m < 4; ++m) { const size_t off = (size_t)(row0 + ai * HALF + m * 16) * ldc + col0;
#pragma unroll
                for (int bj = 0; bj < 2; ++bj)
#pragma unroll
                    for (int n = 0; n < 2; ++n) { f32x4 v = acc[ai][bj][m][n]; if (R) v += *(const f32x4*)(R + off + bj * HALF + n * 16) * rs; *(f32x4*)(C + off + bj * HALF + n * 16) = v; }
                if (m & 1) asm volatile("" ::: "memory"); }
    }
};
struct EpiGateUp {
    static constexpr bool PERM = true;
    bf16_t* H;
    __device__ __forceinline__ void operator()(const f32x4 (&acc)[2][2][4][2], const Unit& u, int wr, int wc, int fr, int fq) const {
        const int row0 = u.pm * BM + wr * 64 + fr, col0 = u.pn * 128 + wc * 32 + 8 * fq;
#pragma unroll
        for (int ai = 0; ai < 2; ++ai)
#pragma unroll
            for (int m = 0; m < 4; ++m) { bf16_t* rowp = H + (size_t)(row0 + ai * HALF + m * 16) * EH + col0; float hv[8];
#pragma unroll
                for (int n = 0; n < 2; ++n)
#pragma unroll
                    for (int j = 0; j < 4; ++j) { const float g = acc[ai][0][m][n][j], up = acc[ai][1][m][n][j]; hv[n * 4 + j] = g * __builtin_amdgcn_rcpf(1.f + __builtin_amdgcn_exp2f(-g * LOG2E)) * up; }
                u32x4 w; w.x = cvt_pk_bf16(hv[0], hv[1]); w.y = cvt_pk_bf16(hv[2], hv[3]); w.z = cvt_pk_bf16(hv[4], hv[5]); w.w = cvt_pk_bf16(hv[6], hv[7]);
                *(u32x4*)rowp = w; }
    }
};
struct EpiDown {
    static constexpr bool PERM = true;
    bf16_t* Y; float* SH; const int* bins; const float* gates;
    __device__ __forceinline__ void operator()(const f32x4 (&acc)[2][2][4][2], const Unit& u, int wr, int wc, int fr, int fq) const {
        const int col0 = u.pn * BM + wc * 32 + 8 * fq;
        if (u.e == NE) {
#pragma unroll
            for (int ai = 0; ai < 2; ++ai)
#pragma unroll
                for (int m = 0; m < 4; ++m) { const int tok = u.mt * 256 + ai * HALF + wr * 64 + m * 16 + fr; bf16_t* rowp = (bf16_t*)(SH + (size_t)tok * DM) + col0;
#pragma unroll
                    for (int bj = 0; bj < 2; ++bj) { const f32x4 v0 = acc[ai][bj][m][0], v1 = acc[ai][bj][m][1];
                        u32x4 w; w.x = cvt_pk_bf16(v0[0], v0[1]); w.y = cvt_pk_bf16(v0[2], v0[3]); w.z = cvt_pk_bf16(v1[0], v1[1]); w.w = cvt_pk_bf16(v1[2], v1[3]);
                        *(u32x4*)(rowp + bj * HALF) = w; } }
        } else {
#pragma unroll
            for (int ai = 0; ai < 2; ++ai)
#pragma unroll
                for (int m = 0; m < 4; ++m) { const int rl = ai * HALF + wr * 64 + m * 16 + fr; if (rl >= u.rows) continue;
                    unsigned char* rowp = (unsigned char*)Y + (size_t)(u.pm * 256 + rl) * DM + u.pn * BM + wc * 64 + fq * 16;
                    unsigned w[4];
#pragma unroll
                    for (int bj = 0; bj < 2; ++bj) { f32x4 v0 = acc[ai][bj][m][0] * YSCALE, v1 = acc[ai][bj][m][1] * YSCALE;
#pragma unroll
                        for (int q = 0; q < 4; ++q) { v0[q] = __builtin_fminf(__builtin_fmaxf(v0[q], -440.f), 440.f); v1[q] = __builtin_fminf(__builtin_fmaxf(v1[q], -440.f), 440.f); }
                        int w0 = 0, w1 = 0; w0 = __builtin_amdgcn_cvt_pk_fp8_f32(v0[0], v0[1], w0, false); w0 = __builtin_amdgcn_cvt_pk_fp8_f32(v0[2], v0[3], w0, true);
                        w1 = __builtin_amdgcn_cvt_pk_fp8_f32(v1[0], v1[1], w1, false); w1 = __builtin_amdgcn_cvt_pk_fp8_f32(v1[2], v1[3], w1, true);
                        w[2 * bj] = (unsigned)w0; w[2 * bj + 1] = (unsigned)w1; }
                    *(u32x4*)rowp = (u32x4){w[0], w[1], w[2], w[3]}; }
        }
    }
};
}


__device__ __forceinline__ unsigned cvtpk_bg(float lo, float hi) { unsigned r; asm volatile("v_cvt_pk_bf16_f32 %0, %1, %2" : "=v"(r) : "v"(lo), "v"(hi)); return r; }
struct ConvBg {
    const float *w_gate, *w_up, *w_down, *ws_gate, *ws_up, *ws_down; bf16_t *WGU, *WD;
    LAS float* scr; int lane, it, it0, end, stride, nl; bool pend; f32x4 v[8]; bf16_t* dst; int ldt;
    static constexpr int NIT = (NE + 1) * 384;
    __device__ __forceinline__ void decode(int r, const float*& src, int& ldw) {
        const int e = r / 384; r -= e * 384;
        if (r < 256) { const int up = r >> 7; r &= 127; const int kb = r >> 3, nb = r & 7, n0 = nb * 32;
            src = ((e < NE) ? ((up ? w_up : w_gate) + (size_t)e * DM * EH) : (up ? ws_up : ws_gate)) + (size_t)kb * 64 * EH + n0; ldw = EH;
            const int drow = (n0 >> 7) * 256 + up * 128 + (n0 & 127); dst = WGU + ((size_t)e * 512 + drow) * DM + kb * 64; ldt = DM;
        } else { r -= 256; const int kb = r >> 5, nb = r & 31;
            src = ((e < NE) ? (w_down + (size_t)e * EH * DM) : ws_down) + (size_t)kb * 64 * DM + nb * 32; ldw = DM;
            dst = WD + ((size_t)e * DM + nb * 32) * EH + kb * 64; ldt = EH; }
    }
    __device__ __forceinline__ void finish() {
        if (!pend) return;
        const int kq = lane >> 3, n4 = (lane & 7) * 4;
#pragma unroll
        for (int i = 0; i < 8; ++i) { LAS float* p = scr + (8 * i + kq) * 33 + n4; p[0] = v[i].x; p[1] = v[i].y; p[2] = v[i].z; p[3] = v[i].w; }
        LDS_WAIT(); asm volatile("" ::: "memory");
        const int c8 = lane & 7;
#pragma unroll
        for (int j = 0; j < 4; ++j) { const int n = (lane >> 3) + 8 * j; const LAS float* s = scr + (8 * c8) * 33 + n;
            u32x4 o; o.x = cvtpk_bg(s[0 * 33], s[1 * 33]); o.y = cvtpk_bg(s[2 * 33], s[3 * 33]); o.z = cvtpk_bg(s[4 * 33], s[5 * 33]); o.w = cvtpk_bg(s[6 * 33], s[7 * 33]);
            *(u32x4*)(dst + (size_t)n * ldt + 8 * c8) = o; }
        LDS_WAIT(); asm volatile("" ::: "memory");
        pend = false;
    }
    __device__ __forceinline__ void issue() {
        const bool valid = it < end; const float* src; int ldw; decode(valid ? it : it0, src, ldw);
        const int kq = lane >> 3, n4 = (lane & 7) * 4;
#pragma unroll
        for (int i = 0; i < 8; ++i) v[i] = __builtin_nontemporal_load((const f32x4*)(src + (size_t)(8 * i + kq) * ldw + n4));
        pend = valid; if (valid) it += stride; nl = 8;
    }
    __device__ __forceinline__ bool busy() const { return pend || it < end; }
};
struct NoBg { int nl; __device__ __forceinline__ void finish() {} __device__ __forceinline__ void issue() { nl = 0; } };

namespace att {
constexpr int SLOTB = 8192, L_K = 0, L_V = 2 * SLOTB, L_WS = 4 * SLOTB, L_OST = L_WS + 8 * 256, L_FK = L_OST + 8 * 4096, L_END = L_FK + 16384;
#define SBAR() __builtin_amdgcn_sched_barrier(0)
__device__ __forceinline__ int crow(int r, int hi) { return (r & 3) + 8 * (r >> 2) + 4 * hi; }
__device__ __forceinline__ void glds16(const void* gsrc, unsigned lds_dst) { unsigned keep;
    asm volatile("s_mov_b32 %0, m0\n\ts_mov_b32 m0, %2\n\ts_nop 0\n\tglobal_load_lds_dwordx4 %1, off\n\ts_mov_b32 m0, %0" : "=&s"(keep) : "v"(gsrc), "s"(lds_dst) : "memory"); }
__device__ __forceinline__ unsigned cvtpk(float lo, float hi) { unsigned r; asm("v_cvt_pk_bf16_f32 %0, %1, %2" : "=v"(r) : "v"(lo), "v"(hi)); return r; }
#define ATT_WAIT_BAR() asm volatile("s_waitcnt vmcnt(0) lgkmcnt(0)\n\ts_barrier" ::: "memory")

struct Job { const bf16_t* Q; int qpitch; const bf16_t* K; const bf16_t* V; int kvpitch; bf16_t* O; int nt; int causal; const float* FC; int q0; float qk2; };
constexpr float SKIP_LOG2 = 36.f;

template <bool FOX, class Bg> __device__ __forceinline__ void unit(const Job& j, LAS unsigned char* shm, Bg& bg) {
    const int tid = threadIdx.x, lane = tid & 63, r32 = lane & 31, hi = lane >> 5; const int wid = __builtin_amdgcn_readfirstlane(tid >> 6);
    const unsigned lds0 = (unsigned)(uintptr_t)shm;
    LAS float* wsf = (LAS float*)(shm + L_WS) + wid * 64;
    LAS float* fk = (LAS float*)(shm + L_FK);
    const int NT = j.nt;
    float fq = 0.f; int tlo = 0;
    if (FOX) {
        const float fq0 = j.FC[j.q0];
        const bool keep = (lane < NT) ? (j.qk2 + fq0 - j.FC[64 * lane + 63] >= -SKIP_LOG2) : false;
        const unsigned long long mk = __ballot(keep);
        tlo = (mk != 0ull) ? (int)__builtin_ctzll(mk) : NT - 1; tlo = __builtin_amdgcn_readfirstlane(tlo);
        for (int i = tlo * 16 + tid; i < NT * 16; i += 512) *(LAS f32x4*)(fk + 4 * i) = *(const f32x4*)(j.FC + 4 * i);
        fq = j.FC[j.q0 + wid * 32 + r32];
    }
    const int NTE = NT - tlo;
    const bf16_t* ksrc = j.K + (size_t)lane * j.kvpitch + wid * 8;
    const bf16_t* vsrc = j.V + (size_t)(16 * (wid & 3) + (lane >> 2)) * j.kvpitch + (wid >> 2) * 32 + (lane & 3) * 8;
    const unsigned kdst = lds0 + L_K + wid * 1024, vdst = lds0 + L_V + wid * 1024;
#define DMA_K(t, slot) glds16(ksrc + (size_t)(t) * 64 * j.kvpitch, (unsigned)__builtin_amdgcn_readfirstlane(kdst + (slot) * SLOTB))
#define DMA_V(t, slot) glds16(vsrc + (size_t)(t) * 64 * j.kvpitch, (unsigned)__builtin_amdgcn_readfirstlane(vdst + (slot) * SLOTB))
    const bf16_t* Qw = j.Q + (size_t)(wid * 32) * j.qpitch;
    bf16x8 qr[4];
#pragma unroll
    for (int d0 = 0; d0 < 4; ++d0) qr[d0] = *reinterpret_cast<const bf16x8*>(Qw + (size_t)r32 * j.qpitch + d0 * 16 + hi * 8);
    asm volatile("s_waitcnt vmcnt(0) lgkmcnt(0)" ::: "memory");
    bg.nl = 0;
    { const int t0 = FOX ? NT - 1 : 0; DMA_K(t0, 0); DMA_V(t0, 0); }
    float mrun = -1e30f, l_reg = 0.f; f32x16 o[2]; o[0] = f32x16{}; o[1] = f32x16{};
    const int qrel = wid * 32 + r32;
    for (int it = 0; it < NTE; ++it) {
        const int tcur = FOX ? NT - 1 - it : it, slot = it & 1;
        if (bg.nl == 8) asm volatile("s_waitcnt vmcnt(8) lgkmcnt(0)\n\ts_barrier" ::: "memory");
        else ATT_WAIT_BAR();
        bg.finish();
        if (it + 1 < NTE) { const int tn = FOX ? tcur - 1 : tcur + 1; DMA_K(tn, slot ^ 1); DMA_V(tn, slot ^ 1); }
        bg.issue();
        f32x16 p0, p1;
        if (FOX) {
#pragma unroll
            for (int g = 0; g < 4; ++g) { const f32x4 a = *(const LAS f32x4*)(fk + 64 * tcur + 8 * g + 4 * hi), b = *(const LAS f32x4*)(fk + 64 * tcur + 32 + 8 * g + 4 * hi);
#pragma unroll
                for (int i = 0; i < 4; ++i) { p0[4 * g + i] = fq - a[i]; p1[4 * g + i] = fq - b[i]; } }
        } else { p0 = f32x16{}; p1 = f32x16{}; }
        { const LAS unsigned char* kb = shm + L_K + slot * SLOTB + hi * 1024 + r32 * 16;
#pragma unroll
          for (int d0 = 0; d0 < 4; ++d0) { const bf16x8 b0 = *(const LAS bf16x8*)(kb + d0 * 2048), b1 = *(const LAS bf16x8*)(kb + d0 * 2048 + 512);
              p0 = __builtin_amdgcn_mfma_f32_32x32x16_bf16(b0, qr[d0], p0, 0, 0, 0); p1 = __builtin_amdgcn_mfma_f32_32x32x16_bf16(b1, qr[d0], p1, 0, 0, 0); } }
        if (j.causal && tcur >= NT - 4) { const int kb0 = 64 * (tcur - (NT - 4)) + 4 * hi;
#pragma unroll
            for (int r = 0; r < 16; ++r) { const int kv = kb0 + (r & 3) + 8 * (r >> 2); if (kv > qrel) p0[r] = -INFINITY; if (kv + 32 > qrel) p1[r] = -INFINITY; } }
        float rm = p0[0];
#pragma unroll
        for (int r = 1; r < 16; ++r) rm = fmaxf(rm, p0[r]);
#pragma unroll
        for (int r = 0; r < 16; ++r) rm = fmaxf(rm, p1[r]);
        rm = fmaxf(rm, __shfl_xor(rm, 32));
        const float mn = fmaxf(mrun, rm), alpha = __builtin_amdgcn_exp2f(mrun - mn); mrun = mn;
        float rs = 0.f;
#pragma unroll
        for (int r = 0; r < 16; ++r) { p0[r] = __builtin_amdgcn_exp2f(p0[r] - mn); p1[r] = __builtin_amdgcn_exp2f(p1[r] - mn); rs += p0[r] + p1[r]; }
        l_reg = l_reg * alpha + rs;
        if (hi == 0) wsf[r32] = alpha;
        LDS_WAIT();
#pragma unroll
        for (int r = 0; r < 16; ++r) { const float f = wsf[crow(r, hi)]; o[0][r] *= f; o[1][r] *= f; }
        u32x4 pw0, pw1, pw2, pw3;
        pw0 = (u32x4){cvtpk(p0[0], p0[1]), cvtpk(p0[2], p0[3]), cvtpk(p0[4], p0[5]), cvtpk(p0[6], p0[7])};
        pw1 = (u32x4){cvtpk(p0[8], p0[9]), cvtpk(p0[10], p0[11]), cvtpk(p0[12], p0[13]), cvtpk(p0[14], p0[15])};
        pw2 = (u32x4){cvtpk(p1[0], p1[1]), cvtpk(p1[2], p1[3]), cvtpk(p1[4], p1[5]), cvtpk(p1[6], p1[7])};
        pw3 = (u32x4){cvtpk(p1[8], p1[9]), cvtpk(p1[10], p1[11]), cvtpk(p1[12], p1[13]), cvtpk(p1[14], p1[15])};
        const bf16x8 pa0 = __builtin_bit_cast(bf16x8, pw0), pa1 = __builtin_bit_cast(bf16x8, pw1), pa2 = __builtin_bit_cast(bf16x8, pw2), pa3 = __builtin_bit_cast(bf16x8, pw3);
        const int vb = (int)(lds0 + L_V + slot * SLOTB) + ((lane >> 4) & 1) * 32 + (lane & 3) * 8 + (4 * hi + ((lane & 15) >> 2)) * 64;
#pragma unroll
        for (int d0 = 0; d0 < 2; ++d0) { s16x4 lo[4], hh[4];
#pragma unroll
            for (int ks = 0; ks < 4; ++ks) {
                asm volatile("ds_read_b64_tr_b16 %0,%1 offset:%c2" : "=&v"(lo[ks]) : "v"(vb), "i"(d0 * 4096 + ks * 1024) : "memory");
                asm volatile("ds_read_b64_tr_b16 %0,%1 offset:%c2" : "=&v"(hh[ks]) : "v"(vb), "i"(d0 * 4096 + ks * 1024 + 512) : "memory"); }
            asm volatile("s_waitcnt lgkmcnt(0)" ::: "memory"); SBAR();
#define PK(k) (bf16x8){lo[k][0], lo[k][1], lo[k][2], lo[k][3], hh[k][0], hh[k][1], hh[k][2], hh[k][3]}
            o[d0] = __builtin_amdgcn_mfma_f32_32x32x16_bf16(pa0, PK(0), o[d0], 0, 0, 0);
            o[d0] = __builtin_amdgcn_mfma_f32_32x32x16_bf16(pa1, PK(1), o[d0], 0, 0, 0);
            o[d0] = __builtin_amdgcn_mfma_f32_32x32x16_bf16(pa2, PK(2), o[d0], 0, 0, 0);
            o[d0] = __builtin_amdgcn_mfma_f32_32x32x16_bf16(pa3, PK(3), o[d0], 0, 0, 0);
#undef PK
        }
    }
    l_reg += __shfl_xor(l_reg, 32);
    if (hi == 0) wsf[32 + r32] = l_reg;
    LDS_WAIT();
    float rli[16];
#pragma unroll
    for (int r = 0; r < 16; ++r) rli[r] = 1.0f / wsf[32 + crow(r, hi)];
    bf16_t* Ow = j.O + (size_t)(wid * 32) * DM;
    { LAS bf16_t* stg = (LAS bf16_t*)(shm + L_OST) + wid * 2048;
#pragma unroll
      for (int r = 0; r < 16; ++r) { const int orow = crow(r, hi);
#pragma unroll
          for (int d0 = 0; d0 < 2; ++d0) stg[orow * 64 + d0 * 32 + r32] = (bf16_t)f2bf(o[d0][r] * rli[r]); }
      LDS_WAIT();
#pragma unroll
      for (int i = 0; i < 4; ++i) { const int row = i * 8 + (lane >> 3), ch = lane & 7; const u32x4 v = *(const LAS u32x4*)(stg + row * 64 + ch * 8); *(u32x4*)(Ow + (size_t)row * DM + ch * 8) = v; } }
    asm volatile("s_waitcnt vmcnt(0) lgkmcnt(0)\n\ts_barrier" ::: "memory");
#undef DMA_K
#undef DMA_V
}
#undef SBAR
}

#define XB_TMO      128
#define XB_XCNT(j)  (256  + 64 * (j))
#define XB_XSUB(j)  (1280 + 64 * (j))
#define XB_XGEN(j)  (2304 + 64 * (j))
#define XB_TOP      3328
#define XB_TOPGEN   3392
#define XCD_BAR_WORDS 3456
#define XB_SPIN_CAP (1u << 18)
constexpr int CW_BAR = 32768;
__device__ __forceinline__ unsigned xb_ld(unsigned* p)              { return __hip_atomic_load(p, __ATOMIC_RELAXED, __HIP_MEMORY_SCOPE_AGENT); }
__device__ __forceinline__ unsigned xb_add(unsigned* p, unsigned v) { return __hip_atomic_fetch_add(p, v, __ATOMIC_RELAXED, __HIP_MEMORY_SCOPE_AGENT); }
__device__ __forceinline__ unsigned xb_xcc_id() { return (unsigned)__builtin_amdgcn_s_getreg((3 << 11) | 20) & 0xFu; }
#define XB_SPIN(cond, bar) do { unsigned _sp = 0; while (cond) { __builtin_amdgcn_s_sleep(1); \
    if ((++_sp & 255u) == 0u) { if (xb_ld(&(bar)[XB_TMO])) break; if (_sp > XB_SPIN_CAP) { atomicAdd(&(bar)[XB_TMO], 1u); break; } } } } while (0)
struct XcdBarrier { unsigned* bar; unsigned x; volatile LAS unsigned* st; };
__device__ __forceinline__ XcdBarrier xcd_barrier_post(unsigned* bar, volatile LAS unsigned* st) {
    XcdBarrier b; b.bar = bar; b.x = xb_xcc_id(); b.st = st;
    if (threadIdx.x == 0) (void)xb_add(&bar[XB_XCNT(b.x)], 1u);
    return b;
}
__device__ __forceinline__ void xcd_barrier_complete(unsigned* bar, unsigned x, unsigned& nloc, unsigned& nx) {
    const unsigned G = gridDim.x * gridDim.y * gridDim.z;
    unsigned sum, cnt, mine, sp = 0u;
    for (;;) {
        sum = 0u; cnt = 0u; mine = 0u;
#pragma unroll
        for (unsigned j = 0; j < 16; ++j) { const unsigned c = xb_ld(&bar[XB_XCNT(j)]); sum += c; cnt += (c > 0u) ? 1u : 0u; mine = (j == x) ? c : mine; }
        if (sum == G) break;
        __builtin_amdgcn_s_sleep(1);
        if ((++sp & 255u) == 0u) { if (xb_ld(&bar[XB_TMO])) break; if (sp > XB_SPIN_CAP) { atomicAdd(&bar[XB_TMO], 1u); break; } }
    }
    nloc = mine > 0u ? mine : 1u; nx = cnt > 0u ? cnt : 1u;
}
__device__ __forceinline__ void xcd_barrier(const XcdBarrier& b) {
    asm volatile("s_waitcnt vmcnt(0)" ::: "memory");
    __syncthreads();
    if (threadIdx.x == 0) {
        unsigned* bar = b.bar;
        __builtin_amdgcn_s_waitcnt(0);
        unsigned nloc = b.st[0], nx = b.st[1];
        if (nloc == 0u) { xcd_barrier_complete(bar, b.x, nloc, nx); b.st[0] = nloc; b.st[1] = nx; }
        const unsigned old = xb_add(&bar[XB_XSUB(b.x)], 1u);
        const unsigned gen = old / nloc;
        if (old + 1u == (gen + 1u) * nloc) {
            __builtin_amdgcn_fence(__ATOMIC_RELEASE, "agent");
            asm volatile("s_waitcnt vmcnt(0)" ::: "memory");
            const unsigned og = xb_add(&bar[XB_TOP], 1u);
            const unsigned tg = og / nx;
            if (og + 1u == (tg + 1u) * nx) xb_add(&bar[XB_TOPGEN], 1u);
            else XB_SPIN(xb_ld(&bar[XB_TOPGEN]) == tg, bar);
            __builtin_amdgcn_fence(__ATOMIC_ACQUIRE, "agent");
            xb_add(&bar[XB_XGEN(b.x)], 1u);
            asm volatile("s_waitcnt vmcnt(0)" ::: "memory");
        } else {
            XB_SPIN(xb_ld(&bar[XB_XGEN(b.x)]) == gen, bar);
            __builtin_amdgcn_fence(__ATOMIC_ACQUIRE, "agent");
            asm volatile("s_waitcnt vmcnt(0)" ::: "memory");
        }
    }
    __syncthreads();
}

struct Ctx { int tid, lane, wave, vcu, G; LAS unsigned char* lds; };

__device__ __forceinline__ unsigned cvtpk_hw(float lo, float hi) { unsigned r; asm volatile("v_cvt_pk_bf16_f32 %0, %1, %2" : "=v"(r) : "v"(lo), "v"(hi)); return r; }
__device__ __forceinline__ void tr_item64(const float* W, int ldw, bf16_t* WT, int ldt, LAS float* scr, int lane) {
    const int kr = lane >> 4, n4 = (lane & 15) * 4;
#pragma unroll
    for (int hb = 0; hb < 2; ++hb) { f32x4 v[8];
#pragma unroll
        for (int i = 0; i < 8; ++i) v[i] = __builtin_nontemporal_load((const f32x4*)(W + (size_t)(4 * (8 * hb + i) + kr) * ldw + n4));
#pragma unroll
        for (int i = 0; i < 8; ++i) { LAS float* p = scr + (4 * (8 * hb + i) + kr) * 65 + n4; p[0] = v[i].x; p[1] = v[i].y; p[2] = v[i].z; p[3] = v[i].w; } }
    LDS_WAIT(); asm volatile("" ::: "memory");
    const int kc = lane & 7;
#pragma unroll
    for (int j = 0; j < 8; ++j) { const int n = (lane >> 3) + 8 * j; const LAS float* s = scr + (8 * kc) * 65 + n;
        u32x4 o; o.x = cvtpk_hw(s[0 * 65], s[1 * 65]); o.y = cvtpk_hw(s[2 * 65], s[3 * 65]); o.z = cvtpk_hw(s[4 * 65], s[5 * 65]); o.w = cvtpk_hw(s[6 * 65], s[7 * 65]);
        *(u32x4*)(WT + (size_t)n * ldt + 8 * kc) = o; }
    LDS_WAIT(); asm volatile("" ::: "memory");
}

__device__ __forceinline__ void p0_prologue(const Args& a, const Ctx& c) {
    unsigned char* ws = a.ws;
    bf16_t* WGU = (bf16_t*)(ws + WS_WGU); bf16_t* WD = (bf16_t*)(ws + WS_WD); bf16_t* WIN = (bf16_t*)(ws + WS_WIN); bf16_t* WMKV = (bf16_t*)(ws + WS_WMKV);
    bf16_t* WOUT = (bf16_t*)(ws + WS_WOUT); bf16_t* WR = (bf16_t*)(ws + WS_WR);
    LAS float* WfT = (LAS float*)c.lds;
    LAS float* scr = (LAS float*)(c.lds + c.wave * 16640);
    const int gw = c.vcu * 8 + c.wave, NGW = c.G * 8;
    constexpr int NEXP_ITEMS = 0;
    constexpr int I_WIN = 512, I_MKV = 128, I_OUT = 192, I_R = 64;
    constexpr int NITEMS = NEXP_ITEMS + I_WIN + I_MKV + I_OUT + I_R;
    for (int it = gw; it < NITEMS; it += NGW) {
        int r = it;
        if (r < NEXP_ITEMS) { const int e = r / 192; r -= e * 192;
            if (r < 128) { const int up = r >> 6; r &= 63; const int kb = r >> 2, nb = r & 3, n0 = nb * 64;
                const float* src = (e < NE) ? ((up ? a.w_up : a.w_gate) + (size_t)e * DM * EH) : (up ? a.ws_up : a.ws_gate);
                const int drow = (n0 >> 7) * 256 + up * 128 + (n0 & 127);
                tr_item64(src + (size_t)kb * 64 * EH + n0, EH, WGU + ((size_t)e * 512 + drow) * DM + kb * 64, DM, scr, c.lane);
            } else { r -= 128; const int kb = r >> 4, nb = r & 15;
                const float* src = (e < NE) ? (a.w_down + (size_t)e * EH * DM) : a.ws_down;
                tr_item64(src + (size_t)kb * 64 * DM + nb * 64, DM, WD + ((size_t)e * DM + nb * 64) * EH + kb * 64, EH, scr, c.lane); }
            continue; }
        r -= NEXP_ITEMS;
        if (r < I_WIN) {
            int col0, drow0, nbw;
            if (r < 128) { col0 = 256; drow0 = 0; nbw = 8; } else if (r < 256) { r -= 128; col0 = 768; drow0 = 512; nbw = 8; } else if (r < 384) { r -= 256; col0 = 1280; drow0 = 1024; nbw = 8; }
            else if (r < 448) { r -= 384; col0 = 0; drow0 = 1536; nbw = 4; } else { r -= 448; col0 = 1800; drow0 = 1792; nbw = 4; }
            const int kb = r / nbw, nb = r % nbw;
            tr_item64(a.w_in + (size_t)kb * 64 * INC + col0 + nb * 64, INC, WIN + (size_t)(drow0 + nb * 64) * DM + kb * 64, DM, scr, c.lane);
            continue; }
        r -= I_WIN;
        if (r < I_MKV) { const int kb = r >> 3, nb = r & 7; tr_item64(a.w_mem_kv + (size_t)kb * 64 * 512 + nb * 64, 512, WMKV + (size_t)(nb * 64) * DM + kb * 64, DM, scr, c.lane); continue; }
        r -= I_MKV;
        if (r < I_OUT) { const int kb = r >> 4, nb = r & 15; tr_item64(a.w_out + (size_t)(256 + kb * 64) * DM + nb * 64, DM, WOUT + (size_t)(nb * 64) * DM + 256 + kb * 64, DM, scr, c.lane); continue; }
        r -= I_OUT;
        { const int kb = r >> 2, nb = r & 3; tr_item64(a.w_router + (size_t)kb * 64 * NE + nb * 64, NE, WR + (size_t)(nb * 64) * DM + kb * 64, DM, scr, c.lane); }
    }
    __syncthreads();
    for (int idx = c.tid; idx < 8192; idx += 512) { const int h = idx & 7, k = idx >> 3; WfT[h * 1024 + k] = a.w_in[(size_t)k * INC + 1792 + h]; }
    for (int idx = (c.vcu * 512 + c.tid); idx < 256 * 1024; idx += c.G * 512) { const int k = idx >> 10, n = idx & 1023, g = k >> 6, cc = k & 63; float s = 0.f;
        for (int d = 0; d < 64; ++d) s += a.w_pool[g * 4096 + cc * 64 + d] * a.pool_scale[g * 64 + d] * a.w_out[(size_t)(g * 64 + d) * DM + n];
        WOUT[(size_t)n * DM + k] = (bf16_t)f2bf(s); }
    __syncthreads();
    bf16_t* XB = (bf16_t*)(ws + WS_XB); float* FLOG = (float*)(ws + WS_FLOG);
    for (int m = gw; m < T; m += NGW) {
        const f32x4* xr = (const f32x4*)(a.x + (size_t)m * DM) + c.lane; f32x4 v[4];
#pragma unroll
        for (int j = 0; j < 4; ++j) v[j] = xr[64 * j];
        u32x2* o8 = (u32x2*)(XB + (size_t)m * DM) + c.lane;
#pragma unroll
        for (int j = 0; j < 4; ++j) o8[64 * j] = (u32x2){pk2(v[j].x, v[j].y), pk2(v[j].z, v[j].w)};
        float acc[8];
#pragma unroll
        for (int h = 0; h < 8; ++h) { float s = 0.f;
#pragma unroll
            for (int j = 0; j < 4; ++j) { const f32x4 w = *(const LAS f32x4*)(WfT + h * 1024 + 4 * c.lane + 256 * j); s += (v[j].x * w.x + v[j].y * w.y) + (v[j].z * w.z + v[j].w * w.w); }
            acc[h] = s; }
        float b4[4], b2[2], z;
        { const bool up = (c.lane & 32) != 0;
#pragma unroll
          for (int i = 0; i < 4; ++i) { const float keep = up ? acc[4 + i] : acc[i], give = up ? acc[i] : acc[4 + i]; b4[i] = keep + __shfl_xor(give, 32); } }
        { const bool up = (c.lane & 16) != 0;
#pragma unroll
          for (int i = 0; i < 2; ++i) { const float keep = up ? b4[2 + i] : b4[i], give = up ? b4[i] : b4[2 + i]; b2[i] = keep + __shfl_xor(give, 16); } }
        { const bool up = (c.lane & 8) != 0; const float keep = up ? b2[1] : b2[0], give = up ? b2[0] : b2[1]; z = keep + __shfl_xor(give, 8); }
        z += __shfl_xor(z, 4); z += __shfl_xor(z, 2); z += __shfl_xor(z, 1);
        if ((c.lane & 7) == 0) { const int h = ((c.lane >> 5) & 1) * 4 + ((c.lane >> 4) & 1) * 2 + ((c.lane >> 3) & 1); z += a.b_f[h];
            const float lf = (z >= 0.f) ? -log1pf(expf(-z)) : (z - log1pf(expf(z))); FLOG[(size_t)m * 8 + h] = lf; }
    }
    bf16_t* MEMB = (bf16_t*)(ws + WS_MEMB);
    for (int m = gw; m < NB * 256; m += NGW) {
        const f32x4* xr = (const f32x4*)(a.mem + (size_t)m * DM) + c.lane; u32x2* o8 = (u32x2*)(MEMB + (size_t)m * DM) + c.lane;
#pragma unroll
        for (int j = 0; j < 4; ++j) { const f32x4 v = xr[64 * j]; o8[64 * j] = (u32x2){pk2(v.x, v.y), pk2(v.z, v.w)}; }
    }
}

__device__ __forceinline__ void p1_fscan(const Args& a, const Ctx& c) {
    if (c.vcu >= 64) return;
    const float* FLOG = (const float*)(a.ws + WS_FLOG); float* FC = (float*)(a.ws + WS_FC);
    LAS float* wtot = (LAS float*)c.lds;
    const int bh = c.vcu, b = bh >> 3, h = bh & 7; float p[8]; float run = 0.f;
#pragma unroll
    for (int i = 0; i < 8; ++i) { run += FLOG[((size_t)b * SEQ + c.tid * 8 + i) * 8 + h]; p[i] = run; }
    float inc = run;
#pragma unroll
    for (int o = 1; o < 64; o <<= 1) { const float t = __shfl_up(inc, o); if (c.lane >= o) inc += t; }
    if (c.lane == 63) wtot[c.wave] = inc;
    __syncthreads();
    float base = inc - run;
    for (int w = 0; w < c.wave; ++w) base += wtot[w];
#pragma unroll
    for (int i = 0; i < 8; ++i) FC[(size_t)bh * SEQ + c.tid * 8 + i] = (base + p[i]) * LOG2E;
    __syncthreads();
}

__device__ __forceinline__ void p2_mixers(const Args& a, const Ctx& c) {
    unsigned char* ws = a.ws;
    const bf16_t* Q = (const bf16_t*)(ws + WS_Q); const bf16_t* Kb = (const bf16_t*)(ws + WS_K); const bf16_t* V = (const bf16_t*)(ws + WS_V); const bf16_t* QM = (const bf16_t*)(ws + WS_QM);
    const bf16_t* U = (const bf16_t*)(ws + WS_U); const bf16_t* KVM = (const bf16_t*)(ws + WS_KVM); bf16_t* YMIX = (bf16_t*)(ws + WS_YMIX); const float* FC = (const float*)(ws + WS_FC);
    { const int cp = c.tid & 127, rg = c.tid >> 7, ch = 2 * cp, w = 2 << (ch >> 6);
      for (int i = 0; i < 32; ++i) { const int t = c.vcu * 128 + rg * 32 + i; if (t >= T) break; const int pos = t & (SEQ - 1), cnt = (pos + 1 < w) ? pos + 1 : w;
          float s0 = 0.f, s1 = 0.f, u0 = 0.f, u1 = 0.f;
          for (int jw = 0; jw < cnt; ++jw) { const unsigned wv = *(const unsigned*)(U + (size_t)(t - jw) * 256 + ch); const float x0 = bflo(wv), x1 = bfhi(wv); s0 += x0; s1 += x1; if (jw == 0) { u0 = x0; u1 = x1; } }
          const float inv = 1.0f / (float)cnt;
          *(unsigned*)(YMIX + (size_t)t * DM + ch) = pk2(s0 * inv - u0, s1 * inv - u1); } }
    __syncthreads();
    ConvBg bg; bg.w_gate = a.w_gate; bg.w_up = a.w_up; bg.w_down = a.w_down; bg.ws_gate = a.ws_gate; bg.ws_up = a.ws_up; bg.ws_down = a.ws_down;
    bg.WGU = (bf16_t*)(ws + WS_WGU); bg.WD = (bf16_t*)(ws + WS_WD); bg.scr = (LAS float*)(c.lds + BG_OFF + c.wave * 8448); bg.lane = c.lane;
    bg.it = c.vcu * 8 + c.wave; bg.end = ConvBg::NIT; bg.stride = c.G * 8; bg.it0 = bg.it; bg.nl = 0; bg.pend = false; bg.dst = nullptr; bg.ldt = 0;
#pragma unroll
    for (int i = 0; i < 8; ++i) bg.v[i] = (f32x4){0.f, 0.f, 0.f, 0.f};
    { const int s = c.vcu >> 6, r = c.vcu & 63; const float* nrm = (const float*)(ws + WS_CTL) + CW_NRM;
      for (int i = 0; i < 4; ++i) { const int qb = (i == 0) ? s : (i == 1) ? 15 - s : (i == 2) ? 7 - s : 8 + s; const int bh = (r + 17 * i) & 63, b = bh >> 3, h = bh & 7;
          att::Job j; const size_t row0 = (size_t)b * SEQ;
          { const float q2 = nrm[bh * 4 + 0] + nrm[bh * 4 + 1], k2 = nrm[bh * 4 + 2] + nrm[bh * 4 + 3]; j.qk2 = 2.02f * sqrtf(q2 * k2); }
          j.Q = Q + (row0 + qb * 256) * 512 + h * 64; j.qpitch = 512; j.K = Kb + row0 * 512 + h * 64; j.V = V + row0 * 512 + h * 64; j.kvpitch = 512;
          j.O = YMIX + (row0 + qb * 256) * DM + 256 + h * 64; j.nt = 4 * qb + 4; j.causal = 1; j.FC = FC + (size_t)bh * SEQ; j.q0 = qb * 256;
          att::unit<true>(j, c.lds, bg); } }
    for (int i = 0; i < 2; ++i) { const int mu = c.vcu * 2 + i, b = mu >> 6, hm = (mu >> 4) & 3, qb = mu & 15;
        att::Job j; const size_t row0 = (size_t)b * SEQ + qb * 256;
        j.Q = QM + row0 * 256 + hm * 64; j.qpitch = 256; j.K = KVM + (size_t)b * 256 * 512 + hm * 64; j.V = KVM + (size_t)b * 256 * 512 + 256 + hm * 64; j.kvpitch = 512;
        j.O = YMIX + row0 * DM + 768 + hm * 64; j.nt = 4; j.causal = 0; j.FC = nullptr; j.q0 = 0; j.qk2 = 0.f;
        att::unit<false>(j, c.lds, bg); }
    while (bg.busy()) { bg.finish(); bg.issue(); }
}

__device__ __forceinline__ void p4_ln1(const Args& a, const Ctx& c) {
    bf16_t* X1B = (bf16_t*)(a.ws + WS_X1B); const int gw = c.vcu * 8 + c.wave, NGW = c.G * 8;
    f32x4 g4[4], b4[4];
#pragma unroll
    for (int j = 0; j < 4; ++j) { g4[j] = *((const f32x4*)a.ln1_g + c.lane + 64 * j); b4[j] = *((const f32x4*)a.ln1_b + c.lane + 64 * j); }
    for (int m = gw; m < T; m += NGW) {
        const u32x2* xr = (const u32x2*)(a.out + (size_t)m * DM) + c.lane; f32x4 v[4]; float s = 0.f;
#pragma unroll
        for (int j = 0; j < 4; ++j) { const u32x2 hw = xr[64 * j]; v[j] = (f32x4){bflo(hw.x), bfhi(hw.x), bflo(hw.y), bfhi(hw.y)}; s += (v[j].x + v[j].y) + (v[j].z + v[j].w); }
        const float mean = wave_sum(s) * (1.f / DM); float s2 = 0.f;
#pragma unroll
        for (int j = 0; j < 4; ++j) { v[j] = v[j] - mean; s2 += (v[j].x * v[j].x + v[j].y * v[j].y) + (v[j].z * v[j].z + v[j].w * v[j].w); }
        const float rstd = 1.f / sqrtf(wave_sum(s2) * (1.f / DM) + LN_EPS);
        u32x2* o8 = (u32x2*)(X1B + (size_t)m * DM) + c.lane;
#pragma unroll
        for (int j = 0; j < 4; ++j) { const f32x4 y = v[j] * rstd * g4[j] + b4[j]; o8[64 * j] = (u32x2){pk2(y.x, y.y), pk2(y.z, y.w)}; }
    }
}

__device__ __forceinline__ float wave_max_f(float v) {
    int x = __float_as_int(v);  v = fmaxf(v, __int_as_float(__builtin_amdgcn_update_dpp(x, x, 0x121, 0xf, 0xf, false)));
    x = __float_as_int(v);      v = fmaxf(v, __int_as_float(__builtin_amdgcn_update_dpp(x, x, 0x122, 0xf, 0xf, false)));
    x = __float_as_int(v);      v = fmaxf(v, __int_as_float(__builtin_amdgcn_update_dpp(x, x, 0x124, 0xf, 0xf, false)));
    x = __float_as_int(v);      v = fmaxf(v, __int_as_float(__builtin_amdgcn_update_dpp(x, x, 0x128, 0xf, 0xf, false)));
    x = __float_as_int(v);
    const float a = __int_as_float(__builtin_amdgcn_readlane(x, 0)), b = __int_as_float(__builtin_amdgcn_readlane(x, 16)), c = __int_as_float(__builtin_amdgcn_readlane(x, 32)), d = __int_as_float(__builtin_amdgcn_readlane(x, 48));
    return fmaxf(fmaxf(a, b), fmaxf(c, d));
}
#define CSWAP(va, ia, sa, vb, ib, sb) do { const bool sw_ = (vb > va) || (vb == va && ib < ia); const float tv_ = sw_ ? vb : va, tw_ = sw_ ? va : vb; const int ti_ = sw_ ? ib : ia, tj_ = sw_ ? ia : ib; \
    const float ts_ = sw_ ? sb : sa, tt_ = sw_ ? sa : sb; va = tv_; vb = tw_; ia = ti_; ib = tj_; sa = ts_; sb = tt_; } while (0)
__device__ __forceinline__ void p6_route(const Args& a, const Ctx& c) {
    const float* LOG = (const float*)(a.ws + WS_LOG); int* cnt = (int*)(a.ws + WS_CTL); int* bins = (int*)(a.ws + WS_BINS); float* gates = (float*)(a.ws + WS_GATES);
    LAS int* hist = (LAS int*)c.lds; LAS int* base = hist + 256; LAS unsigned short* asg_e = (LAS unsigned short*)(base + 256); LAS unsigned short* asg_r = asg_e + 1024;
    const int lane = c.lane;
    const f32x4 bs = *((const f32x4*)a.router_bias + lane);
    for (int chunk = c.vcu; chunk < T / 128; chunk += c.G) {
        __syncthreads();
        if (c.tid < 256) hist[c.tid] = 0;
        __syncthreads();
        for (int i = 0; i < 16; ++i) {
            const int lt = c.wave * 16 + i, tok = chunk * 128 + lt;
            const f32x4 lg = *((const f32x4*)(LOG + (size_t)tok * NE) + lane);
            float s0 = 1.f / (1.f + expf(-lg.x)), s1 = 1.f / (1.f + expf(-lg.y)), s2 = 1.f / (1.f + expf(-lg.z)), s3 = 1.f / (1.f + expf(-lg.w));
            float v0 = s0 + bs.x, v1 = s1 + bs.y, v2 = s2 + bs.z, v3 = s3 + bs.w;
            int i0 = 4 * lane, i1 = i0 + 1, i2 = i0 + 2, i3 = i0 + 3;
            CSWAP(v0, i0, s0, v1, i1, s1); CSWAP(v2, i2, s2, v3, i3, s3); CSWAP(v0, i0, s0, v2, i2, s2); CSWAP(v1, i1, s1, v3, i3, s3); CSWAP(v1, i1, s1, v2, i2, s2);
            float m1 = v0, m2 = v1;
#pragma unroll
            for (int o = 1; o < 8; o <<= 1) { const float o1 = __shfl_xor(m1, o), o2 = __shfl_xor(m2, o); const float n1 = fmaxf(m1, o1), n2 = fmaxf(fminf(m1, o1), fmaxf(m2, o2)); m1 = n1; m2 = n2; }
            const float gs = m1 + m2; const int g = lane >> 3; int rank = 0; const int gsx = __float_as_int(gs);
#pragma unroll
            for (int jg = 0; jg < 8; ++jg) { const float gj = __int_as_float(__builtin_amdgcn_readlane(gsx, 8 * jg)); rank += (gj > gs || (gj == gs && jg < g)) ? 1 : 0; }
            if (rank >= 4) { v0 = -INFINITY; v1 = -INFINITY; v2 = -INFINITY; v3 = -INFINITY; }
            int my_e = 0; float my_s = 0.f;
#pragma unroll
            for (int k = 0; k < TOPK; ++k) {
                const float m = wave_max_f(v0);
                const unsigned long long mk = __ballot(v0 == m);
                const int wl = (int)__builtin_ctzll(mk);
                const int ek = __builtin_amdgcn_readlane(i0, wl); const float sk = __int_as_float(__builtin_amdgcn_readlane(__float_as_int(s0), wl));
                if (lane == wl) { v0 = v1; i0 = i1; s0 = s1; v1 = v2; i1 = i2; s1 = s2; v2 = v3; i2 = i3; s2 = s3; v3 = -INFINITY; }
                if (lane == k) { my_e = ek; my_s = sk; }
            }
            float tot = (lane < 8) ? my_s : 0.f;
            tot += __shfl_xor(tot, 1); tot += __shfl_xor(tot, 2); tot += __shfl_xor(tot, 4);
            if (lane < 8) { const int lr = __hip_atomic_fetch_add(&hist[my_e], 1, __ATOMIC_RELAXED, __HIP_MEMORY_SCOPE_WORKGROUP); asg_e[lt * 8 + lane] = (unsigned short)my_e; asg_r[lt * 8 + lane] = (unsigned short)lr; gates[(size_t)tok * 8 + lane] = my_s / tot * 2.5f; }
        }
        __syncthreads();
        if (c.tid < 256) { const int n = hist[c.tid]; base[c.tid] = n ? atomicAdd(&cnt[c.tid * 64], n) : 0; }
        __syncthreads();
        for (int sl = c.tid; sl < 1024; sl += 512) { const int e = asg_e[sl]; bins[(size_t)e * T + base[e] + asg_r[sl]] = chunk * 1024 + sl; }
    }
    __syncthreads();
}
#undef CSWAP

__device__ __forceinline__ int build_tables(const Args& a, const Ctx& c) {
    const int* cnt = (const int*)(a.ws + WS_CTL);
    LAS unsigned short* te = (LAS unsigned short*)(c.lds + TE_OFF); LAS int* tb = (LAS int*)(c.lds + TB_OFF); LAS int* cn = (LAS int*)(c.lds + CN_OFF);
    __syncthreads();
    if (c.tid < NE) cn[c.tid] = __hip_atomic_load(cnt + c.tid * 64, __ATOMIC_RELAXED, __HIP_MEMORY_SCOPE_AGENT);
    __syncthreads();
    if (c.tid == 0) { int run = 0; for (int e = 0; e < NE; ++e) { tb[e] = run; run += (cn[e] + 255) >> 8; } tb[NE] = run; }
    __syncthreads();
    if (c.tid < NE) { const int n = (cn[c.tid] + 255) >> 8, b0 = tb[c.tid]; for (int jt = 0; jt < n; ++jt) te[b0 + jt] = (unsigned short)c.tid; }
    __syncthreads();
    LAS unsigned short* ord = (LAS unsigned short*)(c.lds + OR_OFF); LAS int* fb = (LAS int*)c.lds;
    const int NTR = tb[NE];
    if (c.tid < NE) { const int n = (cn[c.tid] + 255) >> 8; const int lastrows = cn[c.tid] - (n - 1) * 256; fb[c.tid] = (n > 0 && lastrows <= 128) ? n - 1 : n; }
    __syncthreads();
    if (c.tid == 0) { int run = 0, hrun = 0; for (int e = 0; e < NE; ++e) { const int nf = fb[e]; const int n = (cn[e] + 255) >> 8; fb[256 + e] = run; run += nf; fb[512 + e] = hrun; hrun += n - nf; } fb[768] = run; }
    __syncthreads();
    { const int NF = fb[768];
      if (c.tid < NE) { const int n = (cn[c.tid] + 255) >> 8, nf = fb[c.tid], b0 = tb[c.tid]; for (int jt = 0; jt < nf; ++jt) ord[fb[256 + c.tid] + jt] = (unsigned short)(b0 + jt);
          if (n > nf) ord[NF + 128 + fb[512 + c.tid]] = (unsigned short)(b0 + n - 1); }
      if (c.tid < 128) ord[NF + c.tid] = (unsigned short)(NTR + c.tid); }
    __syncthreads();
    return NTR;
}

__device__ __forceinline__ void p9_combine(const Args& a, const Ctx& c) {
    const bf16_t* X1B = (const bf16_t*)(a.ws + WS_X1B); const bf16_t* Y = (const bf16_t*)(a.ws + WS_Y); const int gw = c.vcu * 8 + c.wave, NGW = c.G * 8;
    const int* ridx = (const int*)(a.ws + WS_ROWIDX); const float* gts = (const float*)(a.ws + WS_GATES);
    f32x4 g4[4], b4[4];
#pragma unroll
    for (int j = 0; j < 4; ++j) { g4[j] = *((const f32x4*)a.ln2_g + c.lane + 64 * j); b4[j] = *((const f32x4*)a.ln2_b + c.lane + 64 * j); }
    for (int m = gw; m < T; m += NGW) {
        f32x4* orow = (f32x4*)(a.out + (size_t)m * DM) + c.lane; f32x4 v[4]; float s = 0.f;
        const u32x2* x8 = (const u32x2*)(X1B + (size_t)m * DM) + c.lane;
        const u32x2* s8 = (const u32x2*)(a.out + (size_t)m * DM) + c.lane;
#pragma unroll
        for (int j = 0; j < 4; ++j) { const u32x2 xw = x8[64 * j], sw = s8[64 * j]; v[j] = (f32x4){bflo(sw.x), bfhi(sw.x), bflo(sw.y), bfhi(sw.y)} + (f32x4){bflo(xw.x), bfhi(xw.x), bflo(xw.y), bfhi(xw.y)} * ALPHA; }
        f32x4 ys[4];
#pragma unroll
        for (int j = 0; j < 4; ++j) ys[j] = (f32x4){0.f, 0.f, 0.f, 0.f};
        const int ypos = (((4 * c.lane) >> 5) & 3) * 64 + (((4 * c.lane) >> 3) & 3) * 16 + (((4 * c.lane) >> 7) & 1) * 8 + ((4 * c.lane) & 7);
        const int my_r = ridx[(size_t)m * TOPK + (c.lane & 7)]; const float my_g = gts[(size_t)m * TOPK + (c.lane & 7)];
#pragma unroll
        for (int k = 0; k < TOPK; ++k) { const int rr = __builtin_amdgcn_readlane(my_r, k); const float gk = __int_as_float(__builtin_amdgcn_readlane(__float_as_int(my_g), k));
            const unsigned char* yrow = (const unsigned char*)Y + (size_t)rr * DM + ypos;
#pragma unroll
            for (int j = 0; j < 4; ++j) { const int yw = *(const int*)(yrow + 256 * j); const f32x2 lo = __builtin_amdgcn_cvt_pk_f32_fp8(yw, false), hi2 = __builtin_amdgcn_cvt_pk_f32_fp8(yw, true); ys[j] += (f32x4){lo.x, lo.y, hi2.x, hi2.y} * gk; } }
#pragma unroll
        for (int j = 0; j < 4; ++j) v[j] += ys[j] * YINV;
#pragma unroll
        for (int j = 0; j < 4; ++j) s += (v[j].x + v[j].y) + (v[j].z + v[j].w);
        const float mean = wave_sum(s) * (1.f / DM); float s2 = 0.f;
#pragma unroll
        for (int j = 0; j < 4; ++j) { v[j] = v[j] - mean; s2 += (v[j].x * v[j].x + v[j].y * v[j].y) + (v[j].z * v[j].z + v[j].w * v[j].w); }
        const float rstd = 1.f / sqrtf(wave_sum(s2) * (1.f / DM) + LN_EPS);
#pragma unroll
        for (int j = 0; j < 4; ++j) orow[64 * j] = v[j] * rstd * g4[j] + b4[j];
    }
}

constexpr int NPHASE = 10;

__global__ void __launch_bounds__(512, 2) mk_fwd(Args a) {
    extern __shared__ __attribute__((aligned(16))) unsigned char lds_raw[];
    cg::grid_group grid = cg::this_grid();
    Ctx c; c.lds = (LAS unsigned char*)lds_raw; c.tid = threadIdx.x; c.lane = c.tid & 63; c.wave = __builtin_amdgcn_readfirstlane(c.tid >> 6); c.G = gridDim.x;
    { const int bx = blockIdx.x; c.vcu = (c.G % 8 == 0) ? (bx % 8) * (c.G / 8) + bx / 8 : bx; }
    unsigned char* ws = a.ws; const int lo = a.ph_lo, hi = a.ph_hi;
#define IN(k) (lo <= (k) && (k) < hi)
    for (int u = c.tid; u < 32; u += 512) ((volatile LAS unsigned*)(c.lds + MISC_OFF))[u] = 0u;
    __syncthreads();
    XcdBarrier bar = xcd_barrier_post((unsigned*)(ws + WS_CTL) + CW_BAR + a.li * XCD_BAR_WORDS, (volatile LAS unsigned*)(c.lds + MISC_OFF) + 8);
    if (a.ph_lo < 0) grid.sync();
    unsigned long long pt_acc = 0ull;
#define PT_ON(id) (PROBE_T == (id))
#define SEAM(k) do { if (IN(k) && IN((k) + 1)) { if (PT_ON(10 + (k)) || PT_ON(30)) { const unsigned long long t0_ = __builtin_amdgcn_s_memrealtime(); xcd_barrier(bar); pt_acc += __builtin_amdgcn_s_memrealtime() - t0_; } else xcd_barrier(bar); } } while (0)
#define PH_BEGIN(k) unsigned long long pt0_##k = 0ull; if (PT_ON(k)) pt0_##k = __builtin_amdgcn_s_memrealtime();
#define PH_END(k) if (PT_ON(k)) { asm volatile("s_waitcnt vmcnt(0)" ::: "memory"); __syncthreads(); pt_acc += __builtin_amdgcn_s_memrealtime() - pt0_##k; }
    { PH_BEGIN(0) if (IN(0)) p0_prologue(a, c); PH_END(0) }
    SEAM(0);
    { PH_BEGIN(1) if (IN(1)) {
        p1_fscan(a, c);
        { pg8::DenseSched S; S.init(T, 2048, DM, c.G, (int)blockIdx.x, ws + WS_WIN);
          pg8::EpiInProj E{(bf16_t*)(ws + WS_Q), (bf16_t*)(ws + WS_K), (bf16_t*)(ws + WS_V), (bf16_t*)(ws + WS_U), (bf16_t*)(ws + WS_QM), (unsigned*)(ws + WS_CTL) + CW_NRM};
          pg8::gemm_phase(c.lds, (const char*)(ws + WS_XB), DM, S, E); }
        { pg8::DenseSched S; S.init(NB * 256, 512, DM, c.G, (int)blockIdx.x, ws + WS_WMKV);
          pg8::EpiBf16 E{(bf16_t*)(ws + WS_KVM), 512};
          pg8::gemm_phase(c.lds, (const char*)(ws + WS_MEMB), DM, S, E); }
    } PH_END(1) }
    SEAM(1);
    { PH_BEGIN(2) if (IN(2)) p2_mixers(a, c); PH_END(2) }
    SEAM(2);
    { PH_BEGIN(3) if (IN(3)) { pg8::DenseSched S; S.init(T, DM, DM, c.G, (int)blockIdx.x, ws + WS_WOUT);
        pg8::EpiRes16 E{(bf16_t*)a.out, a.x, ALPHA};
        pg8::gemm_phase<PT_ON(23)>(c.lds, (const char*)(ws + WS_YMIX), DM, S, E, &pt_acc); } PH_END(3) }
    SEAM(3);
    { PH_BEGIN(4) if (IN(4)) p4_ln1(a, c); PH_END(4) }
    SEAM(4);
    { PH_BEGIN(5) if (IN(5)) { pg8::DenseSched S; S.init(T, NE, DM, c.G, (int)blockIdx.x, ws + WS_WR);
        pg8::EpiF32 E{(float*)(ws + WS_LOG), NE, nullptr, 0.f};
        pg8::gemm_phase(c.lds, (const char*)(ws + WS_X1B), DM, S, E); } PH_END(5) }
    SEAM(5);
    { PH_BEGIN(6) if (IN(6)) p6_route(a, c); PH_END(6) }
    SEAM(6);
    { PH_BEGIN(7) if (IN(7)) { const int NTR = build_tables(a, c);
        pg8::GroupSched S; S.nunits = (NTR + 128) * 2; S.G = c.G; S.c = c.vcu; S.shift = 1; S.NTR = NTR; S.mode = 0; S.K = DM;
        S.tile_e = (const LAS unsigned short*)(c.lds + TE_OFF); S.tbase = (const LAS int*)(c.lds + TB_OFF); S.cnt = (const LAS int*)(c.lds + CN_OFF);
        S.bins = (const int*)(ws + WS_BINS); S.Bt = (const char*)(ws + WS_WGU); S.estride = (size_t)512 * DM * 2; S.rowidx = (int*)(ws + WS_ROWIDX); S.order = (const LAS unsigned short*)(c.lds + OR_OFF);
        pg8::EpiGateUp E{(bf16_t*)(ws + WS_HB)};
        pg8::gemm_phase<PT_ON(27)>(c.lds, (const char*)(ws + WS_X1B), DM, S, E, &pt_acc); } PH_END(7) }
    SEAM(7);
    { PH_BEGIN(8) if (IN(8)) { const int NTR = build_tables(a, c);
        pg8::GroupSched S; S.nunits = (NTR + 128) * 4; S.G = c.G; S.c = c.vcu; S.shift = 2; S.NTR = NTR; S.mode = 1; S.K = EH;
        S.tile_e = (const LAS unsigned short*)(c.lds + TE_OFF); S.tbase = (const LAS int*)(c.lds + TB_OFF); S.cnt = (const LAS int*)(c.lds + CN_OFF);
        S.bins = (const int*)(ws + WS_BINS); S.Bt = (const char*)(ws + WS_WD); S.estride = (size_t)DM * EH * 2; S.rowidx = nullptr; S.order = (const LAS unsigned short*)(c.lds + OR_OFF);
        pg8::EpiDown E{(bf16_t*)(ws + WS_Y), a.out, (const int*)(ws + WS_BINS), (const float*)(ws + WS_GATES)};
        pg8::gemm_phase<PT_ON(28)>(c.lds, (const char*)(ws + WS_HB), EH, S, E, &pt_acc); } PH_END(8) }
    SEAM(8);
    { PH_BEGIN(9) if (IN(9)) p9_combine(a, c); PH_END(9) }
    if (PROBE_T >= 0) {
        unsigned* pw = (unsigned*)(ws + WS_CTL) + CW_PROBE;
        if (c.tid == 0) { if (PROBE_MODE == 0) atomicMax(pw, (unsigned)pt_acc); else atomicAdd(pw, (unsigned)pt_acc); }
        xcd_barrier(bar);
        if (blockIdx.x == 0 && c.tid == 0) { unsigned v = __hip_atomic_load(pw, __ATOMIC_RELAXED, __HIP_MEMORY_SCOPE_AGENT); if (PROBE_MODE == 1) v /= (unsigned)c.G;
            const unsigned long long t0 = __builtin_amdgcn_s_memrealtime(); while (__builtin_amdgcn_s_memrealtime() - t0 < (unsigned long long)v * PROBE_MULT) __builtin_amdgcn_s_sleep(8); }
    }
#undef IN
#undef SEAM
}

#ifndef MK_N_LAUNCHES
#define MK_N_LAUNCHES 1
#endif
extern "C" void kernel_launch(void* const* d_in, const int* in_sizes, int n_in, void* d_out, int out_size, void* d_ws, size_t ws_size, hipStream_t stream) {
    static int grid = 0;
    if (grid == 0) {
        if (n_in != 20 || out_size != T * DM || ws_size < WS_END) { fprintf(stderr, "kernel_launch: unexpected shapes (n_in %d out %d ws %zu)\n", n_in, out_size, ws_size); grid = -1; return; }
        int dev = 0, cus = 0, per_cu = 0;
        (void)hipGetDevice(&dev); (void)hipDeviceGetAttribute(&cus, hipDeviceAttributeMultiprocessorCount, dev);
        if (hipFuncSetAttribute((const void*)mk_fwd, hipFuncAttributeMaxDynamicSharedMemorySize, LDS_BYTES) != hipSuccess) { fprintf(stderr, "kernel_launch: hipFuncSetAttribute failed\n"); grid = -1; return; }
        (void)hipOccupancyMaxActiveBlocksPerMultiprocessor(&per_cu, (const void*)mk_fwd, 512, LDS_BYTES);
        if (per_cu < 1) { fprintf(stderr, "kernel_launch: occupancy query says %d blocks per CU\n", per_cu); grid = -1; return; }
        grid = cus;
        if (grid != 256) fprintf(stderr, "kernel_launch: %d CUs (built for 256)\n", grid);
    }
    if (grid < 0) return;
    (void)hipMemsetAsync((char*)d_ws + WS_CTL, 0, CTL_ZERO_BYTES, stream);
    Args a{};
    const float** p = (const float**)&a;
    for (int i = 0; i < 20; ++i) p[i] = (const float*)d_in[i];
    a.out = (float*)d_out; a.ws = (unsigned char*)d_ws;
    const int nl = MK_N_LAUNCHES;
    for (int li = 0; li < nl; ++li) {
        a.ph_lo = (nl == 1) ? 0 : li; a.ph_hi = (nl == 1) ? NPHASE : li + 1; a.li = li;
        void* args[] = {&a};
        const hipError_t e = hipLaunchCooperativeKernel((void*)mk_fwd, dim3(grid), dim3(512), args, LDS_BYTES, stream);
        if (e != hipSuccess) { fprintf(stderr, "kernel_launch: cooperative launch failed: %s\n", hipGetErrorString(e)); break; }
    }
}
```

```cpp
#include <hip/hip_runtime.h>
#include <hip/hip_cooperative_groups.h>
#include <cstdio>
#include <cstdint>
namespace cg = cooperative_groups;
#ifndef PROBE_T
#define PROBE_T -1
#endif
#ifndef PROBE_MODE
#define PROBE_MODE 0
#endif
#define PROBE_MULT 4
constexpr int CW_PROBE = 20000;
#define PT_BEGIN(id) unsigned long long ptb_##id = 0ull; if (PROBE_T == (id)) ptb_##id = __builtin_amdgcn_s_memrealtime();
#define PT_END(id, tacc) if (PROBE_T == (id)) { asm volatile("s_waitcnt vmcnt(0)" ::: "memory"); __syncthreads(); *(tacc) += __builtin_amdgcn_s_memrealtime() - ptb_##id; }

#define LAS __attribute__((address_space(3)))
typedef unsigned short bf16_t;
typedef short bf16x8 __attribute__((ext_vector_type(8)));
typedef short s16x4 __attribute__((ext_vector_type(4)));
typedef float f32x4 __attribute__((ext_vector_type(4)));
typedef float f32x2 __attribute__((ext_vector_type(2)));
typedef float f32x16 __attribute__((ext_vector_type(16)));
typedef unsigned u32x4 __attribute__((ext_vector_type(4)));
typedef unsigned u32x2 __attribute__((ext_vector_type(2)));

constexpr int NB = 8, SEQ = 4096, T = NB * SEQ, DM = 1024;
constexpr int INC = 2056;
constexpr int NE = 256, TOPK = 8, EH = 256;
constexpr float ALPHA = 1.189207115002721f;
constexpr float LN_EPS = 1e-5f;
constexpr float LOG2E = 1.4426950408889634f;
constexpr float C2 = 0.125f * LOG2E;
constexpr int MAXTILES = 1280 + 128;
constexpr float YSCALE = 32.f, YINV = 1.f / 32.f;

constexpr size_t MiB = 1u << 20;
constexpr size_t WS_CTL = 0, WS_WD = 1 * MiB, WS_HB = 130 * MiB, WS_X1B = 306 * MiB, WS_BINS = 370 * MiB, WS_GATES = 402 * MiB, WS_FC = 403 * MiB, WS_FLOG = 404 * MiB,
                 WS_KVM = 405 * MiB, WS_Y = 408 * MiB, WS_WGU = 408 * MiB, WS_WIN = 665 * MiB, WS_WMKV = 669 * MiB, WS_WOUT = 670 * MiB, WS_WR = 672 * MiB, WS_MEMB = 673 * MiB,
                 WS_XB = 677 * MiB, WS_Q = 741 * MiB, WS_K = 773 * MiB, WS_V = 805 * MiB, WS_QM = 837 * MiB, WS_U = 853 * MiB, WS_YMIX = 869 * MiB, WS_LOG = 933 * MiB, WS_END = 965 * MiB;
constexpr size_t CTL_ZERO_BYTES = 1 * MiB;
constexpr size_t WS_ROWIDX = WS_FLOG;
constexpr int CW_Q = 16400 + 256;
constexpr int CW_NRM = 16384;

constexpr int RING_BYTES = 131072;
constexpr int TE_OFF = 131072, TB_OFF = 135168, CN_OFF = 137216, OR_OFF = 138240  , BG_OFF = 83968  , MISC_OFF = 155648, LDS_BYTES = 156672;

struct Args {
    const float *x, *mem, *w_in, *b_f, *w_pool, *pool_scale, *w_mem_kv, *w_out, *ln1_g, *ln1_b, *w_router, *router_bias, *w_gate, *w_up, *w_down, *ws_gate, *ws_up, *ws_down, *ln2_g, *ln2_b;
    float* out; unsigned char* ws; int ph_lo, ph_hi, li, pad;
};

__device__ __forceinline__ unsigned f2bf(float f) { unsigned u = __float_as_uint(f); return (u + 0x7fffu + ((u >> 16) & 1u)) >> 16; }
__device__ __forceinline__ unsigned pk2(float lo, float hi) { return f2bf(lo) | (f2bf(hi) << 16); }
__device__ __forceinline__ float bflo(unsigned w) { return __uint_as_float(w << 16); }
__device__ __forceinline__ float bfhi(unsigned w) { return __uint_as_float(w & 0xffff0000u); }
__device__ __forceinline__ float wave_sum(float v) {
#pragma unroll
    for (int o = 1; o < 64; o <<= 1) v += __shfl_xor(v, o);
    return v;
}
#define LDS_WAIT() asm volatile("s_waitcnt lgkmcnt(0)" ::: "memory")

namespace pg8 {
constexpr int BM = 256, BK = 64, HALF = 128, HTB = HALF * BK * 2, NXCD = 8, WGM = 8;
__device__ __forceinline__ int lds_byte(int r, int c) { const int st = (r >> 4) * 2 + (c >> 5), rr = r & 15, cc = c & 31, ob = rr * 64 + cc * 2; return st * 1024 + (ob ^ (((ob >> 9) & 1) << 5)); }
__device__ __forceinline__ void stage_rc(int b, int& R, int& C) { const int st = b / 1024, sb = b % 1024, swz = sb ^ (((sb >> 9) & 1) << 5); R = (st >> 1) * 16 + swz / 64; C = (st & 1) * 32 + (swz % 64) / 2; }
__device__ __forceinline__ int perm32(int rho) { const int n = rho >> 4, i = rho & 15; return 8 * (i >> 2) + 4 * n + (i & 3); }
__device__ __forceinline__ int xcd_remap(int L, int nwg) { const int q = nwg / NXCD, r = nwg % NXCD, xcd = L % NXCD, off = L / NXCD; return (xcd < r ? xcd * (q + 1) : r * (q + 1) + (xcd - r) * q) + off; }

struct Unit { int pm, pn, e, rows, mt, rb; };

struct DenseSched {
    int nM, nN, nwg, G, c, K, half; const char* Bt;
    __device__ __forceinline__ void init(int M, int N, int K_, int G_, int c_, const void* Bt_) { nM = M / BM; nN = N / BM; nwg = nM * nN; G = G_; c = c_; K = K_; Bt = (const char*)Bt_; half = 0; }
    __device__ __forceinline__ void init_half(int M, int N, int K_, int G_, int c_, const void* Bt_) { nM = M / HALF; nN = N / BM; nwg = nM * nN; G = G_; c = c_; K = K_; Bt = (const char*)Bt_; half = 1; }
    __device__ __forceinline__ bool next(int i, Unit& u) const {
        const long L = (long)i * G + c; if (L >= nwg) return false;
        if (half) { const int q = (int)L / nN; u.pm = q >> 1; u.pn = (int)L % nN; u.e = 0; u.rows = HALF; u.mt = q; u.rb = q * HALF; return true; }
        const int wgid = xcd_remap((int)L, nwg);
        const int nig = WGM * nN, gid = wgid / nig, fm = gid * WGM, gsz = (nM - fm) < WGM ? (nM - fm) : WGM;
        u.pm = fm + ((wgid % nig) % gsz); u.pn = (wgid % nig) / gsz; u.e = 0; u.rows = 256; u.mt = u.pm; u.rb = u.pm * BM; return true;
    }
    __device__ __forceinline__ unsigned a_off(const Unit& u, int h, int R, int C) const { return (unsigned)(((u.rb + h * HALF + R) * K + C) * 2); }
    __device__ __forceinline__ const char* b_ptr(const Unit& u) const { return Bt + (size_t)u.pn * BM * K * 2; }
};

struct GroupSched {
    int nunits, G, c, shift, NTR, mode, K; const LAS unsigned short* tile_e; const LAS int* tbase; const LAS int* cnt; const int* bins; const char* Bt; size_t estride; int* rowidx; const LAS unsigned short* order;
    __device__ __forceinline__ bool next(int i, Unit& u) const {
        const long L = (long)i * G + c; if (L >= nunits) return false;
        const int wgid = (int)L;
        const int tau = order[wgid >> shift]; u.pn = wgid & ((1 << shift) - 1); u.pm = tau; u.rb = tau * 256;
        if (tau < NTR) { const int e = tile_e[tau]; u.e = e; u.mt = tau - tbase[e]; const int left = cnt[e] - u.mt * 256; u.rows = left < 256 ? left : 256; }
        else { u.e = NE; u.mt = tau - NTR; u.rows = 256; }
        return true;
    }
    __device__ __forceinline__ unsigned a_off(const Unit& u, int h, int R, int C) const {
        if (mode == 0) { const int rl = h * HALF + R; int tok;
            if (u.e < NE) { if (rl < u.rows) { const int a = bins[(size_t)u.e * T + u.mt * 256 + rl]; tok = a >> 3; if (C == 0 && u.pn == 0) rowidx[a] = u.pm * 256 + rl; } else tok = 0; }
            else tok = u.mt * 256 + rl;
            return (unsigned)((tok * 1024 + C) * 2); }
        return (unsigned)(((u.pm * BM + h * HALF + R) * 256 + C) * 2);
    }
    __device__ __forceinline__ const char* b_ptr(const Unit& u) const { return Bt + (size_t)u.e * estride + (size_t)u.pn * BM * K * 2; }
};

__device__ __forceinline__ unsigned cvt_pk_bf16(float lo, float hi) { unsigned r; asm volatile("v_cvt_pk_bf16_f32 %0, %1, %2" : "=v"(r) : "v"(lo), "v"(hi)); return r; }

template <bool TIME = false, class Epi, class Sched>
__device__ __forceinline__ void gemm_phase(LAS unsigned char* lds, const char* Abase, int K, const Sched& S, const Epi& E, unsigned long long* tacc = nullptr) {
    const int tid = threadIdx.x, wid = __builtin_amdgcn_readfirstlane(tid >> 6), lane = tid & 63, wr = wid >> 2, wc = wid & 3, fr = lane & 15, fq = lane >> 4;
    const int nt = K / BK;
    int RA[2], CA[2]; unsigned voffB[2];
#pragma unroll
    for (int i = 0; i < 2; ++i) { int R, C; stage_rc(tid * 16 + i * 8192, R, C); const int Rb = Epi::PERM ? ((R & ~31) + perm32(R & 31)) : R; RA[i] = R; CA[i] = C; voffB[i] = (unsigned)(Rb * K + C) * 2u; }
    const size_t kstep = (size_t)(BK * 2);
    const size_t hstep = (size_t)HALF * K * 2;
    const unsigned ldsw = (unsigned)wid * 1024u;
    const int aoff = lds_byte(wr * 64 + fr, fq * 8), boff = lds_byte(wc * 32 + fr, fq * 8);
#define PG8_SA(b, h) (((b) * 2 + (h)) * HTB)
#define PG8_SB(b, h) ((4 + (b) * 2 + (h)) * HTB)
#define PG8_STAGEB(bufoff, gbase) do { _Pragma("unroll") for (int _i = 0; _i < 2; ++_i) \
        __builtin_amdgcn_global_load_lds((const unsigned*)((const char*)(gbase) + voffB[_i]), (LAS unsigned*)(lds + (bufoff) + ldsw + _i * 8192), 16, 0, 0); } while (0)
#define PG8_STAGEA(bufoff, koff, v0, v1) do { \
        __builtin_amdgcn_global_load_lds((const unsigned*)(Abase + (koff) + (v0)), (LAS unsigned*)(lds + (bufoff) + ldsw), 16, 0, 0); \
        __builtin_amdgcn_global_load_lds((const unsigned*)(Abase + (koff) + (v1)), (LAS unsigned*)(lds + (bufoff) + ldsw + 8192), 16, 0, 0); } while (0)
#define PG8_LDA(dst, b, h) do { _Pragma("unroll") for (int m = 0; m < 4; ++m) _Pragma("unroll") for (int k = 0; k < 2; ++k) dst[m][k] = *(const LAS bf16x8*)(lds + PG8_SA(b, h) + aoff + m * 2048 + k * 1024); } while (0)
#define PG8_LDB(dst, b, h) do { _Pragma("unroll") for (int n = 0; n < 2; ++n) _Pragma("unroll") for (int k = 0; k < 2; ++k) dst[n][k] = *(const LAS bf16x8*)(lds + PG8_SB(b, h) + boff + n * 2048 + k * 1024); } while (0)
#define PG8_MMA(ai, bj, At, Bt) do { __builtin_amdgcn_s_setprio(1); _Pragma("unroll") for (int m = 0; m < 4; ++m) _Pragma("unroll") for (int n = 0; n < 2; ++n) _Pragma("unroll") for (int k = 0; k < 2; ++k) \
        acc[ai][bj][m][n] = __builtin_amdgcn_mfma_f32_16x16x32_bf16(Bt[n][k], At[m][k], acc[ai][bj][m][n], 0, 0, 0); __builtin_amdgcn_s_setprio(0); } while (0)
#define PG8_WAIT_V(n) asm volatile("s_waitcnt vmcnt(" #n ")" ::: "memory")
#define PG8_WAIT_L(n) asm volatile("s_waitcnt lgkmcnt(" #n ")" ::: "memory")
#define PG8_BAR __builtin_amdgcn_s_barrier()
#define PG8_SCHED __builtin_amdgcn_sched_barrier(0)
    Unit cur, nxt; int ui = 0;
    if (!S.next(0, cur)) return;
    unsigned vc00 = S.a_off(cur, 0, RA[0], CA[0]), vc01 = S.a_off(cur, 0, RA[1], CA[1]), vc10 = S.a_off(cur, 1, RA[0], CA[0]), vc11 = S.a_off(cur, 1, RA[1], CA[1]);
    asm volatile("" : "+v"(vc00), "+v"(vc01), "+v"(vc10), "+v"(vc11));
    f32x4 acc[2][2][4][2];
#pragma unroll
    for (int a = 0; a < 2; ++a)
#pragma unroll
        for (int b = 0; b < 2; ++b)
#pragma unroll
            for (int m = 0; m < 4; ++m)
#pragma unroll
                for (int n = 0; n < 2; ++n) acc[a][b][m][n] = (f32x4){0.f, 0.f, 0.f, 0.f};
    bf16x8 At[4][2], B0[2][2], B1[2][2];
    const char* cB = S.b_ptr(cur);
    PG8_STAGEB(PG8_SB(0, 0), cB); PG8_STAGEB(PG8_SB(0, 1), cB + hstep); PG8_STAGEA(PG8_SA(0, 0), 0, vc00, vc01); PG8_STAGEA(PG8_SA(0, 1), 0, vc10, vc11);
    if (wr == 1) PG8_BAR;
    PG8_WAIT_V(2); PG8_BAR;
    PG8_STAGEB(PG8_SB(1, 0), cB + kstep); PG8_STAGEA(PG8_SA(1, 0), kstep, vc00, vc01); PG8_STAGEB(PG8_SB(1, 1), cB + hstep + kstep);
    PG8_WAIT_V(6); PG8_BAR;
    for (;;) {
        const bool has_next = S.next(ui + 1, nxt);
        unsigned vn00 = vc00, vn01 = vc01, vn10 = vc10, vn11 = vc11;
        if (has_next) { vn00 = S.a_off(nxt, 0, RA[0], CA[0]); vn01 = S.a_off(nxt, 0, RA[1], CA[1]); vn10 = S.a_off(nxt, 1, RA[0], CA[0]); vn11 = S.a_off(nxt, 1, RA[1], CA[1]); }
        asm volatile("" : "+v"(vn00), "+v"(vn01), "+v"(vn10), "+v"(vn11));
        const char* nB = has_next ? S.b_ptr(nxt) : cB;
        const bool full = cur.rows > HALF;
        for (int t = 0; t < nt; t += 2) {
            const bool last = (t == nt - 2);
            const size_t k1 = (size_t)(t + 1) * kstep;
            const size_t k2 = last ? 0 : (size_t)(t + 2) * kstep, k3 = k2 + kstep;
            const char* b2 = last ? nB : cB + (size_t)(t + 2) * kstep; const char* b3 = b2 + kstep;
            const unsigned s00 = last ? vn00 : vc00, s01 = last ? vn01 : vc01, s10 = last ? vn10 : vc10, s11 = last ? vn11 : vc11;
            PG8_LDB(B0, 0, 0); PG8_LDB(B1, 0, 1); PG8_SCHED; PG8_LDA(At, 0, 0); PG8_STAGEA(PG8_SA(1, 1), k1, vc10, vc11);
            PG8_WAIT_V(8); PG8_WAIT_L(0); PG8_BAR; PG8_MMA(0, 0, At, B0); PG8_MMA(0, 1, At, B1); PG8_BAR; PG8_SCHED;
            PG8_LDA(At, 0, 1); PG8_STAGEB(PG8_SB(0, 0), b2); PG8_STAGEB(PG8_SB(0, 1), b2 + hstep); PG8_STAGEA(PG8_SA(0, 0), k2, s00, s01);
            PG8_WAIT_V(8); PG8_WAIT_L(0); PG8_BAR; if (full) { PG8_MMA(1, 0, At, B0); PG8_MMA(1, 1, At, B1); } PG8_BAR; PG8_SCHED;
            PG8_LDB(B0, 1, 0); PG8_LDB(B1, 1, 1); PG8_SCHED; PG8_LDA(At, 1, 0); PG8_STAGEA(PG8_SA(0, 1), k2, s10, s11);
            PG8_WAIT_V(8); PG8_WAIT_L(0); PG8_BAR; PG8_MMA(0, 0, At, B0); PG8_MMA(0, 1, At, B1); PG8_BAR; PG8_SCHED;
            PG8_LDA(At, 1, 1); PG8_STAGEB(PG8_SB(1, 0), b3); PG8_STAGEB(PG8_SB(1, 1), b3 + hstep); PG8_STAGEA(PG8_SA(1, 0), k3, s00, s01);
            PG8_WAIT_V(8); PG8_WAIT_L(0); PG8_BAR; if (full) { PG8_MMA(1, 0, At, B0); PG8_MMA(1, 1, At, B1); } PG8_BAR; PG8_SCHED;
        }
        if (wr == 0) PG8_BAR;
        if constexpr (TIME) { const unsigned long long t0_ = __builtin_amdgcn_s_memrealtime(); E(acc, cur, wr, wc, fr, fq); asm volatile("s_waitcnt vmcnt(0)" ::: "memory"); *tacc += __builtin_amdgcn_s_memrealtime() - t0_; }
        else E(acc, cur, wr, wc, fr, fq);
        if (!has_next) break;
#pragma unroll
        for (int a = 0; a < 2; ++a)
#pragma unroll
            for (int b = 0; b < 2; ++b)
#pragma unroll
                for (int m = 0; m < 4; ++m)
#pragma unroll
                    for (int n = 0; n < 2; ++n) acc[a][b][m][n] = (f32x4){0.f, 0.f, 0.f, 0.f};
        cur = nxt; cB = nB; vc00 = vn00; vc01 = vn01; vc10 = vn10; vc11 = vn11; ++ui;
        if (wr == 1) PG8_BAR;
    }
    PG8_WAIT_V(0);
    PG8_BAR;
#undef PG8_SA
#undef PG8_SB
#undef PG8_STAGEA
#undef PG8_STAGEB
#undef PG8_LDA
#undef PG8_LDB
#undef PG8_MMA
#undef PG8_WAIT_V
#undef PG8_WAIT_L
#undef PG8_BAR
#undef PG8_SCHED
}

struct EpiInProj {
    static constexpr bool PERM = true;
    bf16_t *Q, *Kb, *V, *U, *QM; unsigned* nrm;
    __device__ __forceinline__ void operator()(const f32x4 (&acc)[2][2][4][2], const Unit& u, int wr, int wc, int fr, int fq) const {
        bf16_t* base; int ldc, colt; float sc = 1.f; const int pn = u.pn;
        float nmax[2] = {0.f, 0.f};
        if (pn < 2) { base = Q; ldc = 512; colt = pn * 256; sc = C2; } else if (pn < 4) { base = Kb; ldc = 512; colt = (pn - 2) * 256; } else if (pn < 6) { base = V; ldc = 512; colt = (pn - 4) * 256; }
        else if (pn == 6) { base = U; ldc = 256; colt = 0; } else { base = QM; ldc = 256; colt = 0; sc = C2; }
        const int row0 = u.pm * BM + wr * 64 + fr, col0 = colt + wc * 32 + 8 * fq;
#pragma unroll
        for (int ai = 0; ai < 2; ++ai)
#pragma unroll
            for (int m = 0; m < 4; ++m) { bf16_t* rowp = base + (size_t)(row0 + ai * HALF + m * 16) * ldc + col0;
#pragma unroll
                for (int bj = 0; bj < 2; ++bj) { const f32x4 v0 = acc[ai][bj][m][0] * sc, v1 = acc[ai][bj][m][1] * sc;
                    u32x4 w; w.x = cvt_pk_bf16(v0[0], v0[1]); w.y = cvt_pk_bf16(v0[2], v0[3]); w.z = cvt_pk_bf16(v1[0], v1[1]); w.w = cvt_pk_bf16(v1[2], v1[3]);
                    *(u32x4*)(rowp + bj * HALF) = w;
                    if (pn < 4) { float q = (v0[0] * v0[0] + v0[1] * v0[1]) + (v0[2] * v0[2] + v0[3] * v0[3]) + (v1[0] * v1[0] + v1[1] * v1[1]) + (v1[2] * v1[2] + v1[3] * v1[3]);
                        q += __shfl_xor(q, 16); q += __shfl_xor(q, 32); nmax[bj] = fmaxf(nmax[bj], q); } } }
        if (pn < 4) {
#pragma unroll
            for (int bj = 0; bj < 2; ++bj) { float q = nmax[bj];
#pragma unroll
                for (int o = 1; o < 16; o <<= 1) q = fmaxf(q, __shfl_xor(q, o));
                if (fr == 0 && fq == 0) { const int b = (u.pm * BM) / SEQ, h = (pn & 1) * 4 + 2 * bj + (wc >> 1), kind = pn >> 1;
                    atomicMax(nrm + ((b * 8 + h) * 2 + kind) * 2 + (wc & 1), __float_as_uint(q)); } }
        }
    }
};
struct EpiBf16 {
    static constexpr bool PERM = true;
    bf16_t* O; int ldc;
    __device__ __forceinline__ void operator()(const f32x4 (&acc)[2][2][4][2], const Unit& u, int wr, int wc, int fr, int fq) const {
        const int row0 = u.rb + wr * 64 + fr, col0 = u.pn * BM + wc * 32 + 8 * fq;
#pragma unroll
        for (int ai = 0; ai < 2; ++ai)
#pragma unroll
            for (int m = 0; m < 4; ++m) { if (ai * HALF >= u.rows) continue; bf16_t* rowp = O + (size_t)(row0 + ai * HALF + m * 16) * ldc + col0;
#pragma unroll
                for (int bj = 0; bj < 2; ++bj) { const f32x4 v0 = acc[ai][bj][m][0], v1 = acc[ai][bj][m][1];
                    u32x4 w; w.x = cvt_pk_bf16(v0[0], v0[1]); w.y = cvt_pk_bf16(v0[2], v0[3]); w.z = cvt_pk_bf16(v1[0], v1[1]); w.w = cvt_pk_bf16(v1[2], v1[3]);
                    *(u32x4*)(rowp + bj * HALF) = w; } }
    }
};
struct EpiRes16 {
    static constexpr bool PERM = true;
    bf16_t* O; const float* R; float rs;
    __device__ __forceinline__ void operator()(const f32x4 (&acc)[2][2][4][2], const Unit& u, int wr, int wc, int fr, int fq) const {
        const int row0 = u.pm * BM + wr * 64 + fr, col0 = u.pn * BM + wc * 32 + 8 * fq;
#pragma unroll
        for (int ai = 0; ai < 2; ++ai)
#pragma unroll
            for (int m = 0; m < 4; ++m) { const size_t row = (size_t)(row0 + ai * HALF + m * 16);
#pragma unroll
                for (int bj = 0; bj < 2; ++bj) { const float* rp = R + row * DM + col0 + bj * HALF;
                    const f32x4 v0 = acc[ai][bj][m][0] + *(const f32x4*)rp * rs, v1 = acc[ai][bj][m][1] + *(const f32x4*)(rp + 4) * rs;
                    u32x4 w; w.x = cvt_pk_bf16(v0[0], v0[1]); w.y = cvt_pk_bf16(v0[2], v0[3]); w.z = cvt_pk_bf16(v1[0], v1[1]); w.w = cvt_pk_bf16(v1[2], v1[3]);
                    *(u32x4*)(O + row * (2 * DM) + col0 + bj * HALF) = w; }
                if (m & 1) asm volatile("" ::: "memory"); }
    }
};
struct EpiF32 {
    static constexpr bool PERM = false;
    float* C; int ldc; const float* R; float rs;
    __device__ __forceinline__ void operator()(const f32x4 (&acc)[2][2][4][2], const Unit& u, int wr, int wc, int fr, int fq) const {
        const int row0 = u.rb + wr * 64 + fr, col0 = u.pn * BM + wc * 32 + 4 * fq;
#pragma unroll
        for (int ai = 0; ai < 2; ++ai)
#pragma unroll
            for (int m = 0; m < 4; ++m) { if (ai * HALF >= u.rows) continue; const size_t off = (size_t)(row0 + ai * HALF + m * 16) * ldc + col0;
#pragma unroll
                for (int bj = 0; bj < 2; ++bj)
#pragma unroll
                    for (int n = 0; n < 2; ++n) { f32x4 v = acc[ai][bj][m][n]; if (R) v += *(const f32x4*)(R + off + bj * HALF + n * 16) * rs; *(f32x4*)(C + off + bj * HALF + n * 16) = v; }
                if (m & 1) asm volatile("" ::: "memory"); }
    }
};
struct EpiGateUp {
    static constexpr bool PERM = true;
    bf16_t* H;
    __device__ __forceinline__ void operator()(const f32x4 (&acc)[2][2][4][2], const Unit& u, int wr, int wc, int fr, int fq) const {
        const int row0 = u.pm * BM + wr * 64 + fr, col0 = u.pn * 128 + wc * 32 + 8 * fq;
#pragma unroll
        for (int ai = 0; ai < 2; ++ai)
#pragma unroll
            for (int m = 0; m < 4; ++m) { bf16_t* rowp = H + (size_t)(row0 + ai * HALF + m * 16) * EH + col0; float hv[8];
#pragma unroll
                for (int n = 0; n < 2; ++n)
#pragma unroll
                    for (int j = 0; j < 4; ++j) { const float g = acc[ai][0][m][n][j], up = acc[ai][1][m][n][j]; hv[n * 4 + j] = g * __builtin_amdgcn_rcpf(1.f + __builtin_amdgcn_exp2f(-g * LOG2E)) * up; }
                u32x4 w; w.x = cvt_pk_bf16(hv[0], hv[1]); w.y = cvt_pk_bf16(hv[2], hv[3]); w.z = cvt_pk_bf16(hv[4], hv[5]); w.w = cvt_pk_bf16(hv[6], hv[7]);
                *(u32x4*)rowp = w; }
    }
};
struct EpiDown {
    static constexpr bool PERM = true;
    bf16_t* Y; float* SH; const int* bins; const float* gates;
    __device__ __forceinline__ void operator()(const f32x4 (&acc)[2][2][4][2], const Unit& u, int wr, int wc, int fr, int fq) const {
        const int col0 = u.pn * BM + wc * 32 + 8 * fq;
        if (u.e == NE) {
#pragma unroll
            for (int ai = 0; ai < 2; ++ai)
#pragma unroll
                for (int m = 0; m < 4; ++m) { const int tok = u.mt * 256 + ai * HALF + wr * 64 + m * 16 + fr; bf16_t* rowp = (bf16_t*)(SH + (size_t)tok * DM) + col0;
#pragma unroll
                    for (int bj = 0; bj < 2; ++bj) { const f32x4 v0 = acc[ai][bj][m][0], v1 = acc[ai][bj][m][1];
                        u32x4 w; w.x = cvt_pk_bf16(v0[0], v0[1]); w.y = cvt_pk_bf16(v0[2], v0[3]); w.z = cvt_pk_bf16(v1[0], v1[1]); w.w = cvt_pk_bf16(v1[2], v1[3]);
                        *(u32x4*)(rowp + bj * HALF) = w; } }
        } else {
#pragma unroll
            for (int ai = 0; ai < 2; ++ai)
#pragma unroll
                for (int m = 0; m < 4; ++m) { const int rl = ai * HALF + wr * 64 + m * 16 + fr; if (rl >= u.rows) continue;
                    unsigned char* rowp = (unsigned char*)Y + (size_t)(u.pm * 256 + rl) * DM + u.pn * BM + wc * 64 + fq * 16;
                    unsigned w[4];
#pragma unroll
                    for (int bj = 0; bj < 2; ++bj) { f32x4 v0 = acc[ai][bj][m][0] * YSCALE, v1 = acc[ai][bj][m][1] * YSCALE;
#pragma unroll
                        for (int q = 0; q < 4; ++q) { v0[q] = __builtin_fminf(__builtin_fmaxf(v0[q], -440.f), 440.f); v1[q] = __builtin_fminf(__builtin_fmaxf(v1[q], -440.f), 440.f); }
                        int w0 = 0, w1 = 0; w0 = __builtin_amdgcn_cvt_pk_fp8_f32(v0[0], v0[1], w0, false); w0 = __builtin_amdgcn_cvt_pk_fp8_f32(v0[2], v0[3], w0, true);
                        w1 = __builtin_amdgcn_cvt_pk_fp8_f32(v1[0], v1[1], w1, false); w1 = __builtin_amdgcn_cvt_pk_fp8_f32(v1[2], v1[3], w1, true);
                        w[2 * bj] = (unsigned)w0; w[2 * bj + 1] = (unsigned)w1; }
                    *(u32x4*)rowp = (u32x4){w[0], w[1], w[2], w[3]}; }
        }
    }
};
}


__device__ __forceinline__ unsigned cvtpk_bg(float lo, float hi) { unsigned r; asm volatile("v_cvt_pk_bf16_f32 %0, %1, %2" : "=v"(r) : "v"(lo), "v"(hi)); return r; }
struct ConvBg {
    const float *w_gate, *w_up, *w_down, *ws_gate, *ws_up, *ws_down; bf16_t *WGU, *WD;
    LAS float* scr; int lane, it, it0, end, stride, nl; bool pend; f32x4 v[8]; bf16_t* dst; int ldt;
    static constexpr int NIT = (NE + 1) * 384;
    __device__ __forceinline__ void decode(int r, const float*& src, int& ldw) {
        const int e = r / 384; r -= e * 384;
        if (r < 256) { const int up = r >> 7; r &= 127; const int kb = r >> 3, nb = r & 7, n0 = nb * 32;
            src = ((e < NE) ? ((up ? w_up : w_gate) + (size_t)e * DM * EH) : (up ? ws_up : ws_gate)) + (size_t)kb * 64 * EH + n0; ldw = EH;
            const int drow = (n0 >> 7) * 256 + up * 128 + (n0 & 127); dst = WGU + ((size_t)e * 512 + drow) * DM + kb * 64; ldt = DM;
        } else { r -= 256; const int kb = r >> 5, nb = r & 31;
            src = ((e < NE) ? (w_down + (size_t)e * EH * DM) : ws_down) + (size_t)kb * 64 * DM + nb * 32; ldw = DM;
            dst = WD + ((size_t)e * DM + nb * 32) * EH + kb * 64; ldt = EH; }
    }
    __device__ __forceinline__ void finish() {
        if (!pend) return;
        const int kq = lane >> 3, n4 = (lane & 7) * 4;
#pragma unroll
        for (int i = 0; i < 8; ++i) { LAS float* p = scr + (8 * i + kq) * 33 + n4; p[0] = v[i].x; p[1] = v[i].y; p[2] = v[i].z; p[3] = v[i].w; }
        LDS_WAIT(); asm volatile("" ::: "memory");
        const int c8 = lane & 7;
#pragma unroll
        for (int j = 0; j < 4; ++j) { const int n = (lane >> 3) + 8 * j; const LAS float* s = scr + (8 * c8) * 33 + n;
            u32x4 o; o.x = cvtpk_bg(s[0 * 33], s[1 * 33]); o.y = cvtpk_bg(s[2 * 33], s[3 * 33]); o.z = cvtpk_bg(s[4 * 33], s[5 * 33]); o.w = cvtpk_bg(s[6 * 33], s[7 * 33]);
            *(u32x4*)(dst + (size_t)n * ldt + 8 * c8) = o; }
        LDS_WAIT(); asm volatile("" ::: "memory");
        pend = false;
    }
    __device__ __forceinline__ void issue() {
        const bool valid = it < end; const float* src; int ldw; decode(valid ? it : it0, src, ldw);
        const int kq = lane >> 3, n4 = (lane & 7) * 4;
#pragma unroll
        for (int i = 0; i < 8; ++i) v[i] = __builtin_nontemporal_load((const f32x4*)(src + (size_t)(8 * i + kq) * ldw + n4));
        pend = valid; if (valid) it += stride; nl = 8;
    }
    __device__ __forceinline__ bool busy() const { return pend || it < end; }
};
struct NoBg { int nl; __device__ __forceinline__ void finish() {} __device__ __forceinline__ void issue() { nl = 0; } };

namespace att {
constexpr int SLOTB = 8192, L_K = 0, L_V = 2 * SLOTB, L_WS = 4 * SLOTB, L_OST = L_WS + 8 * 256, L_FK = L_OST + 8 * 4096, L_END = L_FK + 16384;
#define SBAR() __builtin_amdgcn_sched_barrier(0)
__device__ __forceinline__ int crow(int r, int hi) { return (r & 3) + 8 * (r >> 2) + 4 * hi; }
__device__ __forceinline__ void glds16(const void* gsrc, unsigned lds_dst) { unsigned keep;
    asm volatile("s_mov_b32 %0, m0\n\ts_mov_b32 m0, %2\n\ts_nop 0\n\tglobal_load_lds_dwordx4 %1, off\n\ts_mov_b32 m0, %0" : "=&s"(keep) : "v"(gsrc), "s"(lds_dst) : "memory"); }
__device__ __forceinline__ unsigned cvtpk(float lo, float hi) { unsigned r; asm("v_cvt_pk_bf16_f32 %0, %1, %2" : "=v"(r) : "v"(lo), "v"(hi)); return r; }
#define ATT_WAIT_BAR() asm volatile("s_waitcnt vmcnt(0) lgkmcnt(0)\n\ts_barrier" ::: "memory")

struct Job { const bf16_t* Q; int qpitch; const bf16_t* K; const bf16_t* V; int kvpitch; bf16_t* O; int nt; int causal; const float* FC; int q0; float qk2; };
constexpr float SKIP_LOG2 = 36.f;

template <bool FOX, class Bg> __device__ __forceinline__ void unit(const Job& j, LAS unsigned char* shm, Bg& bg) {
    const int tid = threadIdx.x, lane = tid & 63, r32 = lane & 31, hi = lane >> 5; const int wid = __builtin_amdgcn_readfirstlane(tid >> 6);
    const unsigned lds0 = (unsigned)(uintptr_t)shm;
    LAS float* wsf = (LAS float*)(shm + L_WS) + wid * 64;
    LAS float* fk = (LAS float*)(shm + L_FK);
    const int NT = j.nt;
    float fq = 0.f; int tlo = 0;
    if (FOX) {
        const float fq0 = j.FC[j.q0];
        const bool keep = (lane < NT) ? (j.qk2 + fq0 - j.FC[64 * lane + 63] >= -SKIP_LOG2) : false;
        const unsigned long long mk = __ballot(keep);
        tlo = (mk != 0ull) ? (int)__builtin_ctzll(mk) : NT - 1; tlo = __builtin_amdgcn_readfirstlane(tlo);
        for (int i = tlo * 16 + tid; i < NT * 16; i += 512) *(LAS f32x4*)(fk + 4 * i) = *(const f32x4*)(j.FC + 4 * i);
        fq = j.FC[j.q0 + wid * 32 + r32];
    }
    const int NTE = NT - tlo;
    const bf16_t* ksrc = j.K + (size_t)lane * j.kvpitch + wid * 8;
    const bf16_t* vsrc = j.V + (size_t)(16 * (wid & 3) + (lane >> 2)) * j.kvpitch + (wid >> 2) * 32 + (lane & 3) * 8;
    const unsigned kdst = lds0 + L_K + wid * 1024, vdst = lds0 + L_V + wid * 1024;
#define DMA_K(t, slot) glds16(ksrc + (size_t)(t) * 64 * j.kvpitch, (unsigned)__builtin_amdgcn_readfirstlane(kdst + (slot) * SLOTB))
#define DMA_V(t, slot) glds16(vsrc + (size_t)(t) * 64 * j.kvpitch, (unsigned)__builtin_amdgcn_readfirstlane(vdst + (slot) * SLOTB))
    const bf16_t* Qw = j.Q + (size_t)(wid * 32) * j.qpitch;
    bf16x8 qr[4];
#pragma unroll
    for (int d0 = 0; d0 < 4; ++d0) qr[d0] = *reinterpret_cast<const bf16x8*>(Qw + (size_t)r32 * j.qpitch + d0 * 16 + hi * 8);
    asm volatile("s_waitcnt vmcnt(0) lgkmcnt(0)" ::: "memory");
    bg.nl = 0;
    { const int t0 = FOX ? NT - 1 : 0; DMA_K(t0, 0); DMA_V(t0, 0); }
    float mrun = -1e30f, l_reg = 0.f; f32x16 o[2]; o[0] = f32x16{}; o[1] = f32x16{};
    const int qrel = wid * 32 + r32;
    for (int it = 0; it < NTE; ++it) {
        const int tcur = FOX ? NT - 1 - it : it, slot = it & 1;
        if (bg.nl == 8) asm volatile("s_waitcnt vmcnt(8) lgkmcnt(0)\n\ts_barrier" ::: "memory");
        else ATT_WAIT_BAR();
        bg.finish();
        if (it + 1 < NTE) { const int tn = FOX ? tcur - 1 : tcur + 1; DMA_K(tn, slot ^ 1); DMA_V(tn, slot ^ 1); }
        bg.issue();
        f32x16 p0, p1;
        if (FOX) {
#pragma unroll
            for (int g = 0; g < 4; ++g) { const f32x4 a = *(const LAS f32x4*)(fk + 64 * tcur + 8 * g + 4 * hi), b = *(const LAS f32x4*)(fk + 64 * tcur + 32 + 8 * g + 4 * hi);
#pragma unroll
                for (int i = 0; i < 4; ++i) { p0[4 * g + i] = fq - a[i]; p1[4 * g + i] = fq - b[i]; } }
        } else { p0 = f32x16{}; p1 = f32x16{}; }
        { const LAS unsigned char* kb = shm + L_K + slot * SLOTB + hi * 1024 + r32 * 16;
#pragma unroll
          for (int d0 = 0; d0 < 4; ++d0) { const bf16x8 b0 = *(const LAS bf16x8*)(kb + d0 * 2048), b1 = *(const LAS bf16x8*)(kb + d0 * 2048 + 512);
              p0 = __builtin_amdgcn_mfma_f32_32x32x16_bf16(b0, qr[d0], p0, 0, 0, 0); p1 = __builtin_amdgcn_mfma_f32_32x32x16_bf16(b1, qr[d0], p1, 0, 0, 0); } }
        if (j.causal && tcur >= NT - 4) { const int kb0 = 64 * (tcur - (NT - 4)) + 4 * hi;
#pragma unroll
            for (int r = 0; r < 16; ++r) { const int kv = kb0 + (r & 3) + 8 * (r >> 2); if (kv > qrel) p0[r] = -INFINITY; if (kv + 32 > qrel) p1[r] = -INFINITY; } }
        float rm = p0[0];
#pragma unroll
        for (int r = 1; r < 16; ++r) rm = fmaxf(rm, p0[r]);
#pragma unroll
        for (int r = 0; r < 16; ++r) rm = fmaxf(rm, p1[r]);
        rm = fmaxf(rm, __shfl_xor(rm, 32));
        const float mn = fmaxf(mrun, rm), alpha = __builtin_amdgcn_exp2f(mrun - mn); mrun = mn;
        float rs = 0.f;
#pragma unroll
        for (int r = 0; r < 16; ++r) { p0[r] = __builtin_amdgcn_exp2f(p0[r] - mn); p1[r] = __builtin_amdgcn_exp2f(p1[r] - mn); rs += p0[r] + p1[r]; }
        l_reg = l_reg * alpha + rs;
        if (hi == 0) wsf[r32] = alpha;
        LDS_WAIT();
#pragma unroll
        for (int r = 0; r < 16; ++r) { const float f = wsf[crow(r, hi)]; o[0][r] *= f; o[1][r] *= f; }
        u32x4 pw0, pw1, pw2, pw3;
        pw0 = (u32x4){cvtpk(p0[0], p0[1]), cvtpk(p0[2], p0[3]), cvtpk(p0[4], p0[5]), cvtpk(p0[6], p0[7])};
        pw1 = (u32x4){cvtpk(p0[8], p0[9]), cvtpk(p0[10], p0[11]), cvtpk(p0[12], p0[13]), cvtpk(p0[14], p0[15])};
        pw2 = (u32x4){cvtpk(p1[0], p1[1]), cvtpk(p1[2], p1[3]), cvtpk(p1[4], p1[5]), cvtpk(p1[6], p1[7])};
        pw3 = (u32x4){cvtpk(p1[8], p1[9]), cvtpk(p1[10], p1[11]), cvtpk(p1[12], p1[13]), cvtpk(p1[14], p1[15])};
        const bf16x8 pa0 = __builtin_bit_cast(bf16x8, pw0), pa1 = __builtin_bit_cast(bf16x8, pw1), pa2 = __builtin_bit_cast(bf16x8, pw2), pa3 = __builtin_bit_cast(bf16x8, pw3);
        const int vb = (int)(lds0 + L_V + slot * SLOTB) + ((lane >> 4) & 1) * 32 + (lane & 3) * 8 + (4 * hi + ((lane & 15) >> 2)) * 64;
#pragma unroll
        for (int d0 = 0; d0 < 2; ++d0) { s16x4 lo[4], hh[4];
#pragma unroll
            for (int ks = 0; ks < 4; ++ks) {
                asm volatile("ds_read_b64_tr_b16 %0,%1 offset:%c2" : "=&v"(lo[ks]) : "v"(vb), "i"(d0 * 4096 + ks * 1024) : "memory");
                asm volatile("ds_read_b64_tr_b16 %0,%1 offset:%c2" : "=&v"(hh[ks]) : "v"(vb), "i"(d0 * 4096 + ks * 1024 + 512) : "memory"); }
            asm volatile("s_waitcnt lgkmcnt(0)" ::: "memory"); SBAR();
#define PK(k) (bf16x8){lo[k][0], lo[k][1], lo[k][2], lo[k][3], hh[k][0], hh[k][1], hh[k][2], hh[k][3]}
            o[d0] = __builtin_amdgcn_mfma_f32_32x32x16_bf16(pa0, PK(0), o[d0], 0, 0, 0);
            o[d0] = __builtin_amdgcn_mfma_f32_32x32x16_bf16(pa1, PK(1), o[d0], 0, 0, 0);
            o[d0] = __builtin_amdgcn_mfma_f32_32x32x16_bf16(pa2, PK(2), o[d0], 0, 0, 0);
            o[d0] = __builtin_amdgcn_mfma_f32_32x32x16_bf16(pa3, PK(3), o[d0], 0, 0, 0);
#undef PK
        }
    }
    l_reg += __shfl_xor(l_reg, 32);
    if (hi == 0) wsf[32 + r32] = l_reg;
    LDS_WAIT();
    float rli[16];
#pragma unroll
    for (int r = 0; r < 16; ++r) rli[r] = 1.0f / wsf[32 + crow(r, hi)];
    bf16_t* Ow = j.O + (size_t)(wid * 32) * DM;
    { LAS bf16_t* stg = (LAS bf16_t*)(shm + L_OST) + wid * 2048;
#pragma unroll
      for (int r = 0; r < 16; ++r) { const int orow = crow(r, hi);
#pragma unroll
          for (int d0 = 0; d0 < 2; ++d0) stg[orow * 64 + d0 * 32 + r32] = (bf16_t)f2bf(o[d0][r] * rli[r]); }
      LDS_WAIT();
#pragma unroll
      for (int i = 0; i < 4; ++i) { const int row = i * 8 + (lane >> 3), ch = lane & 7; const u32x4 v = *(const LAS u32x4*)(stg + row * 64 + ch * 8); *(u32x4*)(Ow + (size_t)row * DM + ch * 8) = v; } }
    asm volatile("s_waitcnt vmcnt(0) lgkmcnt(0)\n\ts_barrier" ::: "memory");
#undef DMA_K
#undef DMA_V
}
#undef SBAR
}

#define XB_TMO      128
#define XB_XCNT(j)  (256  + 64 * (j))
#define XB_XSUB(j)  (1280 + 64 * (j))
#define XB_XGEN(j)  (2304 + 64 * (j))
#define XB_TOP      3328
#define XB_TOPGEN   3392
#define XCD_BAR_WORDS 3456
#define XB_SPIN_CAP (1u << 18)
constexpr int CW_BAR = 32768;
__device__ __forceinline__ unsigned xb_ld(unsigned* p)              { return __hip_atomic_load(p, __ATOMIC_RELAXED, __HIP_MEMORY_SCOPE_AGENT); }
__device__ __forceinline__ unsigned xb_add(unsigned* p, unsigned v) { return __hip_atomic_fetch_add(p, v, __ATOMIC_RELAXED, __HIP_MEMORY_SCOPE_AGENT); }
__device__ __forceinline__ unsigned xb_xcc_id() { return (unsigned)__builtin_amdgcn_s_getreg((3 << 11) | 20) & 0xFu; }
#define XB_SPIN(cond, bar) do { unsigned _sp = 0; while (cond) { __builtin_amdgcn_s_sleep(1); \
    if ((++_sp & 255u) == 0u) { if (xb_ld(&(bar)[XB_TMO])) break; if (_sp > XB_SPIN_CAP) { atomicAdd(&(bar)[XB_TMO], 1u); break; } } } } while (0)
struct XcdBarrier { unsigned* bar; unsigned x; volatile LAS unsigned* st; };
__device__ __forceinline__ XcdBarrier xcd_barrier_post(unsigned* bar, volatile LAS unsigned* st) {
    XcdBarrier b; b.bar = bar; b.x = xb_xcc_id(); b.st = st;
    if (threadIdx.x == 0) (void)xb_add(&bar[XB_XCNT(b.x)], 1u);
    return b;
}
__device__ __forceinline__ void xcd_barrier_complete(unsigned* bar, unsigned x, unsigned& nloc, unsigned& nx) {
    const unsigned G = gridDim.x * gridDim.y * gridDim.z;
    unsigned sum, cnt, mine, sp = 0u;
    for (;;) {
        sum = 0u; cnt = 0u; mine = 0u;
#pragma unroll
        for (unsigned j = 0; j < 16; ++j) { const unsigned c = xb_ld(&bar[XB_XCNT(j)]); sum += c; cnt += (c > 0u) ? 1u : 0u; mine = (j == x) ? c : mine; }
        if (sum == G) break;
        __builtin_amdgcn_s_sleep(1);
        if ((++sp & 255u) == 0u) { if (xb_ld(&bar[XB_TMO])) break; if (sp > XB_SPIN_CAP) { atomicAdd(&bar[XB_TMO], 1u); break; } }
    }
    nloc = mine > 0u ? mine : 1u; nx = cnt > 0u ? cnt : 1u;
}
__device__ __forceinline__ void xcd_barrier(const XcdBarrier& b) {
    asm volatile("s_waitcnt vmcnt(0)" ::: "memory");
    __syncthreads();
    if (threadIdx.x == 0) {
        unsigned* bar = b.bar;
        __builtin_amdgcn_s_waitcnt(0);
        unsigned nloc = b.st[0], nx = b.st[1];
        if (nloc == 0u) { xcd_barrier_complete(bar, b.x, nloc, nx); b.st[0] = nloc; b.st[1] = nx; }
        const unsigned old = xb_add(&bar[XB_XSUB(b.x)], 1u);
        const unsigned gen = old / nloc;
        if (old + 1u == (gen + 1u) * nloc) {
            __builtin_amdgcn_fence(__ATOMIC_RELEASE, "agent");
            asm volatile("s_waitcnt vmcnt(0)" ::: "memory");
            const unsigned og = xb_add(&bar[XB_TOP], 1u);
            const unsigned tg = og / nx;
            if (og + 1u == (tg + 1u) * nx) xb_add(&bar[XB_TOPGEN], 1u);
            else XB_SPIN(xb_ld(&bar[XB_TOPGEN]) == tg, bar);
            __builtin_amdgcn_fence(__ATOMIC_ACQUIRE, "agent");
            xb_add(&bar[XB_XGEN(b.x)], 1u);
            asm volatile("s_waitcnt vmcnt(0)" ::: "memory");
        } else {
            XB_SPIN(xb_ld(&bar[XB_XGEN(b.x)]) == gen, bar);
            __builtin_amdgcn_fence(__ATOMIC_ACQUIRE, "agent");
            asm volatile("s_waitcnt vmcnt(0)" ::: "memory");
        }
    }
    __syncthreads();
}

struct Ctx { int tid, lane, wave, vcu, G; LAS unsigned char* lds; };

__device__ __forceinline__ unsigned cvtpk_hw(float lo, float hi) { unsigned r; asm volatile("v_cvt_pk_bf16_f32 %0, %1, %2" : "=v"(r) : "v"(lo), "v"(hi)); return r; }
__device__ __forceinline__ void tr_item64(const float* W, int ldw, bf16_t* WT, int ldt, LAS float* scr, int lane) {
    const int kr = lane >> 4, n4 = (lane & 15) * 4;
#pragma unroll
    for (int hb = 0; hb < 2; ++hb) { f32x4 v[8];
#pragma unroll
        for (int i = 0; i < 8; ++i) v[i] = __builtin_nontemporal_load((const f32x4*)(W + (size_t)(4 * (8 * hb + i) + kr) * ldw + n4));
#pragma unroll
        for (int i = 0; i < 8; ++i) { LAS float* p = scr + (4 * (8 * hb + i) + kr) * 65 + n4; p[0] = v[i].x; p[1] = v[i].y; p[2] = v[i].z; p[3] = v[i].w; } }
    LDS_WAIT(); asm volatile("" ::: "memory");
    const int kc = lane & 7;
#pragma unroll
    for (int j = 0; j < 8; ++j) { const int n = (lane >> 3) + 8 * j; const LAS float* s = scr + (8 * kc) * 65 + n;
        u32x4 o; o.x = cvtpk_hw(s[0 * 65], s[1 * 65]); o.y = cvtpk_hw(s[2 * 65], s[3 * 65]); o.z = cvtpk_hw(s[4 * 65], s[5 * 65]); o.w = cvtpk_hw(s[6 * 65], s[7 * 65]);
        *(u32x4*)(WT + (size_t)n * ldt + 8 * kc) = o; }
    LDS_WAIT(); asm volatile("" ::: "memory");
}

__device__ __forceinline__ void p0_prologue(const Args& a, const Ctx& c) {
    unsigned char* ws = a.ws;
    bf16_t* WGU = (bf16_t*)(ws + WS_WGU); bf16_t* WD = (bf16_t*)(ws + WS_WD); bf16_t* WIN = (bf16_t*)(ws + WS_WIN); bf16_t* WMKV = (bf16_t*)(ws + WS_WMKV);
    bf16_t* WOUT = (bf16_t*)(ws + WS_WOUT); bf16_t* WR = (bf16_t*)(ws + WS_WR);
    LAS float* WfT = (LAS float*)c.lds;
    LAS float* scr = (LAS float*)(c.lds + c.wave * 16640);
    const int gw = c.vcu * 8 + c.wave, NGW = c.G * 8;
    constexpr int NEXP_ITEMS = 0;
    constexpr int I_WIN = 512, I_MKV = 128, I_OUT = 192, I_R = 64;
    constexpr int NITEMS = NEXP_ITEMS + I_WIN + I_MKV + I_OUT + I_R;
    for (int it = gw; it < NITEMS; it += NGW) {
        int r = it;
        if (r < NEXP_ITEMS) { const int e = r / 192; r -= e * 192;
            if (r < 128) { const int up = r >> 6; r &= 63; const int kb = r >> 2, nb = r & 3, n0 = nb * 64;
                const float* src = (e < NE) ? ((up ? a.w_up : a.w_gate) + (size_t)e * DM * EH) : (up ? a.ws_up : a.ws_gate);
                const int drow = (n0 >> 7) * 256 + up * 128 + (n0 & 127);
                tr_item64(src + (size_t)kb * 64 * EH + n0, EH, WGU + ((size_t)e * 512 + drow) * DM + kb * 64, DM, scr, c.lane);
            } else { r -= 128; const int kb = r >> 4, nb = r & 15;
                const float* src = (e < NE) ? (a.w_down + (size_t)e * EH * DM) : a.ws_down;
                tr_item64(src + (size_t)kb * 64 * DM + nb * 64, DM, WD + ((size_t)e * DM + nb * 64) * EH + kb * 64, EH, scr, c.lane); }
            continue; }
        r -= NEXP_ITEMS;
        if (r < I_WIN) {
            int col0, drow0, nbw;
            if (r < 128) { col0 = 256; drow0 = 0; nbw = 8; } else if (r < 256) { r -= 128; col0 = 768; drow0 = 512; nbw = 8; } else if (r < 384) { r -= 256; col0 = 1280; drow0 = 1024; nbw = 8; }
            else if (r < 448) { r -= 384; col0 = 0; drow0 = 1536; nbw = 4; } else { r -= 448; col0 = 1800; drow0 = 1792; nbw = 4; }
            const int kb = r / nbw, nb = r % nbw;
            tr_item64(a.w_in + (size_t)kb * 64 * INC + col0 + nb * 64, INC, WIN + (size_t)(drow0 + nb * 64) * DM + kb * 64, DM, scr, c.lane);
            continue; }
        r -= I_WIN;
        if (r < I_MKV) { const int kb = r >> 3, nb = r & 7; tr_item64(a.w_mem_kv + (size_t)kb * 64 * 512 + nb * 64, 512, WMKV + (size_t)(nb * 64) * DM + kb * 64, DM, scr, c.lane); continue; }
        r -= I_MKV;
        if (r < I_OUT) { const int kb = r >> 4, nb = r & 15; tr_item64(a.w_out + (size_t)(256 + kb * 64) * DM + nb * 64, DM, WOUT + (size_t)(nb * 64) * DM + 256 + kb * 64, DM, scr, c.lane); continue; }
        r -= I_OUT;
        { const int kb = r >> 2, nb = r & 3; tr_item64(a.w_router + (size_t)kb * 64 * NE + nb * 64, NE, WR + (size_t)(nb * 64) * DM + kb * 64, DM, scr, c.lane); }
    }
    __syncthreads();
    for (int idx = c.tid; idx < 8192; idx += 512) { const int h = idx & 7, k = idx >> 3; WfT[h * 1024 + k] = a.w_in[(size_t)k * INC + 1792 + h]; }
    for (int idx = (c.vcu * 512 + c.tid); idx < 256 * 1024; idx += c.G * 512) { const int k = idx >> 10, n = idx & 1023, g = k >> 6, cc = k & 63; float s = 0.f;
        for (int d = 0; d < 64; ++d) s += a.w_pool[g * 4096 + cc * 64 + d] * a.pool_scale[g * 64 + d] * a.w_out[(size_t)(g * 64 + d) * DM + n];
        WOUT[(size_t)n * DM + k] = (bf16_t)f2bf(s); }
    __syncthreads();
    bf16_t* XB = (bf16_t*)(ws + WS_XB); float* FLOG = (float*)(ws + WS_FLOG);
    for (int m = gw; m < T; m += NGW) {
        const f32x4* xr = (const f32x4*)(a.x + (size_t)m * DM) + c.lane; f32x4 v[4];
#pragma unroll
        for (int j = 0; j < 4; ++j) v[j] = xr[64 * j];
        u32x2* o8 = (u32x2*)(XB + (size_t)m * DM) + c.lane;
#pragma unroll
        for (int j = 0; j < 4; ++j) o8[64 * j] = (u32x2){pk2(v[j].x, v[j].y), pk2(v[j].z, v[j].w)};
        float acc[8];
#pragma unroll
        for (int h = 0; h < 8; ++h) { float s = 0.f;
#pragma unroll
            for (int j = 0; j < 4; ++j) { const f32x4 w = *(const LAS f32x4*)(WfT + h * 1024 + 4 * c.lane + 256 * j); s += (v[j].x * w.x + v[j].y * w.y) + (v[j].z * w.z + v[j].w * w.w); }
            acc[h] = s; }
        float b4[4], b2[2], z;
        { const bool up = (c.lane & 32) != 0;
#pragma unroll
          for (int i = 0; i < 4; ++i) { const float keep = up ? acc[4 + i] : acc[i], give = up ? acc[i] : acc[4 + i]; b4[i] = keep + __shfl_xor(give, 32); } }
        { const bool up = (c.lane & 16) != 0;
#pragma unroll
          for (int i = 0; i < 2; ++i) { const float keep = up ? b4[2 + i] : b4[i], give = up ? b4[i] : b4[2 + i]; b2[i] = keep + __shfl_xor(give, 16); } }
        { const bool up = (c.lane & 8) != 0; const float keep = up ? b2[1] : b2[0], give = up ? b2[0] : b2[1]; z = keep + __shfl_xor(give, 8); }
        z += __shfl_xor(z, 4); z += __shfl_xor(z, 2); z += __shfl_xor(z, 1);
        if ((c.lane & 7) == 0) { const int h = ((c.lane >> 5) & 1) * 4 + ((c.lane >> 4) & 1) * 2 + ((c.lane >> 3) & 1); z += a.b_f[h];
            const float lf = (z >= 0.f) ? -log1pf(expf(-z)) : (z - log1pf(expf(z))); FLOG[(size_t)m * 8 + h] = lf; }
    }
    bf16_t* MEMB = (bf16_t*)(ws + WS_MEMB);
    for (int m = gw; m < NB * 256; m += NGW) {
        const f32x4* xr = (const f32x4*)(a.mem + (size_t)m * DM) + c.lane; u32x2* o8 = (u32x2*)(MEMB + (size_t)m * DM) + c.lane;
#pragma unroll
        for (int j = 0; j < 4; ++j) { const f32x4 v = xr[64 * j]; o8[64 * j] = (u32x2){pk2(v.x, v.y), pk2(v.z, v.w)}; }
    }
}

__device__ __forceinline__ void p1_fscan(const Args& a, const Ctx& c) {
    if (c.vcu >= 64) return;
    const float* FLOG = (const float*)(a.ws + WS_FLOG); float* FC = (float*)(a.ws + WS_FC);
    LAS float* wtot = (LAS float*)c.lds;
    const int bh = c.vcu, b = bh >> 3, h = bh & 7; float p[8]; float run = 0.f;
#pragma unroll
    for (int i = 0; i < 8; ++i) { run += FLOG[((size_t)b * SEQ + c.tid * 8 + i) * 8 + h]; p[i] = run; }
    float inc = run;
#pragma unroll
    for (int o = 1; o < 64; o <<= 1) { const float t = __shfl_up(inc, o); if (c.lane >= o) inc += t; }
    if (c.lane == 63) wtot[c.wave] = inc;
    __syncthreads();
    float base = inc - run;
    for (int w = 0; w < c.wave; ++w) base += wtot[w];
#pragma unroll
    for (int i = 0; i < 8; ++i) FC[(size_t)bh * SEQ + c.tid * 8 + i] = (base + p[i]) * LOG2E;
    __syncthreads();
}

__device__ __forceinline__ void p2_mixers(const Args& a, const Ctx& c) {
    unsigned char* ws = a.ws;
    const bf16_t* Q = (const bf16_t*)(ws + WS_Q); const bf16_t* Kb = (const bf16_t*)(ws + WS_K); const bf16_t* V = (const bf16_t*)(ws + WS_V); const bf16_t* QM = (const bf16_t*)(ws + WS_QM);
    const bf16_t* U = (const bf16_t*)(ws + WS_U); const bf16_t* KVM = (const bf16_t*)(ws + WS_KVM); bf16_t* YMIX = (bf16_t*)(ws + WS_YMIX); const float* FC = (const float*)(ws + WS_FC);
    { const int cp = c.tid & 127, rg = c.tid >> 7, ch = 2 * cp, wsel = ch >> 6;
      const int t0 = c.vcu * 128 + rg * 32, seq0 = t0 & ~(SEQ - 1);
      unsigned raw[47];
#pragma unroll
      for (int k = 0; k < 47; ++k) { const int row = t0 - 15 + k; raw[k] = (row >= seq0) ? *(const unsigned*)(U + (size_t)row * 256 + ch) : 0u; }
      float p0[48], p1[48]; p0[0] = 0.f; p1[0] = 0.f;
#pragma unroll
      for (int k = 0; k < 47; ++k) { p0[k + 1] = p0[k] + bflo(raw[k]); p1[k + 1] = p1[k] + bfhi(raw[k]); }
#pragma unroll
      for (int i = 0; i < 32; ++i) { const int t = t0 + i, k = i + 16; const int pos = t & (SEQ - 1), w = 2 << wsel, cnt = (pos + 1 < w) ? pos + 1 : w;
          const float l0 = (wsel == 0) ? p0[k - 2] : (wsel == 1) ? p0[k - 4] : (wsel == 2) ? p0[k - 8] : p0[k - 16];
          const float l1 = (wsel == 0) ? p1[k - 2] : (wsel == 1) ? p1[k - 4] : (wsel == 2) ? p1[k - 8] : p1[k - 16];
          const float inv = 1.0f / (float)cnt;
          *(unsigned*)(YMIX + (size_t)t * DM + ch) = pk2((p0[k] - l0) * inv - bflo(raw[k - 1]), (p1[k] - l1) * inv - bfhi(raw[k - 1])); } }
    __syncthreads();
    ConvBg bg; bg.w_gate = a.w_gate; bg.w_up = a.w_up; bg.w_down = a.w_down; bg.ws_gate = a.ws_gate; bg.ws_up = a.ws_up; bg.ws_down = a.ws_down;
    bg.WGU = (bf16_t*)(ws + WS_WGU); bg.WD = (bf16_t*)(ws + WS_WD); bg.scr = (LAS float*)(c.lds + BG_OFF + c.wave * 8448); bg.lane = c.lane;
    bg.it = c.vcu * 8 + c.wave; bg.end = ConvBg::NIT; bg.stride = c.G * 8; bg.it0 = bg.it; bg.nl = 0; bg.pend = false; bg.dst = nullptr; bg.ldt = 0;
#pragma unroll
    for (int i = 0; i < 8; ++i) bg.v[i] = (f32x4){0.f, 0.f, 0.f, 0.f};
    { const float* nrm = (const float*)(ws + WS_CTL) + CW_NRM; unsigned* qctr = (unsigned*)(ws + WS_CTL) + CW_Q; volatile LAS int* qslot = (volatile LAS int*)(c.lds + MISC_OFF + 64);
      for (;;) {
          __syncthreads();
          if (c.tid == 0) qslot[0] = (int)__hip_atomic_fetch_add(qctr, 1u, __ATOMIC_RELAXED, __HIP_MEMORY_SCOPE_AGENT);
          __syncthreads();
          const int uq = qslot[0]; if (uq >= 1024) break;
          const int qb = 15 - (uq >> 6), bh = uq & 63, b = bh >> 3, h = bh & 7;
          att::Job j; const size_t row0 = (size_t)b * SEQ;
          { const float q2 = nrm[bh * 4 + 0] + nrm[bh * 4 + 1], k2 = nrm[bh * 4 + 2] + nrm[bh * 4 + 3]; j.qk2 = 2.02f * sqrtf(q2 * k2); }
          j.Q = Q + (row0 + qb * 256) * 512 + h * 64; j.qpitch = 512; j.K = Kb + row0 * 512 + h * 64; j.V = V + row0 * 512 + h * 64; j.kvpitch = 512;
          j.O = YMIX + (row0 + qb * 256) * DM + 256 + h * 64; j.nt = 4 * qb + 4; j.causal = 1; j.FC = FC + (size_t)bh * SEQ; j.q0 = qb * 256;
          att::unit<true>(j, c.lds, bg); } }
    for (int i = 0; i < 2; ++i) { const int mu = c.vcu * 2 + i, b = mu >> 6, hm = (mu >> 4) & 3, qb = mu & 15;
        att::Job j; const size_t row0 = (size_t)b * SEQ + qb * 256;
        j.Q = QM + row0 * 256 + hm * 64; j.qpitch = 256; j.K = KVM + (size_t)b * 256 * 512 + hm * 64; j.V = KVM + (size_t)b * 256 * 512 + 256 + hm * 64; j.kvpitch = 512;
        j.O = YMIX + row0 * DM + 768 + hm * 64; j.nt = 4; j.causal = 0; j.FC = nullptr; j.q0 = 0; j.qk2 = 0.f;
        att::unit<false>(j, c.lds, bg); }
    while (bg.busy()) { bg.finish(); bg.issue(); }
}

__device__ __forceinline__ void p4_ln1(const Args& a, const Ctx& c) {
    bf16_t* X1B = (bf16_t*)(a.ws + WS_X1B);
    f32x4 g4[4], b4[4];
#pragma unroll
    for (int j = 0; j < 4; ++j) { g4[j] = *((const f32x4*)a.ln1_g + c.lane + 64 * j); b4[j] = *((const f32x4*)a.ln1_b + c.lane + 64 * j); }
    for (int m = c.vcu * 128 + c.wave; m < c.vcu * 128 + 128; m += 8) {
        const u32x2* xr = (const u32x2*)(a.out + (size_t)m * DM) + c.lane; f32x4 v[4]; float s = 0.f;
#pragma unroll
        for (int j = 0; j < 4; ++j) { const u32x2 hw = xr[64 * j]; v[j] = (f32x4){bflo(hw.x), bfhi(hw.x), bflo(hw.y), bfhi(hw.y)}; s += (v[j].x + v[j].y) + (v[j].z + v[j].w); }
        const float mean = wave_sum(s) * (1.f / DM); float s2 = 0.f;
#pragma unroll
        for (int j = 0; j < 4; ++j) { v[j] = v[j] - mean; s2 += (v[j].x * v[j].x + v[j].y * v[j].y) + (v[j].z * v[j].z + v[j].w * v[j].w); }
        const float rstd = 1.f / sqrtf(wave_sum(s2) * (1.f / DM) + LN_EPS);
        u32x2* o8 = (u32x2*)(X1B + (size_t)m * DM) + c.lane;
#pragma unroll
        for (int j = 0; j < 4; ++j) { const f32x4 y = v[j] * rstd * g4[j] + b4[j]; o8[64 * j] = (u32x2){pk2(y.x, y.y), pk2(y.z, y.w)}; }
    }
}

__device__ __forceinline__ float wave_max_f(float v) {
    int x = __float_as_int(v);  v = fmaxf(v, __int_as_float(__builtin_amdgcn_update_dpp(x, x, 0x121, 0xf, 0xf, false)));
    x = __float_as_int(v);      v = fmaxf(v, __int_as_float(__builtin_amdgcn_update_dpp(x, x, 0x122, 0xf, 0xf, false)));
    x = __float_as_int(v);      v = fmaxf(v, __int_as_float(__builtin_amdgcn_update_dpp(x, x, 0x124, 0xf, 0xf, false)));
    x = __float_as_int(v);      v = fmaxf(v, __int_as_float(__builtin_amdgcn_update_dpp(x, x, 0x128, 0xf, 0xf, false)));
    x = __float_as_int(v);
    const float a = __int_as_float(__builtin_amdgcn_readlane(x, 0)), b = __int_as_float(__builtin_amdgcn_readlane(x, 16)), c = __int_as_float(__builtin_amdgcn_readlane(x, 32)), d = __int_as_float(__builtin_amdgcn_readlane(x, 48));
    return fmaxf(fmaxf(a, b), fmaxf(c, d));
}
#define CSWAP(va, ia, sa, vb, ib, sb) do { const bool sw_ = (vb > va) || (vb == va && ib < ia); const float tv_ = sw_ ? vb : va, tw_ = sw_ ? va : vb; const int ti_ = sw_ ? ib : ia, tj_ = sw_ ? ia : ib; \
    const float ts_ = sw_ ? sb : sa, tt_ = sw_ ? sa : sb; va = tv_; vb = tw_; ia = ti_; ib = tj_; sa = ts_; sb = tt_; } while (0)
__device__ __forceinline__ void p6_route(const Args& a, const Ctx& c) {
    const float* LOG = (const float*)(a.ws + WS_LOG); int* cnt = (int*)(a.ws + WS_CTL); int* bins = (int*)(a.ws + WS_BINS); float* gates = (float*)(a.ws + WS_GATES);
    LAS int* hist = (LAS int*)c.lds; LAS int* base = hist + 256; LAS unsigned short* asg_e = (LAS unsigned short*)(base + 256); LAS unsigned short* asg_r = asg_e + 1024;
    const int lane = c.lane;
    const f32x4 bs = *((const f32x4*)a.router_bias + lane);
    for (int chunk = c.vcu; chunk < T / 128; chunk += c.G) {
        __syncthreads();
        if (c.tid < 256) hist[c.tid] = 0;
        __syncthreads();
        for (int i = 0; i < 16; ++i) {
            const int lt = c.wave * 16 + i, tok = chunk * 128 + lt;
            const f32x4 lg = *((const f32x4*)(LOG + (size_t)tok * NE) + lane);
            float s0 = 1.f / (1.f + expf(-lg.x)), s1 = 1.f / (1.f + expf(-lg.y)), s2 = 1.f / (1.f + expf(-lg.z)), s3 = 1.f / (1.f + expf(-lg.w));
            float v0 = s0 + bs.x, v1 = s1 + bs.y, v2 = s2 + bs.z, v3 = s3 + bs.w;
            int i0 = 4 * lane, i1 = i0 + 1, i2 = i0 + 2, i3 = i0 + 3;
            CSWAP(v0, i0, s0, v1, i1, s1); CSWAP(v2, i2, s2, v3, i3, s3); CSWAP(v0, i0, s0, v2, i2, s2); CSWAP(v1, i1, s1, v3, i3, s3); CSWAP(v1, i1, s1, v2, i2, s2);
            float m1 = v0, m2 = v1;
#pragma unroll
            for (int o = 1; o < 8; o <<= 1) { const float o1 = __shfl_xor(m1, o), o2 = __shfl_xor(m2, o); const float n1 = fmaxf(m1, o1), n2 = fmaxf(fminf(m1, o1), fmaxf(m2, o2)); m1 = n1; m2 = n2; }
            const float gs = m1 + m2; const int g = lane >> 3; int rank = 0; const int gsx = __float_as_int(gs);
#pragma unroll
            for (int jg = 0; jg < 8; ++jg) { const float gj = __int_as_float(__builtin_amdgcn_readlane(gsx, 8 * jg)); rank += (gj > gs || (gj == gs && jg < g)) ? 1 : 0; }
            if (rank >= 4) { v0 = -INFINITY; v1 = -INFINITY; v2 = -INFINITY; v3 = -INFINITY; }
            int my_e = 0; float my_s = 0.f;
#pragma unroll
            for (int k = 0; k < TOPK; ++k) {
                const float m = wave_max_f(v0);
                const unsigned long long mk = __ballot(v0 == m);
                const int wl = (int)__builtin_ctzll(mk);
                const int ek = __builtin_amdgcn_readlane(i0, wl); const float sk = __int_as_float(__builtin_amdgcn_readlane(__float_as_int(s0), wl));
                if (lane == wl) { v0 = v1; i0 = i1; s0 = s1; v1 = v2; i1 = i2; s1 = s2; v2 = v3; i2 = i3; s2 = s3; v3 = -INFINITY; }
                if (lane == k) { my_e = ek; my_s = sk; }
            }
            float tot = (lane < 8) ? my_s : 0.f;
            tot += __shfl_xor(tot, 1); tot += __shfl_xor(tot, 2); tot += __shfl_xor(tot, 4);
            if (lane < 8) { const int lr = __hip_atomic_fetch_add(&hist[my_e], 1, __ATOMIC_RELAXED, __HIP_MEMORY_SCOPE_WORKGROUP); asg_e[lt * 8 + lane] = (unsigned short)my_e; asg_r[lt * 8 + lane] = (unsigned short)lr; gates[(size_t)tok * 8 + lane] = my_s / tot * 2.5f; }
        }
        __syncthreads();
        if (c.tid < 256) { const int n = hist[c.tid]; base[c.tid] = n ? atomicAdd(&cnt[c.tid * 64], n) : 0; }
        __syncthreads();
        for (int sl = c.tid; sl < 1024; sl += 512) { const int e = asg_e[sl]; bins[(size_t)e * T + base[e] + asg_r[sl]] = chunk * 1024 + sl; }
    }
    __syncthreads();
}
#undef CSWAP

__device__ __forceinline__ int build_tables(const Args& a, const Ctx& c) {
    const int* cnt = (const int*)(a.ws + WS_CTL);
    LAS unsigned short* te = (LAS unsigned short*)(c.lds + TE_OFF); LAS int* tb = (LAS int*)(c.lds + TB_OFF); LAS int* cn = (LAS int*)(c.lds + CN_OFF);
    __syncthreads();
    if (c.tid < NE) cn[c.tid] = __hip_atomic_load(cnt + c.tid * 64, __ATOMIC_RELAXED, __HIP_MEMORY_SCOPE_AGENT);
    __syncthreads();
    if (c.tid == 0) { int run = 0; for (int e = 0; e < NE; ++e) { tb[e] = run; run += (cn[e] + 255) >> 8; } tb[NE] = run; }
    __syncthreads();
    if (c.tid < NE) { const int n = (cn[c.tid] + 255) >> 8, b0 = tb[c.tid]; for (int jt = 0; jt < n; ++jt) te[b0 + jt] = (unsigned short)c.tid; }
    __syncthreads();
    LAS unsigned short* ord = (LAS unsigned short*)(c.lds + OR_OFF); LAS int* fb = (LAS int*)c.lds;
    const int NTR = tb[NE];
    if (c.tid < NE) { const int n = (cn[c.tid] + 255) >> 8; const int lastrows = cn[c.tid] - (n - 1) * 256; fb[c.tid] = (n > 0 && lastrows <= 128) ? n - 1 : n; }
    __syncthreads();
    if (c.tid == 0) { int run = 0, hrun = 0; for (int e = 0; e < NE; ++e) { const int nf = fb[e]; const int n = (cn[e] + 255) >> 8; fb[256 + e] = run; run += nf; fb[512 + e] = hrun; hrun += n - nf; } fb[768] = run; }
    __syncthreads();
    { const int NF = fb[768];
      if (c.tid < NE) { const int n = (cn[c.tid] + 255) >> 8, nf = fb[c.tid], b0 = tb[c.tid]; for (int jt = 0; jt < nf; ++jt) ord[fb[256 + c.tid] + jt] = (unsigned short)(b0 + jt);
          if (n > nf) ord[NF + 128 + fb[512 + c.tid]] = (unsigned short)(b0 + n - 1); }
      if (c.tid < 128) ord[NF + c.tid] = (unsigned short)(NTR + c.tid); }
    __syncthreads();
    return NTR;
}

__device__ __forceinline__ void p9_combine(const Args& a, const Ctx& c) {
    const bf16_t* X1B = (const bf16_t*)(a.ws + WS_X1B); const bf16_t* Y = (const bf16_t*)(a.ws + WS_Y); const int gw = c.vcu * 8 + c.wave, NGW = c.G * 8;
    const int* ridx = (const int*)(a.ws + WS_ROWIDX); const float* gts = (const float*)(a.ws + WS_GATES);
    f32x4 g4[4], b4[4];
#pragma unroll
    for (int j = 0; j < 4; ++j) { g4[j] = *((const f32x4*)a.ln2_g + c.lane + 64 * j); b4[j] = *((const f32x4*)a.ln2_b + c.lane + 64 * j); }
    for (int m = gw; m < T; m += NGW) {
        f32x4* orow = (f32x4*)(a.out + (size_t)m * DM) + c.lane; f32x4 v[4]; float s = 0.f;
        const u32x2* x8 = (const u32x2*)(X1B + (size_t)m * DM) + c.lane;
        const u32x2* s8 = (const u32x2*)(a.out + (size_t)m * DM) + c.lane;
#pragma unroll
        for (int j = 0; j < 4; ++j) { const u32x2 xw = x8[64 * j], sw = s8[64 * j]; v[j] = (f32x4){bflo(sw.x), bfhi(sw.x), bflo(sw.y), bfhi(sw.y)} + (f32x4){bflo(xw.x), bfhi(xw.x), bflo(xw.y), bfhi(xw.y)} * ALPHA; }
        f32x4 ys[4];
#pragma unroll
        for (int j = 0; j < 4; ++j) ys[j] = (f32x4){0.f, 0.f, 0.f, 0.f};
        const int ypos = (((4 * c.lane) >> 5) & 3) * 64 + (((4 * c.lane) >> 3) & 3) * 16 + (((4 * c.lane) >> 7) & 1) * 8 + ((4 * c.lane) & 7);
        const int my_r = ridx[(size_t)m * TOPK + (c.lane & 7)]; const float my_g = gts[(size_t)m * TOPK + (c.lane & 7)];
#pragma unroll
        for (int k = 0; k < TOPK; ++k) { const int rr = __builtin_amdgcn_readlane(my_r, k); const float gk = __int_as_float(__builtin_amdgcn_readlane(__float_as_int(my_g), k));
            const unsigned char* yrow = (const unsigned char*)Y + (size_t)rr * DM + ypos;
#pragma unroll
            for (int j = 0; j < 4; ++j) { const int yw = *(const int*)(yrow + 256 * j); const f32x2 lo = __builtin_amdgcn_cvt_pk_f32_fp8(yw, false), hi2 = __builtin_amdgcn_cvt_pk_f32_fp8(yw, true); ys[j] += (f32x4){lo.x, lo.y, hi2.x, hi2.y} * gk; } }
#pragma unroll
        for (int j = 0; j < 4; ++j) v[j] += ys[j] * YINV;
#pragma unroll
        for (int j = 0; j < 4; ++j) s += (v[j].x + v[j].y) + (v[j].z + v[j].w);
        const float mean = wave_sum(s) * (1.f / DM); float s2 = 0.f;
#pragma unroll
        for (int j = 0; j < 4; ++j) { v[j] = v[j] - mean; s2 += (v[j].x * v[j].x + v[j].y * v[j].y) + (v[j].z * v[j].z + v[j].w * v[j].w); }
        const float rstd = 1.f / sqrtf(wave_sum(s2) * (1.f / DM) + LN_EPS);
#pragma unroll
        for (int j = 0; j < 4; ++j) orow[64 * j] = v[j] * rstd * g4[j] + b4[j];
    }
}

constexpr int NPHASE = 10;

__global__ void __launch_bounds__(512, 2) mk_fwd(Args a) {
    extern __shared__ __attribute__((aligned(16))) unsigned char lds_raw[];
    cg::grid_group grid = cg::this_grid();
    Ctx c; c.lds = (LAS unsigned char*)lds_raw; c.tid = threadIdx.x; c.lane = c.tid & 63; c.wave = __builtin_amdgcn_readfirstlane(c.tid >> 6); c.G = gridDim.x;
    { const int bx = blockIdx.x; c.vcu = (c.G % 8 == 0) ? (bx % 8) * (c.G / 8) + bx / 8 : bx; }
    unsigned char* ws = a.ws; const int lo = a.ph_lo, hi = a.ph_hi;
#define IN(k) (lo <= (k) && (k) < hi)
    for (int u = c.tid; u < 32; u += 512) ((volatile LAS unsigned*)(c.lds + MISC_OFF))[u] = 0u;
    __syncthreads();
    XcdBarrier bar = xcd_barrier_post((unsigned*)(ws + WS_CTL) + CW_BAR + a.li * XCD_BAR_WORDS, (volatile LAS unsigned*)(c.lds + MISC_OFF) + 8);
    if (a.ph_lo < 0) grid.sync();
    unsigned long long pt_acc = 0ull;
#define PT_ON(id) (PROBE_T == (id))
#define SEAM(k) do { if (IN(k) && IN((k) + 1)) { if (PT_ON(10 + (k)) || PT_ON(30)) { const unsigned long long t0_ = __builtin_amdgcn_s_memrealtime(); xcd_barrier(bar); pt_acc += __builtin_amdgcn_s_memrealtime() - t0_; } else xcd_barrier(bar); } } while (0)
#define PH_BEGIN(k) unsigned long long pt0_##k = 0ull; if (PT_ON(k)) pt0_##k = __builtin_amdgcn_s_memrealtime();
#define PH_END(k) if (PT_ON(k)) { asm volatile("s_waitcnt vmcnt(0)" ::: "memory"); __syncthreads(); pt_acc += __builtin_amdgcn_s_memrealtime() - pt0_##k; }
    { PH_BEGIN(0) if (IN(0)) p0_prologue(a, c); PH_END(0) }
    SEAM(0);
    { PH_BEGIN(1) if (IN(1)) {
        p1_fscan(a, c);
        { pg8::DenseSched S; S.init(T, 2048, DM, c.G, (int)blockIdx.x, ws + WS_WIN);
          pg8::EpiInProj E{(bf16_t*)(ws + WS_Q), (bf16_t*)(ws + WS_K), (bf16_t*)(ws + WS_V), (bf16_t*)(ws + WS_U), (bf16_t*)(ws + WS_QM), (unsigned*)(ws + WS_CTL) + CW_NRM};
          pg8::gemm_phase(c.lds, (const char*)(ws + WS_XB), DM, S, E); }
        { pg8::DenseSched S; S.init_half(NB * 256, 512, DM, c.G, c.vcu, ws + WS_WMKV);
          pg8::EpiBf16 E{(bf16_t*)(ws + WS_KVM), 512};
          pg8::gemm_phase(c.lds, (const char*)(ws + WS_MEMB), DM, S, E); }
    } PH_END(1) }
    SEAM(1);
    { PH_BEGIN(2) if (IN(2)) p2_mixers(a, c); PH_END(2) }
    SEAM(2);
    { PH_BEGIN(3) if (IN(3)) { pg8::DenseSched S; S.init(T, DM, DM, c.G, (int)blockIdx.x, ws + WS_WOUT);
        pg8::EpiRes16 E{(bf16_t*)a.out, a.x, ALPHA};
        pg8::gemm_phase<PT_ON(23)>(c.lds, (const char*)(ws + WS_YMIX), DM, S, E, &pt_acc); } PH_END(3) }
    SEAM(3);
    { PH_BEGIN(4) if (IN(4)) { p4_ln1(a, c); asm volatile("s_waitcnt vmcnt(0)" ::: "memory"); __syncthreads(); } PH_END(4) }
    { PH_BEGIN(5) if (IN(5)) { pg8::DenseSched S; S.init_half(T, NE, DM, c.G, c.vcu, ws + WS_WR);
        pg8::EpiF32 E{(float*)(ws + WS_LOG), NE, nullptr, 0.f};
        pg8::gemm_phase(c.lds, (const char*)(ws + WS_X1B), DM, S, E); asm volatile("s_waitcnt vmcnt(0)" ::: "memory"); __syncthreads(); } PH_END(5) }
    { PH_BEGIN(6) if (IN(6)) p6_route(a, c); PH_END(6) }
    SEAM(6);
    { PH_BEGIN(7) if (IN(7)) { const int NTR = build_tables(a, c);
        pg8::GroupSched S; S.nunits = (NTR + 128) * 2; S.G = c.G; S.c = c.vcu; S.shift = 1; S.NTR = NTR; S.mode = 0; S.K = DM;
        S.tile_e = (const LAS unsigned short*)(c.lds + TE_OFF); S.tbase = (const LAS int*)(c.lds + TB_OFF); S.cnt = (const LAS int*)(c.lds + CN_OFF);
        S.bins = (const int*)(ws + WS_BINS); S.Bt = (const char*)(ws + WS_WGU); S.estride = (size_t)512 * DM * 2; S.rowidx = (int*)(ws + WS_ROWIDX); S.order = (const LAS unsigned short*)(c.lds + OR_OFF);
        pg8::EpiGateUp E{(bf16_t*)(ws + WS_HB)};
        pg8::gemm_phase<PT_ON(27)>(c.lds, (const char*)(ws + WS_X1B), DM, S, E, &pt_acc); } PH_END(7) }
    SEAM(7);
    { PH_BEGIN(8) if (IN(8)) { const int NTR = build_tables(a, c);
        pg8::GroupSched S; S.nunits = (NTR + 128) * 4; S.G = c.G; S.c = c.vcu; S.shift = 2; S.NTR = NTR; S.mode = 1; S.K = EH;
        S.tile_e = (const LAS unsigned short*)(c.lds + TE_OFF); S.tbase = (const LAS int*)(c.lds + TB_OFF); S.cnt = (const LAS int*)(c.lds + CN_OFF);
        S.bins = (const int*)(ws + WS_BINS); S.Bt = (const char*)(ws + WS_WD); S.estride = (size_t)DM * EH * 2; S.rowidx = nullptr; S.order = (const LAS unsigned short*)(c.lds + OR_OFF);
        pg8::EpiDown E{(bf16_t*)(ws + WS_Y), a.out, (const int*)(ws + WS_BINS), (const float*)(ws + WS_GATES)};
        pg8::gemm_phase<PT_ON(28)>(c.lds, (const char*)(ws + WS_HB), EH, S, E, &pt_acc); } PH_END(8) }
    SEAM(8);
    { PH_BEGIN(9) if (IN(9)) p9_combine(a, c); PH_END(9) }
    if (PROBE_T >= 0) {
        unsigned* pw = (unsigned*)(ws + WS_CTL) + CW_PROBE;
        if (c.tid == 0) { if (PROBE_MODE == 0) atomicMax(pw, (unsigned)pt_acc); else atomicAdd(pw, (unsigned)pt_acc); }
        xcd_barrier(bar);
        if (blockIdx.x == 0 && c.tid == 0) { unsigned v = __hip_atomic_load(pw, __ATOMIC_RELAXED, __HIP_MEMORY_SCOPE_AGENT); if (PROBE_MODE == 1) v /= (unsigned)c.G;
            const unsigned long long t0 = __builtin_amdgcn_s_memrealtime(); while (__builtin_amdgcn_s_memrealtime() - t0 < (unsigned long long)v * PROBE_MULT) __builtin_amdgcn_s_sleep(8); }
    }
#undef IN
#undef SEAM
}

#ifndef MK_N_LAUNCHES
#define MK_N_LAUNCHES 1
#endif
extern "C" void kernel_launch(void* const* d_in, const int* in_sizes, int n_in, void* d_out, int out_size, void* d_ws, size_t ws_size, hipStream_t stream) {
    static int grid = 0;
    if (grid == 0) {
        if (n_in != 20 || out_size != T * DM || ws_size < WS_END) { fprintf(stderr, "kernel_launch: unexpected shapes (n_in %d out %d ws %zu)\n", n_in, out_size, ws_size); grid = -1; return; }
        int dev = 0, cus = 0, per_cu = 0;
        (void)hipGetDevice(&dev); (void)hipDeviceGetAttribute(&cus, hipDeviceAttributeMultiprocessorCount, dev);
        if (hipFuncSetAttribute((const void*)mk_fwd, hipFuncAttributeMaxDynamicSharedMemorySize, LDS_BYTES) != hipSuccess) { fprintf(stderr, "kernel_launch: hipFuncSetAttribute failed\n"); grid = -1; return; }
        (void)hipOccupancyMaxActiveBlocksPerMultiprocessor(&per_cu, (const void*)mk_fwd, 512, LDS_BYTES);
        if (per_cu < 1) { fprintf(stderr, "kernel_launch: occupancy query says %d blocks per CU\n", per_cu); grid = -1; return; }
        grid = cus;
        if (grid != 256) fprintf(stderr, "kernel_launch: %d CUs (built for 256)\n", grid);
    }
    if (grid < 0) return;
    (void)hipMemsetAsync((char*)d_ws + WS_CTL, 0, CTL_ZERO_BYTES, stream);
    Args a{};
    const float** p = (const float**)&a;
    for (int i = 0; i < 20; ++i) p[i] = (const float*)d_in[i];
    a.out = (float*)d_out; a.ws = (unsigned char*)d_ws;
    const int nl = MK_N_LAUNCHES;
    for (int li = 0; li < nl; ++li) {
        a.ph_lo = (nl == 1) ? 0 : li; a.ph_hi = (nl == 1) ? NPHASE : li + 1; a.li = li;
        void* args[] = {&a};
        const hipError_t e = hipLaunchCooperativeKernel((void*)mk_fwd, dim3(grid), dim3(512), args, LDS_BYTES, stream);
        if (e != hipSuccess) { fprintf(stderr, "kernel_launch: cooperative launch failed: %s\n", hipGetErrorString(e)); break; }
    }
}
```

```cpp
#include <hip/hip_runtime.h>
#include <hip/hip_cooperative_groups.h>
#include <cstdio>
#include <cstdint>
namespace cg = cooperative_groups;
#ifndef PROBE_T
#define PROBE_T -1
#endif
#ifndef PROBE_MODE
#define PROBE_MODE 0
#endif
#define PROBE_MULT 4
constexpr int CW_PROBE = 20000;
#define PT_BEGIN(id) unsigned long long ptb_##id = 0ull; if (PROBE_T == (id)) ptb_##id = __builtin_amdgcn_s_memrealtime();
#define PT_END(id, tacc) if (PROBE_T == (id)) { asm volatile("s_waitcnt vmcnt(0)" ::: "memory"); __syncthreads(); *(tacc) += __builtin_amdgcn_s_memrealtime() - ptb_##id; }

#define LAS __attribute__((address_space(3)))
typedef unsigned short bf16_t;
typedef short bf16x8 __attribute__((ext_vector_type(8)));
typedef short s16x4 __attribute__((ext_vector_type(4)));
typedef float f32x4 __attribute__((ext_vector_type(4)));
typedef float f32x2 __attribute__((ext_vector_type(2)));
typedef float f32x16 __attribute__((ext_vector_type(16)));
typedef unsigned u32x4 __attribute__((ext_vector_type(4)));
typedef unsigned u32x2 __attribute__((ext_vector_type(2)));
typedef int i32x4v __attribute__((ext_vector_type(4)));
typedef int i32x8 __attribute__((ext_vector_type(8)));

constexpr int NB = 8, SEQ = 4096, T = NB * SEQ, DM = 1024;
constexpr int INC = 2056;
constexpr int NE = 256, TOPK = 8, EH = 256;
constexpr float ALPHA = 1.189207115002721f;
constexpr float LN_EPS = 1e-5f;
constexpr float LOG2E = 1.4426950408889634f;
constexpr float C2 = 0.125f * LOG2E;
constexpr int MAXTILES = 1280 + 128;
constexpr float YSCALE = 32.f, YINV = 1.f / 32.f;

constexpr size_t MiB = 1u << 20;
constexpr size_t WS_CTL = 0, WS_WD = 1 * MiB, WS_HB = 130 * MiB, WS_X1B = 306 * MiB, WS_BINS = 370 * MiB, WS_GATES = 402 * MiB, WS_FC = 403 * MiB, WS_FLOG = 404 * MiB,
                 WS_KVM = 405 * MiB, WS_Y = 408 * MiB, WS_WGU = 408 * MiB, WS_WIN = 665 * MiB, WS_WMKV = 669 * MiB, WS_WOUT = 670 * MiB, WS_WR = 672 * MiB, WS_MEMB = 673 * MiB,
                 WS_XB = 677 * MiB, WS_Q = 741 * MiB, WS_K = 773 * MiB, WS_V = 805 * MiB, WS_QM = 837 * MiB, WS_U = 853 * MiB, WS_YMIX = 869 * MiB, WS_LOG = 933 * MiB, WS_END = 965 * MiB,
                 WS_X1F8 = WS_Q;
constexpr size_t CTL_ZERO_BYTES = 1 * MiB;
constexpr size_t WS_ROWIDX = WS_FLOG;
constexpr int CW_Q = 16400 + 256;
constexpr int CW_NRM = 16384;

constexpr int RING_BYTES = 131072;
constexpr int TE_OFF = 131072, TB_OFF = 135168, CN_OFF = 137216, OR_OFF = 138240  , BG_OFF = 83968  , MISC_OFF = 155648, LDS_BYTES = 156672;

struct Args {
    const float *x, *mem, *w_in, *b_f, *w_pool, *pool_scale, *w_mem_kv, *w_out, *ln1_g, *ln1_b, *w_router, *router_bias, *w_gate, *w_up, *w_down, *ws_gate, *ws_up, *ws_down, *ln2_g, *ln2_b;
    float* out; unsigned char* ws; int ph_lo, ph_hi, li, pad;
};

__device__ __forceinline__ unsigned f2bf(float f) { unsigned u = __float_as_uint(f); return (u + 0x7fffu + ((u >> 16) & 1u)) >> 16; }
__device__ __forceinline__ unsigned pk2(float lo, float hi) { return f2bf(lo) | (f2bf(hi) << 16); }
__device__ __forceinline__ float bflo(unsigned w) { return __uint_as_float(w << 16); }
__device__ __forceinline__ float bfhi(unsigned w) { return __uint_as_float(w & 0xffff0000u); }
__device__ __forceinline__ float wave_sum(float v) {
#pragma unroll
    for (int o = 1; o < 64; o <<= 1) v += __shfl_xor(v, o);
    return v;
}
#define LDS_WAIT() asm volatile("s_waitcnt lgkmcnt(0)" ::: "memory")

namespace pg8 {
constexpr int BM = 256, BK = 64, HALF = 128, HTB = HALF * BK * 2, NXCD = 8, WGM = 8;
__device__ __forceinline__ int lds_byte(int r, int c) { const int st = (r >> 4) * 2 + (c >> 5), rr = r & 15, cc = c & 31, ob = rr * 64 + cc * 2; return st * 1024 + (ob ^ (((ob >> 9) & 1) << 5)); }
__device__ __forceinline__ void stage_rc(int b, int& R, int& C) { const int st = b / 1024, sb = b % 1024, swz = sb ^ (((sb >> 9) & 1) << 5); R = (st >> 1) * 16 + swz / 64; C = (st & 1) * 32 + (swz % 64) / 2; }
__device__ __forceinline__ int perm32(int rho) { const int n = rho >> 4, i = rho & 15; return 8 * (i >> 2) + 4 * n + (i & 3); }
__device__ __forceinline__ int xcd_remap(int L, int nwg) { const int q = nwg / NXCD, r = nwg % NXCD, xcd = L % NXCD, off = L / NXCD; return (xcd < r ? xcd * (q + 1) : r * (q + 1) + (xcd - r) * q) + off; }

struct Unit { int pm, pn, e, rows, mt, rb; };

struct DenseSched {
    int nM, nN, nwg, G, c, K, half; const char* Bt;
    __device__ __forceinline__ void init(int M, int N, int K_, int G_, int c_, const void* Bt_) { nM = M / BM; nN = N / BM; nwg = nM * nN; G = G_; c = c_; K = K_; Bt = (const char*)Bt_; half = 0; }
    __device__ __forceinline__ void init_half(int M, int N, int K_, int G_, int c_, const void* Bt_) { nM = M / HALF; nN = N / BM; nwg = nM * nN; G = G_; c = c_; K = K_; Bt = (const char*)Bt_; half = 1; }
    __device__ __forceinline__ bool next(int i, Unit& u) const {
        const long L = (long)i * G + c; if (L >= nwg) return false;
        if (half) { const int q = (int)L / nN; u.pm = q >> 1; u.pn = (int)L % nN; u.e = 0; u.rows = HALF; u.mt = q; u.rb = q * HALF; return true; }
        const int wgid = xcd_remap((int)L, nwg);
        const int nig = WGM * nN, gid = wgid / nig, fm = gid * WGM, gsz = (nM - fm) < WGM ? (nM - fm) : WGM;
        u.pm = fm + ((wgid % nig) % gsz); u.pn = (wgid % nig) / gsz; u.e = 0; u.rows = 256; u.mt = u.pm; u.rb = u.pm * BM; return true;
    }
    __device__ __forceinline__ unsigned a_off(const Unit& u, int h, int R, int C) const { return (unsigned)(((u.rb + h * HALF + R) * K + C) * 2); }
    __device__ __forceinline__ const char* b_ptr(const Unit& u) const { return Bt + (size_t)u.pn * BM * K * 2; }
};

template <int MODE> struct GroupSched {
    static constexpr int mode = MODE;
    int nunits, G, c, shift, NTR, K; const LAS unsigned short* tile_e; const LAS int* tbase; const LAS int* cnt; const int* bins; const char* Bt; size_t estride; int* rowidx; const LAS unsigned short* order; const LAS unsigned short* tokidx;
    __device__ __forceinline__ bool next(int i, Unit& u) const {
        const long L = (long)i * G + c; if (L >= nunits) return false;
        const int wgid = (int)L;
        const int tau = order[wgid >> shift]; u.pn = wgid & ((1 << shift) - 1); u.pm = tau; u.rb = i;
        if (tau < NTR) { const int e = tile_e[tau]; u.e = e; u.mt = tau - tbase[e]; const int left = cnt[e] - u.mt * 256; u.rows = left < 256 ? left : 256; }
        else { u.e = NE; u.mt = tau - NTR; u.rows = 256; }
        return true;
    }
    __device__ __forceinline__ unsigned a_off(const Unit& u, int h, int R, int C) const {
        if constexpr (MODE == 0) { const int rl = h * HALF + R; const int tok = tokidx[u.rb * 256 + rl];
            return (unsigned)((tok * K + C) * 2); }
        else return (unsigned)(((u.pm * BM + h * HALF + R) * K + C) * 2);
    }
    __device__ __forceinline__ const char* b_ptr(const Unit& u) const { return Bt + (size_t)u.e * estride + (size_t)u.pn * BM * K * 2; }
};

__device__ __forceinline__ unsigned cvt_pk_bf16(float lo, float hi) { unsigned r; asm volatile("v_cvt_pk_bf16_f32 %0, %1, %2" : "=v"(r) : "v"(lo), "v"(hi)); return r; }

template <bool TIME = false, int F8S = 0  , class Epi, class Sched>
__device__ __forceinline__ void gemm_phase(LAS unsigned char* lds, const char* Abase, int K, const Sched& S, const Epi& E, unsigned long long* tacc = nullptr) {
    const int tid = threadIdx.x, wid = __builtin_amdgcn_readfirstlane(tid >> 6), lane = tid & 63, wr = wid >> 2, wc = wid & 3, fr = lane & 15, fq = lane >> 4;
    constexpr bool F8 = F8S != 0;
    int nt = K / BK; if constexpr (F8) asm volatile("" : "+s"(nt));
    int RA[2], CA[2]; unsigned voffB[2];
#pragma unroll
    for (int i = 0; i < 2; ++i) { int R, C; stage_rc(tid * 16 + i * 8192, R, C); const int Rb = Epi::PERM ? ((R & ~31) + perm32(R & 31)) : R; RA[i] = R; CA[i] = C; voffB[i] = (unsigned)(Rb * K + C) * 2u; }
    const size_t kstep = (size_t)(BK * 2);
    const size_t hstep = (size_t)HALF * K * 2;
    const unsigned ldsw = (unsigned)wid * 1024u;
    const int aoff = lds_byte(wr * 64 + fr, fq * 8), boff = lds_byte(wc * 32 + fr, fq * 8);
#define PG8_SA(b, h) (((b) * 2 + (h)) * HTB)
#define PG8_SB(b, h) ((4 + (b) * 2 + (h)) * HTB)
#define PG8_STAGEB(bufoff, gbase) do { _Pragma("unroll") for (int _i = 0; _i < 2; ++_i) \
        __builtin_amdgcn_global_load_lds((const unsigned*)((const char*)(gbase) + voffB[_i]), (LAS unsigned*)(lds + (bufoff) + ldsw + _i * 8192), 16, 0, 0); } while (0)
#define PG8_STAGEA(bufoff, koff, v0, v1) do { \
        __builtin_amdgcn_global_load_lds((const unsigned*)(Abase + (koff) + (v0)), (LAS unsigned*)(lds + (bufoff) + ldsw), 16, 0, 0); \
        __builtin_amdgcn_global_load_lds((const unsigned*)(Abase + (koff) + (v1)), (LAS unsigned*)(lds + (bufoff) + ldsw + 8192), 16, 0, 0); } while (0)
#define PG8_LDA(dst, b, h) do { _Pragma("unroll") for (int m = 0; m < 4; ++m) _Pragma("unroll") for (int k = 0; k < 2; ++k) dst[m][k] = *(const LAS bf16x8*)(lds + PG8_SA(b, h) + aoff + m * 2048 + k * 1024); } while (0)
#define PG8_LDB(dst, b, h) do { _Pragma("unroll") for (int n = 0; n < 2; ++n) _Pragma("unroll") for (int k = 0; k < 2; ++k) dst[n][k] = *(const LAS bf16x8*)(lds + PG8_SB(b, h) + boff + n * 2048 + k * 1024); } while (0)
#define PG8_LDA8(dst, b, h) do { _Pragma("unroll") for (int m = 0; m < 4; ++m) { const i32x4v lo_ = *(const LAS i32x4v*)(lds + PG8_SA(b, h) + aoff + m * 2048), hi_ = *(const LAS i32x4v*)(lds + PG8_SA(b, h) + aoff + m * 2048 + 1024); \
        dst[m] = __builtin_shufflevector(lo_, hi_, 0, 1, 2, 3, 4, 5, 6, 7); } } while (0)
#define PG8_LDB8(dst, b, h) do { _Pragma("unroll") for (int n = 0; n < 2; ++n) { const i32x4v lo_ = *(const LAS i32x4v*)(lds + PG8_SB(b, h) + boff + n * 2048), hi_ = *(const LAS i32x4v*)(lds + PG8_SB(b, h) + boff + n * 2048 + 1024); \
        dst[n] = __builtin_shufflevector(lo_, hi_, 0, 1, 2, 3, 4, 5, 6, 7); } } while (0)
#define PG8_LDAX(b, h) do { if constexpr (F8) PG8_LDA8(At8, b, h); else PG8_LDA(At, b, h); } while (0)
#define PG8_LDBX(w, b, h) do { if constexpr (F8) { if (w == 0) PG8_LDB8(B08, b, h); else PG8_LDB8(B18, b, h); } else { if (w == 0) PG8_LDB(B0, b, h); else PG8_LDB(B1, b, h); } } while (0)
#define PG8_MMAX(ai, bj, w) do { __builtin_amdgcn_s_setprio(1); _Pragma("unroll") for (int m = 0; m < 4; ++m) _Pragma("unroll") for (int n = 0; n < 2; ++n) { \
        if constexpr (F8) acc[ai][bj][m][n] = __builtin_amdgcn_mfma_scale_f32_16x16x128_f8f6f4((w == 0) ? B08[n] : B18[n], At8[m], acc[ai][bj][m][n], 0, 0, 0, 0x7a7a7a7a, 0, F8S * 0x01010101); \
        else { _Pragma("unroll") for (int k = 0; k < 2; ++k) acc[ai][bj][m][n] = __builtin_amdgcn_mfma_f32_16x16x32_bf16((w == 0) ? B0[n][k] : B1[n][k], At[m][k], acc[ai][bj][m][n], 0, 0, 0); } } \
        if constexpr (F8) asm volatile("" : "+v"(acc[ai][bj][0][0]), "+v"(acc[ai][bj][0][1]), "+v"(acc[ai][bj][1][0]), "+v"(acc[ai][bj][1][1]), "+v"(acc[ai][bj][2][0]), "+v"(acc[ai][bj][2][1]), "+v"(acc[ai][bj][3][0]), "+v"(acc[ai][bj][3][1])); \
        __builtin_amdgcn_s_setprio(0); } while (0)
#define PG8_WAIT_V(n) asm volatile("s_waitcnt vmcnt(" #n ")" ::: "memory")
#define PG8_WAIT_L(n) asm volatile("s_waitcnt lgkmcnt(" #n ")" ::: "memory")
#define PG8_BAR __builtin_amdgcn_s_barrier()
#define PG8_SCHED __builtin_amdgcn_sched_barrier(0)
    Unit cur, nxt; int ui = 0;
    if (!S.next(0, cur)) return;
    unsigned vc00 = S.a_off(cur, 0, RA[0], CA[0]), vc01 = S.a_off(cur, 0, RA[1], CA[1]), vc10 = S.a_off(cur, 1, RA[0], CA[0]), vc11 = S.a_off(cur, 1, RA[1], CA[1]);
    asm volatile("" : "+v"(vc00), "+v"(vc01), "+v"(vc10), "+v"(vc11));
    f32x4 acc[2][2][4][2];
#pragma unroll
    for (int a = 0; a < 2; ++a)
#pragma unroll
        for (int b = 0; b < 2; ++b)
#pragma unroll
            for (int m = 0; m < 4; ++m)
#pragma unroll
                for (int n = 0; n < 2; ++n) acc[a][b][m][n] = (f32x4){0.f, 0.f, 0.f, 0.f};
    bf16x8 At[4][2], B0[2][2], B1[2][2]; i32x8 At8[4], B08[2], B18[2];
    const char* cB = S.b_ptr(cur);
    PG8_STAGEB(PG8_SB(0, 0), cB); PG8_STAGEB(PG8_SB(0, 1), cB + hstep); PG8_STAGEA(PG8_SA(0, 0), 0, vc00, vc01); PG8_STAGEA(PG8_SA(0, 1), 0, vc10, vc11);
    if (wr == 1) PG8_BAR;
    PG8_WAIT_V(2); PG8_BAR;
    PG8_STAGEB(PG8_SB(1, 0), cB + kstep); PG8_STAGEA(PG8_SA(1, 0), kstep, vc00, vc01); PG8_STAGEB(PG8_SB(1, 1), cB + hstep + kstep);
    PG8_WAIT_V(6); PG8_BAR;
    for (;;) {
        const bool has_next = S.next(ui + 1, nxt);
        unsigned vn00 = vc00, vn01 = vc01, vn10 = vc10, vn11 = vc11;
        if (has_next) { vn00 = S.a_off(nxt, 0, RA[0], CA[0]); vn01 = S.a_off(nxt, 0, RA[1], CA[1]); vn10 = S.a_off(nxt, 1, RA[0], CA[0]); vn11 = S.a_off(nxt, 1, RA[1], CA[1]); }
        asm volatile("" : "+v"(vn00), "+v"(vn01), "+v"(vn10), "+v"(vn11));
        const char* nB = has_next ? S.b_ptr(nxt) : cB;
        const bool full = cur.rows > HALF;
        for (int t = 0; t < nt; t += 2) {
            const bool last = (t == nt - 2);
            const size_t k1 = (size_t)(t + 1) * kstep;
            const size_t k2 = last ? 0 : (size_t)(t + 2) * kstep, k3 = k2 + kstep;
            const char* b2 = last ? nB : cB + (size_t)(t + 2) * kstep; const char* b3 = b2 + kstep;
            const unsigned s00 = last ? vn00 : vc00, s01 = last ? vn01 : vc01, s10 = last ? vn10 : vc10, s11 = last ? vn11 : vc11;
            PG8_LDBX(0, 0, 0); PG8_LDBX(1, 0, 1); PG8_SCHED; PG8_LDAX(0, 0); PG8_STAGEA(PG8_SA(1, 1), k1, vc10, vc11);
            PG8_WAIT_V(8); PG8_WAIT_L(0); PG8_BAR; PG8_MMAX(0, 0, 0); PG8_MMAX(0, 1, 1); PG8_BAR; PG8_SCHED;
            PG8_LDAX(0, 1); PG8_STAGEB(PG8_SB(0, 0), b2); PG8_STAGEB(PG8_SB(0, 1), b2 + hstep); PG8_STAGEA(PG8_SA(0, 0), k2, s00, s01);
            PG8_WAIT_V(8); PG8_WAIT_L(0); PG8_BAR; if (full) { PG8_MMAX(1, 0, 0); PG8_MMAX(1, 1, 1); } PG8_BAR; PG8_SCHED;
            PG8_LDBX(0, 1, 0); PG8_LDBX(1, 1, 1); PG8_SCHED; PG8_LDAX(1, 0); PG8_STAGEA(PG8_SA(0, 1), k2, s10, s11);
            PG8_WAIT_V(8); PG8_WAIT_L(0); PG8_BAR; PG8_MMAX(0, 0, 0); PG8_MMAX(0, 1, 1); PG8_BAR; PG8_SCHED;
            PG8_LDAX(1, 1); PG8_STAGEB(PG8_SB(1, 0), b3); PG8_STAGEB(PG8_SB(1, 1), b3 + hstep); PG8_STAGEA(PG8_SA(1, 0), k3, s00, s01);
            PG8_WAIT_V(8); PG8_WAIT_L(0); PG8_BAR; if (full) { PG8_MMAX(1, 0, 0); PG8_MMAX(1, 1, 1); } PG8_BAR; PG8_SCHED;
        }
        if (wr == 0) PG8_BAR;
        if constexpr (TIME) { const unsigned long long t0_ = __builtin_amdgcn_s_memrealtime(); E(acc, cur, wr, wc, fr, fq); asm volatile("s_waitcnt vmcnt(0)" ::: "memory"); *tacc += __builtin_amdgcn_s_memrealtime() - t0_; }
        else { int fr_ = fr, fq_ = fq; asm volatile("" : "+v"(fr_), "+v"(fq_)); E(acc, cur, wr, wc, fr_, fq_); }
        if (!has_next) break;
#pragma unroll
        for (int a = 0; a < 2; ++a)
#pragma unroll
            for (int b = 0; b < 2; ++b)
#pragma unroll
                for (int m = 0; m < 4; ++m)
#pragma unroll
                    for (int n = 0; n < 2; ++n) acc[a][b][m][n] = (f32x4){0.f, 0.f, 0.f, 0.f};
        cur = nxt; cB = nB; vc00 = vn00; vc01 = vn01; vc10 = vn10; vc11 = vn11; ++ui;
        if (wr == 1) PG8_BAR;
    }
    PG8_WAIT_V(0);
    PG8_BAR;
#undef PG8_SA
#undef PG8_SB
#undef PG8_STAGEA
#undef PG8_STAGEB
#undef PG8_LDA
#undef PG8_LDB
#undef PG8_MMAX
#undef PG8_LDAX
#undef PG8_LDBX
#undef PG8_LDA8
#undef PG8_LDB8
#undef PG8_WAIT_V
#undef PG8_WAIT_L
#undef PG8_BAR
#undef PG8_SCHED
}

struct EpiInProj {
    static constexpr bool PERM = true;
    bf16_t *Q, *Kb, *V, *U, *QM; unsigned* nrm;
    __device__ __forceinline__ void operator()(const f32x4 (&acc)[2][2][4][2], const Unit& u, int wr, int wc, int fr, int fq) const {
        bf16_t* base; int ldc, colt; float sc = 1.f; const int pn = u.pn;
        float nmax[2] = {0.f, 0.f};
        if (pn < 2) { base = Q; ldc = 512; colt = pn * 256; sc = C2; } else if (pn < 4) { base = Kb; ldc = 512; colt = (pn - 2) * 256; } else if (pn < 6) { base = V; ldc = 512; colt = (pn - 4) * 256; }
        else if (pn == 6) { base = U; ldc = 256; colt = 0; } else { base = QM; ldc = 256; colt = 0; sc = C2; }
        const int row0 = u.pm * BM + wr * 64 + fr, col0 = colt + wc * 32 + 8 * fq;
#pragma unroll
        for (int ai = 0; ai < 2; ++ai)
#pragma unroll
            for (int m = 0; m < 4; ++m) { bf16_t* rowp = base + (size_t)(row0 + ai * HALF + m * 16) * ldc + col0;
#pragma unroll
                for (int bj = 0; bj < 2; ++bj) { const f32x4 v0 = acc[ai][bj][m][0] * sc, v1 = acc[ai][bj][m][1] * sc;
                    u32x4 w; w.x = cvt_pk_bf16(v0[0], v0[1]); w.y = cvt_pk_bf16(v0[2], v0[3]); w.z = cvt_pk_bf16(v1[0], v1[1]); w.w = cvt_pk_bf16(v1[2], v1[3]);
                    *(u32x4*)(rowp + bj * HALF) = w;
                    if (pn < 4) { float q = (v0[0] * v0[0] + v0[1] * v0[1]) + (v0[2] * v0[2] + v0[3] * v0[3]) + (v1[0] * v1[0] + v1[1] * v1[1]) + (v1[2] * v1[2] + v1[3] * v1[3]);
                        q += __shfl_xor(q, 16); q += __shfl_xor(q, 32); nmax[bj] = fmaxf(nmax[bj], q); } } }
        if (pn < 4) {
#pragma unroll
            for (int bj = 0; bj < 2; ++bj) { float q = nmax[bj];
#pragma unroll
                for (int o = 1; o < 16; o <<= 1) q = fmaxf(q, __shfl_xor(q, o));
                if (fr == 0 && fq == 0) { const int b = (u.pm * BM) / SEQ, h = (pn & 1) * 4 + 2 * bj + (wc >> 1), kind = pn >> 1;
                    atomicMax(nrm + ((b * 8 + h) * 2 + kind) * 2 + (wc & 1), __float_as_uint(q)); } }
        }
    }
};
struct EpiBf16 {
    static constexpr bool PERM = true;
    bf16_t* O; int ldc;
    __device__ __forceinline__ void operator()(const f32x4 (&acc)[2][2][4][2], const Unit& u, int wr, int wc, int fr, int fq) const {
        const int row0 = u.rb + wr * 64 + fr, col0 = u.pn * BM + wc * 32 + 8 * fq;
#pragma unroll
        for (int ai = 0; ai < 2; ++ai)
#pragma unroll
            for (int m = 0; m < 4; ++m) { if (ai * HALF >= u.rows) continue; bf16_t* rowp = O + (size_t)(row0 + ai * HALF + m * 16) * ldc + col0;
#pragma unroll
                for (int bj = 0; bj < 2; ++bj) { const f32x4 v0 = acc[ai][bj][m][0], v1 = acc[ai][bj][m][1];
                    u32x4 w; w.x = cvt_pk_bf16(v0[0], v0[1]); w.y = cvt_pk_bf16(v0[2], v0[3]); w.z = cvt_pk_bf16(v1[0], v1[1]); w.w = cvt_pk_bf16(v1[2], v1[3]);
                    *(u32x4*)(rowp + bj * HALF) = w; } }
    }
};
struct EpiRes16 {
    static constexpr bool PERM = true;
    bf16_t* O; const float* R; float rs;
    __device__ __forceinline__ void operator()(const f32x4 (&acc)[2][2][4][2], const Unit& u, int wr, int wc, int fr, int fq) const {
        const int row0 = u.pm * BM + wr * 64 + fr, col0 = u.pn * BM + wc * 32 + 8 * fq;
#pragma unroll
        for (int ai = 0; ai < 2; ++ai) {
            f32x4 pre[4][2][2];
#pragma unroll
            for (int m = 0; m < 4; ++m)
#pragma unroll
                for (int bj = 0; bj < 2; ++bj) { const float* rp = R + (size_t)(row0 + ai * HALF + m * 16) * DM + col0 + bj * HALF; pre[m][bj][0] = *(const f32x4*)rp; pre[m][bj][1] = *(const f32x4*)(rp + 4); }
#pragma unroll
            for (int m = 0; m < 4; ++m) { const size_t row = (size_t)(row0 + ai * HALF + m * 16);
#pragma unroll
                for (int bj = 0; bj < 2; ++bj) { const f32x4 v0 = acc[ai][bj][m][0] + pre[m][bj][0] * rs, v1 = acc[ai][bj][m][1] + pre[m][bj][1] * rs;
                    u32x4 w; w.x = cvt_pk_bf16(v0[0], v0[1]); w.y = cvt_pk_bf16(v0[2], v0[3]); w.z = cvt_pk_bf16(v1[0], v1[1]); w.w = cvt_pk_bf16(v1[2], v1[3]);
                    *(u32x4*)(O + row * (2 * DM) + col0 + bj * HALF) = w; } }
            asm volatile("" ::: "memory"); }
    }
};
struct EpiF32 {
    static constexpr bool PERM = false;
    float* C; int ldc; const float* R; float rs;
    __device__ __forceinline__ void operator()(const f32x4 (&acc)[2][2][4][2], const Unit& u, int wr, int wc, int fr, int fq) const {
        const int row0 = u.rb + wr * 64 + fr, col0 = u.pn * BM + wc * 32 + 4 * fq;
#pragma unroll
        for (int ai = 0; ai < 2; ++ai)
#pragma unroll
            for (int m = 0; m < 4; ++m) { if (ai * HALF >= u.rows) continue; const size_t off = (size_t)(row0 + ai * HALF + m * 16) * ldc + col0;
#pragma unroll
                for (int bj = 0; bj < 2; ++bj)
#pragma unroll
                    for (int n = 0; n < 2; ++n) { f32x4 v = acc[ai][bj][m][n]; if (R) v += *(const f32x4*)(R + off + bj * HALF + n * 16) * rs; *(f32x4*)(C + off + bj * HALF + n * 16) = v; }
                if (m & 1) asm volatile("" ::: "memory"); }
    }
};
struct EpiGateUp {
    static constexpr bool PERM = true;
    unsigned char* H;
    __device__ __forceinline__ void operator()(const f32x4 (&acc)[2][2][4][2], const Unit& u, int wr, int wc, int fr, int fq) const {
        const int odd = fq & 1, row0 = u.pm * BM + wr * 64 + fr + odd * 16, col0 = u.pn * 128 + wc * 32 + 8 * (fq - odd);
#pragma unroll
        for (int ai = 0; ai < 2; ++ai)
#pragma unroll
            for (int mp = 0; mp < 4; mp += 2) { unsigned wv[2][2];
#pragma unroll
                for (int mm = 0; mm < 2; ++mm) { const int m = mp + mm; float hv[8];
#pragma unroll
                    for (int n = 0; n < 2; ++n)
#pragma unroll
                        for (int j = 0; j < 4; ++j) { const float g = acc[ai][0][m][n][j], up = acc[ai][1][m][n][j]; hv[n * 4 + j] = __builtin_amdgcn_fmed3f(g * __builtin_amdgcn_rcpf(1.f + __builtin_amdgcn_exp2f(-g * LOG2E)) * up * 8.f, -440.f, 440.f); }
                    int w0 = 0, w1 = 0;
                    w0 = __builtin_amdgcn_cvt_pk_fp8_f32(hv[0], hv[1], w0, false); w0 = __builtin_amdgcn_cvt_pk_fp8_f32(hv[2], hv[3], w0, true);
                    w1 = __builtin_amdgcn_cvt_pk_fp8_f32(hv[4], hv[5], w1, false); w1 = __builtin_amdgcn_cvt_pk_fp8_f32(hv[6], hv[7], w1, true);
                    wv[mm][0] = (unsigned)w0; wv[mm][1] = (unsigned)w1; }
                const auto r0 = __builtin_amdgcn_permlane16_swap(wv[0][0], wv[1][0], false, false), r1 = __builtin_amdgcn_permlane16_swap(wv[0][1], wv[1][1], false, false);
                *(u32x4*)(H + (size_t)(row0 + ai * HALF + mp * 16) * EH + col0) = (u32x4){r0[0], r1[0], r0[1], r1[1]}; }
    }
};
struct EpiDown {
    static constexpr bool PERM = true;
    bf16_t* Y; float* SH; const int* bins; const float* gates;
    __device__ __forceinline__ void operator()(const f32x4 (&acc)[2][2][4][2], const Unit& u, int wr, int wc, int fr, int fq_) const {
        int fq = fq_; asm volatile("" : "+v"(fq));
        const int col0 = u.pn * BM + wc * 32 + 8 * fq;
        if (u.e == NE) {
#pragma unroll
            for (int ai = 0; ai < 2; ++ai)
#pragma unroll
                for (int m = 0; m < 4; ++m) { const int tok = u.mt * 256 + ai * HALF + wr * 64 + m * 16 + fr; bf16_t* rowp = (bf16_t*)(SH + (size_t)tok * DM) + col0;
#pragma unroll
                    for (int bj = 0; bj < 2; ++bj) { const f32x4 v0 = acc[ai][bj][m][0], v1 = acc[ai][bj][m][1];
                        u32x4 w; w.x = cvt_pk_bf16(v0[0], v0[1]); w.y = cvt_pk_bf16(v0[2], v0[3]); w.z = cvt_pk_bf16(v1[0], v1[1]); w.w = cvt_pk_bf16(v1[2], v1[3]);
                        *(u32x4*)(rowp + bj * HALF) = w; } }
        } else {
#pragma unroll
            for (int ai = 0; ai < 2; ++ai)
#pragma unroll
                for (int m = 0; m < 4; ++m) { const int rl = ai * HALF + wr * 64 + m * 16 + fr; if (rl >= u.rows) continue;
                    unsigned char* rowp = (unsigned char*)Y + (size_t)(u.pm * 256 + rl) * DM + u.pn * BM + wc * 64 + fq * 16;
                    unsigned w[4];
#pragma unroll
                    for (int bj = 0; bj < 2; ++bj) { f32x4 v0 = acc[ai][bj][m][0] * YSCALE, v1 = acc[ai][bj][m][1] * YSCALE;
#pragma unroll
                        for (int q = 0; q < 4; ++q) { v0[q] = __builtin_amdgcn_fmed3f(v0[q], -440.f, 440.f); v1[q] = __builtin_amdgcn_fmed3f(v1[q], -440.f, 440.f); }
                        int w0 = 0, w1 = 0; w0 = __builtin_amdgcn_cvt_pk_fp8_f32(v0[0], v0[1], w0, false); w0 = __builtin_amdgcn_cvt_pk_fp8_f32(v0[2], v0[3], w0, true);
                        w1 = __builtin_amdgcn_cvt_pk_fp8_f32(v1[0], v1[1], w1, false); w1 = __builtin_amdgcn_cvt_pk_fp8_f32(v1[2], v1[3], w1, true);
                        w[2 * bj] = (unsigned)w0; w[2 * bj + 1] = (unsigned)w1; }
                    *(u32x4*)rowp = (u32x4){w[0], w[1], w[2], w[3]}; }
        }
    }
};
}


__device__ __forceinline__ unsigned cvtpk_bg(float lo, float hi) { unsigned r; asm volatile("v_cvt_pk_bf16_f32 %0, %1, %2" : "=v"(r) : "v"(lo), "v"(hi)); return r; }
struct ConvBg {
    const float *w_gate, *w_up, *w_down, *ws_gate, *ws_up, *ws_down; bf16_t *WGU, *WD;
    LAS float* scr; int lane, it, it0, end, stride, nl; bool pend; f32x4 v[8]; bf16_t* dst; int ldt;
    static constexpr int NIT = (NE + 1) * 384;
    __device__ __forceinline__ void decode(int r, const float*& src, int& ldw) {
        const int e = r / 384; r -= e * 384;
        if (r < 256) { const int up = r >> 7; r &= 127; const int kb = ((r >> 4) << 1) | ((r >> 2) & 1), nb = (((r >> 3) & 1) << 2) | (r & 3), n0 = nb * 32;
            src = ((e < NE) ? ((up ? w_up : w_gate) + (size_t)e * DM * EH) : (up ? ws_up : ws_gate)) + (size_t)kb * 64 * EH + n0; ldw = EH;
            const int drow = (n0 >> 7) * 256 + up * 128 + (n0 & 127); dst = WGU + ((size_t)e * 512 + drow) * (DM / 2) + kb * 32; ldt = DM / 2;
        } else { r -= 256; const int kb = ((r >> 6) << 1) | ((r >> 2) & 1), nb = (((r >> 3) & 7) << 2) | (r & 3);
            src = ((e < NE) ? (w_down + (size_t)e * EH * DM) : ws_down) + (size_t)kb * 64 * DM + nb * 32; ldw = DM;
            dst = WD + ((size_t)e * DM + nb * 32) * (EH / 2) + kb * 32; ldt = EH / 2; }
    }
    __device__ __forceinline__ void finish() {
        if (!pend) return;
        const int kq = lane >> 3, n4 = (lane & 7) * 4;
#pragma unroll
        for (int i = 0; i < 8; ++i) { LAS float* p = scr + (8 * i + kq) * 33 + n4; p[0] = v[i].x; p[1] = v[i].y; p[2] = v[i].z; p[3] = v[i].w; }
        LDS_WAIT(); asm volatile("" ::: "memory");
        const int c8 = lane & 7;
#pragma unroll
        for (int j = 0; j < 4; ++j) { const int n = (lane >> 3) + 8 * j; const LAS float* s = scr + (8 * c8) * 33 + n;
            { int w0 = 0, w1 = 0;
                w0 = __builtin_amdgcn_cvt_pk_fp8_f32(s[0 * 33] * 32.f, s[1 * 33] * 32.f, w0, false); w0 = __builtin_amdgcn_cvt_pk_fp8_f32(s[2 * 33] * 32.f, s[3 * 33] * 32.f, w0, true);
                w1 = __builtin_amdgcn_cvt_pk_fp8_f32(s[4 * 33] * 32.f, s[5 * 33] * 32.f, w1, false); w1 = __builtin_amdgcn_cvt_pk_fp8_f32(s[6 * 33] * 32.f, s[7 * 33] * 32.f, w1, true);
                __builtin_nontemporal_store((u32x2){(unsigned)w0, (unsigned)w1}, (u32x2*)(dst + (size_t)n * ldt + 4 * c8)); } }
        LDS_WAIT(); asm volatile("" ::: "memory");
        pend = false;
    }
    __device__ __forceinline__ void issue() {
        const bool valid = it < end; const float* src; int ldw; decode(valid ? it : it0, src, ldw);
        if (!valid) ldw = 0;
        const int kq = lane >> 3, n4 = (lane & 7) * 4;
#pragma unroll
        for (int i = 0; i < 8; ++i) v[i] = __builtin_nontemporal_load((const f32x4*)(src + (size_t)(8 * i + kq) * ldw + n4));
        pend = valid; if (valid) it += stride; nl = 8;
    }
    __device__ __forceinline__ bool busy() const { return pend || it < end; }
};
struct NoBg { int nl; __device__ __forceinline__ void finish() {} __device__ __forceinline__ void issue() { nl = 0; } };

namespace att {
constexpr int SLOTB = 8192, L_K = 0, L_V = 2 * SLOTB, L_WS = 4 * SLOTB, L_OST = L_WS + 8 * 256, L_FK = L_OST + 8 * 4096, L_END = L_FK + 16384;
#define SBAR() __builtin_amdgcn_sched_barrier(0)
__device__ __forceinline__ int crow(int r, int hi) { return (r & 3) + 8 * (r >> 2) + 4 * hi; }
__device__ __forceinline__ void glds16(const void* gsrc, unsigned lds_dst) { unsigned keep;
    asm volatile("s_mov_b32 %0, m0\n\ts_mov_b32 m0, %2\n\ts_nop 0\n\tglobal_load_lds_dwordx4 %1, off\n\ts_mov_b32 m0, %0" : "=&s"(keep) : "v"(gsrc), "s"(lds_dst) : "memory"); }
__device__ __forceinline__ unsigned cvtpk(float lo, float hi) { unsigned r; asm("v_cvt_pk_bf16_f32 %0, %1, %2" : "=v"(r) : "v"(lo), "v"(hi)); return r; }
#define ATT_WAIT_BAR() asm volatile("s_waitcnt vmcnt(0) lgkmcnt(0)\n\ts_barrier" ::: "memory")

struct Job { const bf16_t* Q; int qpitch; const bf16_t* K; const bf16_t* V; int kvpitch; bf16_t* O; int nt; int causal; const float* FC; int q0; float qk2; };
constexpr float SKIP_LOG2 = 36.f;

template <bool FOX, class Bg> __device__ __forceinline__ void unit(const Job& j, LAS unsigned char* shm, Bg& bg) {
    const int tid = threadIdx.x, lane = tid & 63, r32 = lane & 31, hi = lane >> 5; const int wid = __builtin_amdgcn_readfirstlane(tid >> 6);
    const unsigned lds0 = (unsigned)(uintptr_t)shm;
    LAS float* wsf = (LAS float*)(shm + L_WS) + wid * 64;
    LAS float* fk = (LAS float*)(shm + L_FK);
    const int NT = j.nt;
    float fq = 0.f; int tlo = 0;
    if (FOX) {
        const float fq0 = j.FC[j.q0];
        const bool keep = (lane < NT) ? (j.qk2 + fq0 - j.FC[64 * lane + 63] >= -SKIP_LOG2) : false;
        const unsigned long long mk = __ballot(keep);
        tlo = (mk != 0ull) ? (int)__builtin_ctzll(mk) : NT - 1; tlo = __builtin_amdgcn_readfirstlane(tlo);
        for (int i = tlo * 16 + tid; i < NT * 16; i += 512) *(LAS f32x4*)(fk + 4 * i) = *(const f32x4*)(j.FC + 4 * i);
        fq = j.FC[j.q0 + wid * 32 + r32];
    }
    const int NTE = NT - tlo;
    const bf16_t* ksrc = j.K + (size_t)lane * j.kvpitch + wid * 8;
    const bf16_t* vsrc = j.V + (size_t)(16 * (wid & 3) + (lane >> 2)) * j.kvpitch + (wid >> 2) * 32 + (lane & 3) * 8;
    const unsigned kdst = lds0 + L_K + wid * 1024, vdst = lds0 + L_V + wid * 1024;
#define DMA_K(t, slot) glds16(ksrc + (size_t)(t) * 64 * j.kvpitch, (unsigned)__builtin_amdgcn_readfirstlane(kdst + (slot) * SLOTB))
#define DMA_V(t, slot) glds16(vsrc + (size_t)(t) * 64 * j.kvpitch, (unsigned)__builtin_amdgcn_readfirstlane(vdst + (slot) * SLOTB))
    const bf16_t* Qw = j.Q + (size_t)(wid * 32) * j.qpitch;
    bf16x8 qr[4];
#pragma unroll
    for (int d0 = 0; d0 < 4; ++d0) qr[d0] = *reinterpret_cast<const bf16x8*>(Qw + (size_t)r32 * j.qpitch + d0 * 16 + hi * 8);
    asm volatile("s_waitcnt vmcnt(0) lgkmcnt(0)" ::: "memory");
    bg.nl = 0;
    { const int t0 = FOX ? NT - 1 : 0; DMA_K(t0, 0); DMA_V(t0, 0); }
    float mrun = -1e30f, l_reg = 0.f; f32x16 o[2]; o[0] = f32x16{}; o[1] = f32x16{};
    const int qrel = wid * 32 + r32;
    for (int it = 0; it < NTE; ++it) {
        const int tcur = FOX ? NT - 1 - it : it, slot = it & 1;
        if (bg.nl == 8) asm volatile("s_waitcnt vmcnt(8) lgkmcnt(0)\n\ts_barrier" ::: "memory");
        else ATT_WAIT_BAR();
        bg.finish();
        if (it + 1 < NTE) { const int tn = FOX ? tcur - 1 : tcur + 1; DMA_K(tn, slot ^ 1); DMA_V(tn, slot ^ 1); }
        bg.issue();
        f32x16 p0, p1;
        if (FOX) {
#pragma unroll
            for (int g = 0; g < 4; ++g) { const f32x4 a = *(const LAS f32x4*)(fk + 64 * tcur + 8 * g + 4 * hi), b = *(const LAS f32x4*)(fk + 64 * tcur + 32 + 8 * g + 4 * hi);
#pragma unroll
                for (int i = 0; i < 4; ++i) { p0[4 * g + i] = fq - a[i]; p1[4 * g + i] = fq - b[i]; } }
        } else { p0 = f32x16{}; p1 = f32x16{}; }
        { const LAS unsigned char* kb = shm + L_K + slot * SLOTB + hi * 1024 + r32 * 16;
#pragma unroll
          for (int d0 = 0; d0 < 4; ++d0) { const bf16x8 b0 = *(const LAS bf16x8*)(kb + d0 * 2048), b1 = *(const LAS bf16x8*)(kb + d0 * 2048 + 512);
              p0 = __builtin_amdgcn_mfma_f32_32x32x16_bf16(b0, qr[d0], p0, 0, 0, 0); p1 = __builtin_amdgcn_mfma_f32_32x32x16_bf16(b1, qr[d0], p1, 0, 0, 0); } }
        if (j.causal && tcur >= NT - 4) { const int kb0 = 64 * (tcur - (NT - 4)) + 4 * hi;
#pragma unroll
            for (int r = 0; r < 16; ++r) { const int kv = kb0 + (r & 3) + 8 * (r >> 2); if (kv > qrel) p0[r] = -INFINITY; if (kv + 32 > qrel) p1[r] = -INFINITY; } }
        float rm = p0[0];
#pragma unroll
        for (int r = 1; r < 16; ++r) rm = fmaxf(rm, p0[r]);
#pragma unroll
        for (int r = 0; r < 16; ++r) rm = fmaxf(rm, p1[r]);
        rm = fmaxf(rm, __shfl_xor(rm, 32));
        const float mn = fmaxf(mrun, rm), alpha = __builtin_amdgcn_exp2f(mrun - mn); mrun = mn;
        float rs = 0.f;
#pragma unroll
        for (int r = 0; r < 16; ++r) { p0[r] = __builtin_amdgcn_exp2f(p0[r] - mn); p1[r] = __builtin_amdgcn_exp2f(p1[r] - mn); rs += p0[r] + p1[r]; }
        l_reg = l_reg * alpha + rs;
        if (hi == 0) wsf[r32] = alpha;
        LDS_WAIT();
#pragma unroll
        for (int r = 0; r < 16; ++r) { const float f = wsf[crow(r, hi)]; o[0][r] *= f; o[1][r] *= f; }
        u32x4 pw0, pw1, pw2, pw3;
        pw0 = (u32x4){cvtpk(p0[0], p0[1]), cvtpk(p0[2], p0[3]), cvtpk(p0[4], p0[5]), cvtpk(p0[6], p0[7])};
        pw1 = (u32x4){cvtpk(p0[8], p0[9]), cvtpk(p0[10], p0[11]), cvtpk(p0[12], p0[13]), cvtpk(p0[14], p0[15])};
        pw2 = (u32x4){cvtpk(p1[0], p1[1]), cvtpk(p1[2], p1[3]), cvtpk(p1[4], p1[5]), cvtpk(p1[6], p1[7])};
        pw3 = (u32x4){cvtpk(p1[8], p1[9]), cvtpk(p1[10], p1[11]), cvtpk(p1[12], p1[13]), cvtpk(p1[14], p1[15])};
        const bf16x8 pa0 = __builtin_bit_cast(bf16x8, pw0), pa1 = __builtin_bit_cast(bf16x8, pw1), pa2 = __builtin_bit_cast(bf16x8, pw2), pa3 = __builtin_bit_cast(bf16x8, pw3);
        const int vb = (int)(lds0 + L_V + slot * SLOTB) + ((lane >> 4) & 1) * 32 + (lane & 3) * 8 + (4 * hi + ((lane & 15) >> 2)) * 64;
#pragma unroll
        for (int d0 = 0; d0 < 2; ++d0) { s16x4 lo[4], hh[4];
#pragma unroll
            for (int ks = 0; ks < 4; ++ks) {
                asm volatile("ds_read_b64_tr_b16 %0,%1 offset:%c2" : "=&v"(lo[ks]) : "v"(vb), "i"(d0 * 4096 + ks * 1024) : "memory");
                asm volatile("ds_read_b64_tr_b16 %0,%1 offset:%c2" : "=&v"(hh[ks]) : "v"(vb), "i"(d0 * 4096 + ks * 1024 + 512) : "memory"); }
            asm volatile("s_waitcnt lgkmcnt(0)" ::: "memory"); SBAR();
#define PK(k) (bf16x8){lo[k][0], lo[k][1], lo[k][2], lo[k][3], hh[k][0], hh[k][1], hh[k][2], hh[k][3]}
            o[d0] = __builtin_amdgcn_mfma_f32_32x32x16_bf16(pa0, PK(0), o[d0], 0, 0, 0);
            o[d0] = __builtin_amdgcn_mfma_f32_32x32x16_bf16(pa1, PK(1), o[d0], 0, 0, 0);
            o[d0] = __builtin_amdgcn_mfma_f32_32x32x16_bf16(pa2, PK(2), o[d0], 0, 0, 0);
            o[d0] = __builtin_amdgcn_mfma_f32_32x32x16_bf16(pa3, PK(3), o[d0], 0, 0, 0);
#undef PK
        }
    }
    l_reg += __shfl_xor(l_reg, 32);
    if (hi == 0) wsf[32 + r32] = l_reg;
    LDS_WAIT();
    float rli[16];
#pragma unroll
    for (int r = 0; r < 16; ++r) rli[r] = 1.0f / wsf[32 + crow(r, hi)];
    bf16_t* Ow = j.O + (size_t)(wid * 32) * DM;
    { LAS bf16_t* stg = (LAS bf16_t*)(shm + L_OST) + wid * 2048;
#pragma unroll
      for (int r = 0; r < 16; ++r) { const int orow = crow(r, hi);
#pragma unroll
          for (int d0 = 0; d0 < 2; ++d0) stg[orow * 64 + d0 * 32 + r32] = (bf16_t)f2bf(o[d0][r] * rli[r]); }
      LDS_WAIT();
#pragma unroll
      for (int i = 0; i < 4; ++i) { const int row = i * 8 + (lane >> 3), ch = lane & 7; const u32x4 v = *(const LAS u32x4*)(stg + row * 64 + ch * 8); *(u32x4*)(Ow + (size_t)row * DM + ch * 8) = v; } }
    asm volatile("s_waitcnt vmcnt(0) lgkmcnt(0)\n\ts_barrier" ::: "memory");
#undef DMA_K
#undef DMA_V
}
#undef SBAR
}

#define XB_TMO      128
#define XB_XCNT(j)  (256  + 64 * (j))
#define XB_XSUB(j)  (1280 + 64 * (j))
#define XB_XGEN(j)  (2304 + 64 * (j))
#define XB_TOP      3328
#define XB_TOPGEN   3392
#define XCD_BAR_WORDS 3456
#define XB_SPIN_CAP (1u << 18)
constexpr int CW_BAR = 32768;
__device__ __forceinline__ unsigned xb_ld(unsigned* p)              { return __hip_atomic_load(p, __ATOMIC_RELAXED, __HIP_MEMORY_SCOPE_AGENT); }
__device__ __forceinline__ unsigned xb_add(unsigned* p, unsigned v) { return __hip_atomic_fetch_add(p, v, __ATOMIC_RELAXED, __HIP_MEMORY_SCOPE_AGENT); }
__device__ __forceinline__ unsigned xb_xcc_id() { return (unsigned)__builtin_amdgcn_s_getreg((3 << 11) | 20) & 0xFu; }
#define XB_SPIN(cond, bar) do { unsigned _sp = 0; while (cond) { __builtin_amdgcn_s_sleep(1); \
    if ((++_sp & 255u) == 0u) { if (xb_ld(&(bar)[XB_TMO])) break; if (_sp > XB_SPIN_CAP) { atomicAdd(&(bar)[XB_TMO], 1u); break; } } } } while (0)
struct XcdBarrier { unsigned* bar; unsigned x; volatile LAS unsigned* st; };
__device__ __forceinline__ XcdBarrier xcd_barrier_post(unsigned* bar, volatile LAS unsigned* st) {
    XcdBarrier b; b.bar = bar; b.x = xb_xcc_id(); b.st = st;
    if (threadIdx.x == 0) (void)xb_add(&bar[XB_XCNT(b.x)], 1u);
    return b;
}
__device__ __forceinline__ void xcd_barrier_complete(unsigned* bar, unsigned x, unsigned& nloc, unsigned& nx) {
    const unsigned G = gridDim.x * gridDim.y * gridDim.z;
    unsigned sum, cnt, mine, sp = 0u;
    for (;;) {
        sum = 0u; cnt = 0u; mine = 0u;
#pragma unroll
        for (unsigned j = 0; j < 16; ++j) { const unsigned c = xb_ld(&bar[XB_XCNT(j)]); sum += c; cnt += (c > 0u) ? 1u : 0u; mine = (j == x) ? c : mine; }
        if (sum == G) break;
        __builtin_amdgcn_s_sleep(1);
        if ((++sp & 255u) == 0u) { if (xb_ld(&bar[XB_TMO])) break; if (sp > XB_SPIN_CAP) { atomicAdd(&bar[XB_TMO], 1u); break; } }
    }
    nloc = mine > 0u ? mine : 1u; nx = cnt > 0u ? cnt : 1u;
}
__device__ __forceinline__ void xcd_barrier(const XcdBarrier& b) {
    asm volatile("s_waitcnt vmcnt(0)" ::: "memory");
    __syncthreads();
    if (threadIdx.x == 0) {
        unsigned* bar = b.bar;
        __builtin_amdgcn_s_waitcnt(0);
        unsigned nloc = b.st[0], nx = b.st[1];
        if (nloc == 0u) { xcd_barrier_complete(bar, b.x, nloc, nx); b.st[0] = nloc; b.st[1] = nx; }
        const unsigned old = xb_add(&bar[XB_XSUB(b.x)], 1u);
        const unsigned gen = old / nloc;
        if (old + 1u == (gen + 1u) * nloc) {
            __builtin_amdgcn_fence(__ATOMIC_RELEASE, "agent");
            asm volatile("s_waitcnt vmcnt(0)" ::: "memory");
            const unsigned og = xb_add(&bar[XB_TOP], 1u);
            const unsigned tg = og / nx;
            if (og + 1u == (tg + 1u) * nx) xb_add(&bar[XB_TOPGEN], 1u);
            else XB_SPIN(xb_ld(&bar[XB_TOPGEN]) == tg, bar);
            __builtin_amdgcn_fence(__ATOMIC_ACQUIRE, "agent");
            xb_add(&bar[XB_XGEN(b.x)], 1u);
            asm volatile("s_waitcnt vmcnt(0)" ::: "memory");
        } else {
            XB_SPIN(xb_ld(&bar[XB_XGEN(b.x)]) == gen, bar);
            __builtin_amdgcn_fence(__ATOMIC_ACQUIRE, "agent");
            asm volatile("s_waitcnt vmcnt(0)" ::: "memory");
        }
    }
    __syncthreads();
}

struct Ctx { int tid, lane, wave, vcu, G; LAS unsigned char* lds; };

__device__ __forceinline__ unsigned cvtpk_hw(float lo, float hi) { unsigned r; asm volatile("v_cvt_pk_bf16_f32 %0, %1, %2" : "=v"(r) : "v"(lo), "v"(hi)); return r; }
__device__ __forceinline__ void tr_item64(const float* W, int ldw, bf16_t* WT, int ldt, LAS float* scr, int lane) {
    const int kr = lane >> 4, n4 = (lane & 15) * 4;
#pragma unroll
    for (int hb = 0; hb < 2; ++hb) { f32x4 v[8];
#pragma unroll
        for (int i = 0; i < 8; ++i) v[i] = __builtin_nontemporal_load((const f32x4*)(W + (size_t)(4 * (8 * hb + i) + kr) * ldw + n4));
#pragma unroll
        for (int i = 0; i < 8; ++i) { LAS float* p = scr + (4 * (8 * hb + i) + kr) * 65 + n4; p[0] = v[i].x; p[1] = v[i].y; p[2] = v[i].z; p[3] = v[i].w; } }
    LDS_WAIT(); asm volatile("" ::: "memory");
    const int kc = lane & 7;
#pragma unroll
    for (int j = 0; j < 8; ++j) { const int n = (lane >> 3) + 8 * j; const LAS float* s = scr + (8 * kc) * 65 + n;
        u32x4 o; o.x = cvtpk_hw(s[0 * 65], s[1 * 65]); o.y = cvtpk_hw(s[2 * 65], s[3 * 65]); o.z = cvtpk_hw(s[4 * 65], s[5 * 65]); o.w = cvtpk_hw(s[6 * 65], s[7 * 65]);
        *(u32x4*)(WT + (size_t)n * ldt + 8 * kc) = o; }
    LDS_WAIT(); asm volatile("" ::: "memory");
}

__device__ __forceinline__ void p0_prologue(const Args& a, const Ctx& c) {
    unsigned char* ws = a.ws;
    bf16_t* WGU = (bf16_t*)(ws + WS_WGU); bf16_t* WD = (bf16_t*)(ws + WS_WD); bf16_t* WIN = (bf16_t*)(ws + WS_WIN); bf16_t* WMKV = (bf16_t*)(ws + WS_WMKV);
    bf16_t* WOUT = (bf16_t*)(ws + WS_WOUT); bf16_t* WR = (bf16_t*)(ws + WS_WR);
    LAS float* WfT = (LAS float*)c.lds;
    LAS float* scr = (LAS float*)(c.lds + c.wave * 16640);
    const int gw = c.vcu * 8 + c.wave, NGW = c.G * 8;
    constexpr int NEXP_ITEMS = 0;
    constexpr int I_WIN = 512, I_MKV = 128, I_OUT = 192, I_R = 64;
    constexpr int NITEMS = NEXP_ITEMS + I_WIN + I_MKV + I_OUT + I_R;
    for (int it = gw; it < NITEMS; it += NGW) {
        int r = it;
        if (r < NEXP_ITEMS) { const int e = r / 192; r -= e * 192;
            if (r < 128) { const int up = r >> 6; r &= 63; const int kb = r >> 2, nb = r & 3, n0 = nb * 64;
                const float* src = (e < NE) ? ((up ? a.w_up : a.w_gate) + (size_t)e * DM * EH) : (up ? a.ws_up : a.ws_gate);
                const int drow = (n0 >> 7) * 256 + up * 128 + (n0 & 127);
                tr_item64(src + (size_t)kb * 64 * EH + n0, EH, WGU + ((size_t)e * 512 + drow) * DM + kb * 64, DM, scr, c.lane);
            } else { r -= 128; const int kb = r >> 4, nb = r & 15;
                const float* src = (e < NE) ? (a.w_down + (size_t)e * EH * DM) : a.ws_down;
                tr_item64(src + (size_t)kb * 64 * DM + nb * 64, DM, WD + ((size_t)e * DM + nb * 64) * EH + kb * 64, EH, scr, c.lane); }
            continue; }
        r -= NEXP_ITEMS;
        if (r < I_WIN) {
            int col0, drow0, nbw;
            if (r < 128) { col0 = 256; drow0 = 0; nbw = 8; } else if (r < 256) { r -= 128; col0 = 768; drow0 = 512; nbw = 8; } else if (r < 384) { r -= 256; col0 = 1280; drow0 = 1024; nbw = 8; }
            else if (r < 448) { r -= 384; col0 = 0; drow0 = 1536; nbw = 4; } else { r -= 448; col0 = 1800; drow0 = 1792; nbw = 4; }
            const int kb = r / nbw, nb = r % nbw;
            tr_item64(a.w_in + (size_t)kb * 64 * INC + col0 + nb * 64, INC, WIN + (size_t)(drow0 + nb * 64) * DM + kb * 64, DM, scr, c.lane);
            continue; }
        r -= I_WIN;
        if (r < I_MKV) { const int kb = r >> 3, nb = r & 7; tr_item64(a.w_mem_kv + (size_t)kb * 64 * 512 + nb * 64, 512, WMKV + (size_t)(nb * 64) * DM + kb * 64, DM, scr, c.lane); continue; }
        r -= I_MKV;
        if (r < I_OUT) { const int kb = r >> 4, nb = r & 15; tr_item64(a.w_out + (size_t)(256 + kb * 64) * DM + nb * 64, DM, WOUT + (size_t)(nb * 64) * DM + 256 + kb * 64, DM, scr, c.lane); continue; }
        r -= I_OUT;
        { const int kb = r >> 2, nb = r & 3; tr_item64(a.w_router + (size_t)kb * 64 * NE + nb * 64, NE, WR + (size_t)(nb * 64) * DM + kb * 64, DM, scr, c.lane); }
    }
    __syncthreads();
    for (int idx = c.tid; idx < 8192; idx += 512) { const int h = idx & 7, k = idx >> 3; WfT[h * 1024 + k] = a.w_in[(size_t)k * INC + 1792 + h]; }
    for (int idx = (c.vcu * 512 + c.tid); idx < 256 * 1024; idx += c.G * 512) { const int k = idx >> 10, n = idx & 1023, g = k >> 6, cc = k & 63; float s = 0.f;
        for (int d = 0; d < 64; ++d) s += a.w_pool[g * 4096 + cc * 64 + d] * a.pool_scale[g * 64 + d] * a.w_out[(size_t)(g * 64 + d) * DM + n];
        WOUT[(size_t)n * DM + k] = (bf16_t)f2bf(s); }
    __syncthreads();
    bf16_t* XB = (bf16_t*)(ws + WS_XB); float* FLOG = (float*)(ws + WS_FLOG);
    constexpr int XR = 4;
    for (int m0 = gw; m0 < T; m0 += XR * NGW) {
        f32x4 v[XR][4]; float zz[XR];
#pragma unroll
        for (int r = 0; r < XR; ++r) { const int m = (m0 + r * NGW < T) ? m0 + r * NGW : m0; const f32x4* xr = (const f32x4*)(a.x + (size_t)m * DM) + c.lane;
#pragma unroll
            for (int j = 0; j < 4; ++j) v[r][j] = __builtin_nontemporal_load(xr + 64 * j); }
        float accs[XR][8];
#pragma unroll
        for (int h = 0; h < 8; ++h) {
#pragma unroll
            for (int r = 0; r < XR; ++r) accs[r][h] = 0.f;
#pragma unroll
            for (int j = 0; j < 4; ++j) { const f32x4 w = *(const LAS f32x4*)(WfT + h * 1024 + 4 * c.lane + 256 * j);
#pragma unroll
                for (int r = 0; r < XR; ++r) accs[r][h] += (v[r][j].x * w.x + v[r][j].y * w.y) + (v[r][j].z * w.z + v[r][j].w * w.w); } }
#pragma unroll
        for (int r = 0; r < XR; ++r) {
            float acc[8];
#pragma unroll
            for (int h = 0; h < 8; ++h) acc[h] = accs[r][h];
            float b4[4], b2[2], z;
            { const bool up = (c.lane & 32) != 0;
#pragma unroll
              for (int i = 0; i < 4; ++i) { const float keep = up ? acc[4 + i] : acc[i], give = up ? acc[i] : acc[4 + i]; b4[i] = keep + __shfl_xor(give, 32); } }
            { const bool up = (c.lane & 16) != 0;
#pragma unroll
              for (int i = 0; i < 2; ++i) { const float keep = up ? b4[2 + i] : b4[i], give = up ? b4[i] : b4[2 + i]; b2[i] = keep + __shfl_xor(give, 16); } }
            { const bool up = (c.lane & 8) != 0; const float keep = up ? b2[1] : b2[0], give = up ? b2[0] : b2[1]; z = keep + __shfl_xor(give, 8); }
            z += __shfl_xor(z, 4); z += __shfl_xor(z, 2); z += __shfl_xor(z, 1);
            zz[r] = z; }
#pragma unroll
        for (int r = 0; r < XR; ++r) { const int m = m0 + r * NGW; if (m >= T) break;
            u32x2* o8 = (u32x2*)(XB + (size_t)m * DM) + c.lane;
#pragma unroll
            for (int j = 0; j < 4; ++j) o8[64 * j] = (u32x2){cvtpk_hw(v[r][j].x, v[r][j].y), cvtpk_hw(v[r][j].z, v[r][j].w)};
            if ((c.lane & 7) == 0) { const int h = ((c.lane >> 5) & 1) * 4 + ((c.lane >> 4) & 1) * 2 + ((c.lane >> 3) & 1); FLOG[(size_t)m * 8 + h] = zz[r] + a.b_f[h]; } }
    }
    bf16_t* MEMB = (bf16_t*)(ws + WS_MEMB);
    for (int m = gw; m < NB * 256; m += NGW) {
        const f32x4* xr = (const f32x4*)(a.mem + (size_t)m * DM) + c.lane; u32x2* o8 = (u32x2*)(MEMB + (size_t)m * DM) + c.lane;
#pragma unroll
        for (int j = 0; j < 4; ++j) { const f32x4 v = xr[64 * j]; o8[64 * j] = (u32x2){pk2(v.x, v.y), pk2(v.z, v.w)}; }
    }
}

__device__ __forceinline__ void p1_fscan(const Args& a, const Ctx& c) {
    if (c.vcu < 64 || c.vcu >= 128) return;
    const float* FLOG = (const float*)(a.ws + WS_FLOG); float* FC = (float*)(a.ws + WS_FC);
    LAS float* wtot = (LAS float*)c.lds;
    const int bh = c.vcu - 64, b = bh >> 3, h = bh & 7; float p[8]; float run = 0.f;
#pragma unroll
    for (int i = 0; i < 8; ++i) { const float z = FLOG[((size_t)b * SEQ + c.tid * 8 + i) * 8 + h]; run += fminf(z, 0.f) - __logf(1.f + __expf(-fabsf(z))); p[i] = run; }
    float inc = run;
#pragma unroll
    for (int o = 1; o < 64; o <<= 1) { const float t = __shfl_up(inc, o); if (c.lane >= o) inc += t; }
    if (c.lane == 63) wtot[c.wave] = inc;
    __syncthreads();
    float base = inc - run;
    for (int w = 0; w < c.wave; ++w) base += wtot[w];
#pragma unroll
    for (int i = 0; i < 8; i += 4) *(f32x4*)(FC + (size_t)bh * SEQ + c.tid * 8 + i) = (f32x4){(base + p[i]) * LOG2E, (base + p[i + 1]) * LOG2E, (base + p[i + 2]) * LOG2E, (base + p[i + 3]) * LOG2E};
    __syncthreads();
}

__device__ __forceinline__ void p2_mixers(const Args& a, const Ctx& c) {
    unsigned char* ws = a.ws;
    const bf16_t* Q = (const bf16_t*)(ws + WS_Q); const bf16_t* Kb = (const bf16_t*)(ws + WS_K); const bf16_t* V = (const bf16_t*)(ws + WS_V); const bf16_t* QM = (const bf16_t*)(ws + WS_QM);
    const bf16_t* U = (const bf16_t*)(ws + WS_U); const bf16_t* KVM = (const bf16_t*)(ws + WS_KVM); bf16_t* YMIX = (bf16_t*)(ws + WS_YMIX); const float* FC = (const float*)(ws + WS_FC);
    ConvBg bg; bg.w_gate = a.w_gate; bg.w_up = a.w_up; bg.w_down = a.w_down; bg.ws_gate = a.ws_gate; bg.ws_up = a.ws_up; bg.ws_down = a.ws_down;
    bg.WGU = (bf16_t*)(ws + WS_WGU); bg.WD = (bf16_t*)(ws + WS_WD); bg.scr = (LAS float*)(c.lds + BG_OFF + c.wave * 8448); bg.lane = c.lane;
    bg.it = c.vcu * 8 + c.wave; bg.end = ConvBg::NIT; bg.stride = c.G * 8; bg.it0 = bg.it; bg.nl = 0; bg.pend = false; bg.dst = nullptr; bg.ldt = 0;
#pragma unroll
    for (int i = 0; i < 8; ++i) bg.v[i] = (f32x4){0.f, 0.f, 0.f, 0.f};
    { const int cp = c.tid & 127, rg = c.tid >> 7, ch = 2 * cp, wsel = ch >> 6;
      const int t0 = c.vcu * 128 + rg * 32, seq0 = t0 & ~(SEQ - 1);
      bg.issue();
      unsigned raw[47];
#pragma unroll
      for (int k = 0; k < 47; ++k) { const int row = t0 - 15 + k; raw[k] = (row >= seq0) ? *(const unsigned*)(U + (size_t)row * 256 + ch) : 0u; }
      float p0[48], p1[48]; p0[0] = 0.f; p1[0] = 0.f;
#pragma unroll
      for (int k = 0; k < 47; ++k) { p0[k + 1] = p0[k] + bflo(raw[k]); p1[k + 1] = p1[k] + bfhi(raw[k]); }
#pragma unroll
      for (int i = 0; i < 32; ++i) { if (i == 16) { bg.finish(); bg.issue(); }
          const int t = t0 + i, k = i + 16; const int pos = t & (SEQ - 1), w = 2 << wsel, cnt = (pos + 1 < w) ? pos + 1 : w;
          const float l0 = (wsel == 0) ? p0[k - 2] : (wsel == 1) ? p0[k - 4] : (wsel == 2) ? p0[k - 8] : p0[k - 16];
          const float l1 = (wsel == 0) ? p1[k - 2] : (wsel == 1) ? p1[k - 4] : (wsel == 2) ? p1[k - 8] : p1[k - 16];
          const float inv = 1.0f / (float)cnt;
          *(unsigned*)(YMIX + (size_t)t * DM + ch) = pk2((p0[k] - l0) * inv - bflo(raw[k - 1]), (p1[k] - l1) * inv - bfhi(raw[k - 1])); } }
    bg.finish(); bg.issue();
    __syncthreads();
    { const float* nrm = (const float*)(ws + WS_CTL) + CW_NRM; unsigned* qctr = (unsigned*)(ws + WS_CTL) + CW_Q; volatile LAS int* qslot = (volatile LAS int*)(c.lds + MISC_OFF + 64);
      for (;;) {
          __syncthreads();
          if (c.tid == 0) qslot[0] = (int)__hip_atomic_fetch_add(qctr, 1u, __ATOMIC_RELAXED, __HIP_MEMORY_SCOPE_AGENT);
          __syncthreads();
          const int uq = qslot[0]; if (uq >= 1024) break;
          const int qb = 15 - (uq >> 6), bh = uq & 63, b = bh >> 3, h = bh & 7;
          att::Job j; const size_t row0 = (size_t)b * SEQ;
          { const float q2 = nrm[bh * 4 + 0] + nrm[bh * 4 + 1], k2 = nrm[bh * 4 + 2] + nrm[bh * 4 + 3]; j.qk2 = 2.02f * sqrtf(q2 * k2); }
          j.Q = Q + (row0 + qb * 256) * 512 + h * 64; j.qpitch = 512; j.K = Kb + row0 * 512 + h * 64; j.V = V + row0 * 512 + h * 64; j.kvpitch = 512;
          j.O = YMIX + (row0 + qb * 256) * DM + 256 + h * 64; j.nt = 4 * qb + 4; j.causal = 1; j.FC = FC + (size_t)bh * SEQ; j.q0 = qb * 256;
          att::unit<true>(j, c.lds, bg); } }
    for (int i = 0; i < 2; ++i) { const int mu = c.vcu * 2 + i, b = mu >> 6, hm = (mu >> 4) & 3, qb = mu & 15;
        att::Job j; const size_t row0 = (size_t)b * SEQ + qb * 256;
        j.Q = QM + row0 * 256 + hm * 64; j.qpitch = 256; j.K = KVM + (size_t)b * 256 * 512 + hm * 64; j.V = KVM + (size_t)b * 256 * 512 + 256 + hm * 64; j.kvpitch = 512;
        j.O = YMIX + row0 * DM + 768 + hm * 64; j.nt = 4; j.causal = 0; j.FC = nullptr; j.q0 = 0; j.qk2 = 0.f;
        att::unit<false>(j, c.lds, bg); }
    while (bg.busy()) { bg.finish(); bg.issue(); }
}

__device__ __forceinline__ void p4_ln1(const Args& a, const Ctx& c) {
    bf16_t* X1B = (bf16_t*)(a.ws + WS_X1B);
    f32x4 g4[4], b4[4];
#pragma unroll
    for (int j = 0; j < 4; ++j) { g4[j] = *((const f32x4*)a.ln1_g + c.lane + 64 * j); b4[j] = *((const f32x4*)a.ln1_b + c.lane + 64 * j); }
    for (int m = c.vcu * 128 + c.wave; m < c.vcu * 128 + 128; m += 8) {
        const u32x2* xr = (const u32x2*)(a.out + (size_t)m * DM) + c.lane; f32x4 v[4]; float s = 0.f;
#pragma unroll
        for (int j = 0; j < 4; ++j) { const u32x2 hw = xr[64 * j]; v[j] = (f32x4){bflo(hw.x), bfhi(hw.x), bflo(hw.y), bfhi(hw.y)}; s += (v[j].x + v[j].y) + (v[j].z + v[j].w); }
        const float mean = wave_sum(s) * (1.f / DM); float s2 = 0.f;
#pragma unroll
        for (int j = 0; j < 4; ++j) { v[j] = v[j] - mean; s2 += (v[j].x * v[j].x + v[j].y * v[j].y) + (v[j].z * v[j].z + v[j].w * v[j].w); }
        const float rstd = 1.f / sqrtf(wave_sum(s2) * (1.f / DM) + LN_EPS);
        u32x2* o8 = (u32x2*)(X1B + (size_t)m * DM) + c.lane; unsigned* f8 = (unsigned*)(a.ws + WS_X1F8 + (size_t)m * DM) + c.lane;
#pragma unroll
        for (int j = 0; j < 4; ++j) { const f32x4 y = v[j] * rstd * g4[j] + b4[j]; o8[64 * j] = (u32x2){pk2(y.x, y.y), pk2(y.z, y.w)};
            int w = 0; w = __builtin_amdgcn_cvt_pk_fp8_f32(y.x, y.y, w, false); w = __builtin_amdgcn_cvt_pk_fp8_f32(y.z, y.w, w, true); f8[64 * j] = (unsigned)w; }
    }
}

__device__ __forceinline__ float wave_max_f(float v) {
    int x = __float_as_int(v);  v = fmaxf(v, __int_as_float(__builtin_amdgcn_update_dpp(x, x, 0x121, 0xf, 0xf, false)));
    x = __float_as_int(v);      v = fmaxf(v, __int_as_float(__builtin_amdgcn_update_dpp(x, x, 0x122, 0xf, 0xf, false)));
    x = __float_as_int(v);      v = fmaxf(v, __int_as_float(__builtin_amdgcn_update_dpp(x, x, 0x124, 0xf, 0xf, false)));
    x = __float_as_int(v);      v = fmaxf(v, __int_as_float(__builtin_amdgcn_update_dpp(x, x, 0x128, 0xf, 0xf, false)));
    x = __float_as_int(v);
    const float a = __int_as_float(__builtin_amdgcn_readlane(x, 0)), b = __int_as_float(__builtin_amdgcn_readlane(x, 16)), c = __int_as_float(__builtin_amdgcn_readlane(x, 32)), d = __int_as_float(__builtin_amdgcn_readlane(x, 48));
    return fmaxf(fmaxf(a, b), fmaxf(c, d));
}
#define ROWDPP_I(x, ctrl) __builtin_amdgcn_update_dpp((int)(x), (int)(x), (ctrl), 0xf, 0xf, false)
#define ROWDPP_F(x, ctrl) __int_as_float(__builtin_amdgcn_update_dpp(__float_as_int(x), __float_as_int(x), (ctrl), 0xf, 0xf, false))
#define CSWAP(va, ia, sa, vb, ib, sb) do { const bool sw_ = (vb > va) || (vb == va && ib < ia); const float tv_ = sw_ ? vb : va, tw_ = sw_ ? va : vb; const int ti_ = sw_ ? ib : ia, tj_ = sw_ ? ia : ib; \
    const float ts_ = sw_ ? sb : sa, tt_ = sw_ ? sa : sb; va = tv_; vb = tw_; ia = ti_; ib = tj_; sa = ts_; sb = tt_; } while (0)
__device__ __forceinline__ void p6_route(const Args& a, const Ctx& c) {
    const float* LOG = (const float*)(a.ws + WS_LOG); int* cnt = (int*)(a.ws + WS_CTL); int* bins = (int*)(a.ws + WS_BINS); float* gates = (float*)(a.ws + WS_GATES);
    LAS int* hist = (LAS int*)c.lds; LAS int* base = hist + 256; LAS unsigned short* asg_e = (LAS unsigned short*)(base + 256); LAS unsigned short* asg_r = asg_e + 1024;
    const int lane = c.lane;
    for (int chunk = c.vcu; chunk < T / 128; chunk += c.G) {
        __syncthreads();
        if (c.tid < 256) hist[c.tid] = 0;
        __syncthreads();
        for (int i4 = 0; i4 < 4; ++i4) {
            const int lt = c.wave * 16 + i4 * 4 + (lane >> 4), tok = chunk * 128 + lt, r = lane & 15;
            float sc[16], bv[16];
#pragma unroll
            for (int q = 0; q < 4; ++q) { const f32x4 lg = *((const f32x4*)(LOG + (size_t)tok * NE + 16 * r) + q); const f32x4 bq = *((const f32x4*)(a.router_bias + 16 * r) + q);
                sc[4 * q + 0] = __builtin_amdgcn_rcpf(1.f + __expf(-lg.x)); sc[4 * q + 1] = __builtin_amdgcn_rcpf(1.f + __expf(-lg.y)); sc[4 * q + 2] = __builtin_amdgcn_rcpf(1.f + __expf(-lg.z)); sc[4 * q + 3] = __builtin_amdgcn_rcpf(1.f + __expf(-lg.w));
                bv[4 * q + 0] = sc[4 * q + 0] + bq.x; bv[4 * q + 1] = sc[4 * q + 1] + bq.y; bv[4 * q + 2] = sc[4 * q + 2] + bq.z; bv[4 * q + 3] = sc[4 * q + 3] + bq.w; }
            float m1 = -INFINITY, m2 = -INFINITY;
#pragma unroll
            for (int e = 0; e < 16; ++e) { const float x = bv[e]; m2 = fmaxf(m2, fminf(m1, x)); m1 = fmaxf(m1, x); }
            { const float o1 = ROWDPP_F(m1, 0xB1), o2 = ROWDPP_F(m2, 0xB1); const float n1 = fmaxf(m1, o1), n2 = fmaxf(fminf(m1, o1), fmaxf(m2, o2)); m1 = n1; m2 = n2; }
            const float gs = m1 + m2; const int g = r >> 1; int rank = 0;
#define GRANK(CTRL) { const float og = ROWDPP_F(gs, CTRL); const int oi = ROWDPP_I(g, CTRL); rank += (og > gs || (og == gs && oi < g)) ? 1 : 0; }
            GRANK(0x122) GRANK(0x124) GRANK(0x126) GRANK(0x128) GRANK(0x12A) GRANK(0x12C) GRANK(0x12E)
#undef GRANK
            if (rank >= 4) {
#pragma unroll
                for (int e = 0; e < 16; ++e) bv[e] = -INFINITY; }
            int my_e = 0; float my_s = 0.f;
#pragma unroll
            for (int k = 0; k < TOPK; ++k) {
                float lb = bv[0], ls = sc[0]; int li = 0;
#pragma unroll
                for (int e = 1; e < 16; ++e) { const bool gt = bv[e] > lb; lb = gt ? bv[e] : lb; ls = gt ? sc[e] : ls; li = gt ? e : li; }
                float vmax = lb;
                vmax = fmaxf(vmax, ROWDPP_F(vmax, 0x121)); vmax = fmaxf(vmax, ROWDPP_F(vmax, 0x122)); vmax = fmaxf(vmax, ROWDPP_F(vmax, 0x124)); vmax = fmaxf(vmax, ROWDPP_F(vmax, 0x128));
                int key = (lb == vmax) ? 16 * r + li : 4096;
                key = min(key, ROWDPP_I(key, 0x121)); key = min(key, ROWDPP_I(key, 0x122)); key = min(key, ROWDPP_I(key, 0x124)); key = min(key, ROWDPP_I(key, 0x128));
                const bool win = (lb == vmax) && (16 * r + li == key);
                float sw = win ? ls : -1.f;
                sw = fmaxf(sw, ROWDPP_F(sw, 0x121)); sw = fmaxf(sw, ROWDPP_F(sw, 0x122)); sw = fmaxf(sw, ROWDPP_F(sw, 0x124)); sw = fmaxf(sw, ROWDPP_F(sw, 0x128));
#pragma unroll
                for (int e = 0; e < 16; ++e) bv[e] = (win && li == e) ? -INFINITY : bv[e];
                if (r == k) { my_e = key; my_s = sw; }
            }
            float tot = (r < 8) ? my_s : 0.f;
            tot += ROWDPP_F(tot, 0x121); tot += ROWDPP_F(tot, 0x122); tot += ROWDPP_F(tot, 0x124); tot += ROWDPP_F(tot, 0x128);
            if (r < 8) { const int lr = __hip_atomic_fetch_add(&hist[my_e], 1, __ATOMIC_RELAXED, __HIP_MEMORY_SCOPE_WORKGROUP); asg_e[lt * 8 + r] = (unsigned short)my_e; asg_r[lt * 8 + r] = (unsigned short)lr; gates[(size_t)tok * 8 + r] = my_s / tot * 2.5f; }
        }
        __syncthreads();
        if (c.tid < 256) { const int n = hist[c.tid]; base[c.tid] = n ? atomicAdd(&cnt[c.tid * 64], n) : 0; }
        __syncthreads();
        for (int sl = c.tid; sl < 1024; sl += 512) { const int e = asg_e[sl]; bins[(size_t)e * T + base[e] + asg_r[sl]] = chunk * 1024 + sl; }
    }
    __syncthreads();
}
#undef CSWAP
#undef ROWDPP_I
#undef ROWDPP_F

__device__ __forceinline__ int build_tables(const Args& a, const Ctx& c) {
    const int* cnt = (const int*)(a.ws + WS_CTL);
    LAS unsigned short* te = (LAS unsigned short*)(c.lds + TE_OFF); LAS int* tb = (LAS int*)(c.lds + TB_OFF); LAS int* cn = (LAS int*)(c.lds + CN_OFF);
    LAS unsigned short* ord = (LAS unsigned short*)(c.lds + OR_OFF); LAS int* wt = (LAS int*)c.lds;
    __syncthreads();
    int n = 0, nf = 0, my = 0;
    if (c.tid < NE) { my = __hip_atomic_load(cnt + c.tid * 64, __ATOMIC_RELAXED, __HIP_MEMORY_SCOPE_AGENT); cn[c.tid] = my; n = (my + 255) >> 8; nf = (n > 0 && my - (n - 1) * 256 <= 128) ? n - 1 : n; }
    int pa = n | (nf << 16), pb = n - nf;
#pragma unroll
    for (int o = 1; o < 64; o <<= 1) { const int ta = __shfl_up(pa, o), tb2 = __shfl_up(pb, o); if (c.lane >= o) { pa += ta; pb += tb2; } }
    if (c.lane == 63 && c.wave < 4) { wt[2 * c.wave] = pa; wt[2 * c.wave + 1] = pb; }
    __syncthreads();
    int oa = 0, ob = 0;
    for (int w = 0; w < 4; ++w) if (w < c.wave) { oa += wt[2 * w]; ob += wt[2 * w + 1]; }
    const int tot_a = wt[0] + wt[2] + wt[4] + wt[6];
    const int NTR = tot_a & 0xffff, NF = tot_a >> 16;
    if (c.tid < NE) { const int ea = oa + pa - (n | (nf << 16)), eb = ob + pb - (n - nf); const int b0 = ea & 0xffff, f0 = ea >> 16;
        tb[c.tid] = b0; if (c.tid == NE - 1) tb[NE] = NTR;
        for (int jt = 0; jt < n; ++jt) te[b0 + jt] = (unsigned short)c.tid;
        for (int jt = 0; jt < nf; ++jt) ord[f0 + jt] = (unsigned short)(b0 + jt);
        if (n > nf) ord[NF + 128 + eb] = (unsigned short)(b0 + n - 1); }
    if (c.tid < 128) ord[NF + c.tid] = (unsigned short)(NTR + c.tid);
    __syncthreads();
    return __builtin_amdgcn_readfirstlane(NTR);
}

constexpr int TK_OFF = 141056, MAXU = 11;
template <class Sched> __device__ __forceinline__ void preload_tokens(const Ctx& c, const Sched& S) {
    LAS unsigned short* tk = (LAS unsigned short*)(c.lds + TK_OFF);
#pragma unroll
    for (int b0 = 0; b0 < 12; b0 += 6) { int tv0 = 0, tv1 = 0, tv2 = 0, tv3 = 0, tv4 = 0, tv5 = 0;
#define PT_ONE(J, TV) { pg8::Unit u; if (b0 + (J) < MAXU && c.tid < 256 && S.next(b0 + (J), u)) { if (u.e < NE) { if (c.tid < u.rows) { const int a = S.bins[(size_t)u.e * T + u.mt * 256 + c.tid]; TV = a >> 3; if (u.pn == 0) S.rowidx[a] = u.pm * 256 + c.tid; } } else TV = u.mt * 256 + c.tid; } }
        PT_ONE(0, tv0) PT_ONE(1, tv1) PT_ONE(2, tv2) PT_ONE(3, tv3) PT_ONE(4, tv4) PT_ONE(5, tv5)
#undef PT_ONE
        if (c.tid < 256) { tk[(b0 + 0) * 256 + c.tid] = (unsigned short)tv0; tk[(b0 + 1) * 256 + c.tid] = (unsigned short)tv1; tk[(b0 + 2) * 256 + c.tid] = (unsigned short)tv2;
                           tk[(b0 + 3) * 256 + c.tid] = (unsigned short)tv3; tk[(b0 + 4) * 256 + c.tid] = (unsigned short)tv4; if (b0 + 5 < MAXU) tk[(b0 + 5) * 256 + c.tid] = (unsigned short)tv5; } }
    __syncthreads();
}

__device__ __forceinline__ void p9_combine(const Args& a, const Ctx& c) {
    const bf16_t* X1B = (const bf16_t*)(a.ws + WS_X1B); const bf16_t* Y = (const bf16_t*)(a.ws + WS_Y); const int gw = c.vcu * 8 + c.wave, NGW = c.G * 8;
    const int* ridx = (const int*)(a.ws + WS_ROWIDX); const float* gts = (const float*)(a.ws + WS_GATES);
    f32x4 g4[4], b4[4];
#pragma unroll
    for (int j = 0; j < 4; ++j) { g4[j] = *((const f32x4*)a.ln2_g + c.lane + 64 * j); b4[j] = *((const f32x4*)a.ln2_b + c.lane + 64 * j); }
    for (int m = gw; m < T; m += NGW) {
        f32x4* orow = (f32x4*)(a.out + (size_t)m * DM) + c.lane; f32x4 v[4]; float s = 0.f;
        const u32x2* x8 = (const u32x2*)(X1B + (size_t)m * DM) + c.lane;
        const u32x2* s8 = (const u32x2*)(a.out + (size_t)m * DM) + c.lane;
#pragma unroll
        for (int j = 0; j < 4; ++j) { const u32x2 xw = x8[64 * j], sw = s8[64 * j]; v[j] = (f32x4){bflo(sw.x), bfhi(sw.x), bflo(sw.y), bfhi(sw.y)} + (f32x4){bflo(xw.x), bfhi(xw.x), bflo(xw.y), bfhi(xw.y)} * ALPHA; }
        f32x4 ys[4];
#pragma unroll
        for (int j = 0; j < 4; ++j) ys[j] = (f32x4){0.f, 0.f, 0.f, 0.f};
        const int ypos = (((4 * c.lane) >> 5) & 3) * 64 + (((4 * c.lane) >> 3) & 3) * 16 + (((4 * c.lane) >> 7) & 1) * 8 + ((4 * c.lane) & 7);
        const int my_r = ridx[(size_t)m * TOPK + (c.lane & 7)]; const float my_g = gts[(size_t)m * TOPK + (c.lane & 7)];
#pragma unroll
        for (int k = 0; k < TOPK; ++k) { const int rr = __builtin_amdgcn_readlane(my_r, k); const float gk = __int_as_float(__builtin_amdgcn_readlane(__float_as_int(my_g), k));
            const unsigned char* yrow = (const unsigned char*)Y + (size_t)rr * DM + ypos;
#pragma unroll
            for (int j = 0; j < 4; ++j) { const int yw = *(const int*)(yrow + 256 * j); const f32x2 lo = __builtin_amdgcn_cvt_pk_f32_fp8(yw, false), hi2 = __builtin_amdgcn_cvt_pk_f32_fp8(yw, true); ys[j] += (f32x4){lo.x, lo.y, hi2.x, hi2.y} * gk; } }
#pragma unroll
        for (int j = 0; j < 4; ++j) v[j] += ys[j] * YINV;
#pragma unroll
        for (int j = 0; j < 4; ++j) s += (v[j].x + v[j].y) + (v[j].z + v[j].w);
        const float mean = wave_sum(s) * (1.f / DM); float s2 = 0.f;
#pragma unroll
        for (int j = 0; j < 4; ++j) { v[j] = v[j] - mean; s2 += (v[j].x * v[j].x + v[j].y * v[j].y) + (v[j].z * v[j].z + v[j].w * v[j].w); }
        const float rstd = 1.f / sqrtf(wave_sum(s2) * (1.f / DM) + LN_EPS);
#pragma unroll
        for (int j = 0; j < 4; ++j) orow[64 * j] = v[j] * rstd * g4[j] + b4[j];
    }
}

constexpr int NPHASE = 10;

__global__ void __launch_bounds__(512, 2) mk_fwd(Args a) {
    extern __shared__ __attribute__((aligned(16))) unsigned char lds_raw[];
    cg::grid_group grid = cg::this_grid();
    Ctx c; c.lds = (LAS unsigned char*)lds_raw; c.tid = threadIdx.x; c.lane = c.tid & 63; c.wave = __builtin_amdgcn_readfirstlane(c.tid >> 6); c.G = gridDim.x;
    { const int bx = blockIdx.x; c.vcu = (c.G % 8 == 0) ? (bx % 8) * (c.G / 8) + bx / 8 : bx; }
    unsigned char* ws = a.ws; const int lo = a.ph_lo, hi = a.ph_hi;
#define IN(k) (lo <= (k) && (k) < hi)
    for (int u = c.tid; u < 32; u += 512) ((volatile LAS unsigned*)(c.lds + MISC_OFF))[u] = 0u;
    __syncthreads();
    XcdBarrier bar = xcd_barrier_post((unsigned*)(ws + WS_CTL) + CW_BAR + a.li * XCD_BAR_WORDS, (volatile LAS unsigned*)(c.lds + MISC_OFF) + 8);
    if (a.ph_lo < 0) grid.sync();
    unsigned long long pt_acc = 0ull;
#define PT_ON(id) (PROBE_T == (id))
#define SEAM(k) do { if (IN(k) && IN((k) + 1)) { if (PT_ON(10 + (k)) || PT_ON(30)) { const unsigned long long t0_ = __builtin_amdgcn_s_memrealtime(); xcd_barrier(bar); pt_acc += __builtin_amdgcn_s_memrealtime() - t0_; } else xcd_barrier(bar); } } while (0)
#define PH_BEGIN(k) unsigned long long pt0_##k = 0ull; if (PT_ON(k)) pt0_##k = __builtin_amdgcn_s_memrealtime();
#define PH_END(k) if (PT_ON(k)) { asm volatile("s_waitcnt vmcnt(0)" ::: "memory"); __syncthreads(); pt_acc += __builtin_amdgcn_s_memrealtime() - pt0_##k; }
    { PH_BEGIN(0) if (IN(0)) p0_prologue(a, c); PH_END(0) }
    SEAM(0);
    { PH_BEGIN(1) if (IN(1)) {
        p1_fscan(a, c);
        { pg8::DenseSched S; S.init(T, 2048, DM, c.G, (int)blockIdx.x, ws + WS_WIN);
          pg8::EpiInProj E{(bf16_t*)(ws + WS_Q), (bf16_t*)(ws + WS_K), (bf16_t*)(ws + WS_V), (bf16_t*)(ws + WS_U), (bf16_t*)(ws + WS_QM), (unsigned*)(ws + WS_CTL) + CW_NRM};
          pg8::gemm_phase(c.lds, (const char*)(ws + WS_XB), DM, S, E); }
        { pg8::DenseSched S; S.init_half(NB * 256, 512, DM, c.G, c.vcu, ws + WS_WMKV);
          pg8::EpiBf16 E{(bf16_t*)(ws + WS_KVM), 512};
          pg8::gemm_phase(c.lds, (const char*)(ws + WS_MEMB), DM, S, E); }
    } PH_END(1) }
    SEAM(1);
    { PH_BEGIN(2) if (IN(2)) p2_mixers(a, c); PH_END(2) }
    SEAM(2);
    { PH_BEGIN(3) if (IN(3)) { pg8::DenseSched S; S.init(T, DM, DM, c.G, (int)blockIdx.x, ws + WS_WOUT);
        pg8::EpiRes16 E{(bf16_t*)a.out, a.x, ALPHA};
        pg8::gemm_phase<PT_ON(23)>(c.lds, (const char*)(ws + WS_YMIX), DM, S, E, &pt_acc); } PH_END(3) }
    SEAM(3);
    { PH_BEGIN(4) if (IN(4)) { p4_ln1(a, c); asm volatile("s_waitcnt vmcnt(0)" ::: "memory"); __syncthreads(); } PH_END(4) }
    { PH_BEGIN(5) if (IN(5)) { pg8::DenseSched S; S.init_half(T, NE, DM, c.G, c.vcu, ws + WS_WR);
        pg8::EpiF32 E{(float*)(ws + WS_LOG), NE, nullptr, 0.f};
        pg8::gemm_phase(c.lds, (const char*)(ws + WS_X1B), DM, S, E); asm volatile("s_waitcnt vmcnt(0)" ::: "memory"); __syncthreads(); } PH_END(5) }
    { PH_BEGIN(6) if (IN(6)) p6_route(a, c); PH_END(6) }
    SEAM(6);
    { PH_BEGIN(7) if (IN(7)) { const int NTR = build_tables(a, c);
        pg8::GroupSched<0> S; S.nunits = (NTR + 128) * 2; S.G = c.G; S.c = c.vcu; S.shift = 1; S.NTR = NTR; S.K = DM / 2;

        S.tile_e = (const LAS unsigned short*)(c.lds + TE_OFF); S.tbase = (const LAS int*)(c.lds + TB_OFF); S.cnt = (const LAS int*)(c.lds + CN_OFF);
        S.bins = (const int*)(ws + WS_BINS); S.Bt = (const char*)(ws + WS_WGU); S.estride = (size_t)512 * DM; S.rowidx = (int*)(ws + WS_ROWIDX); S.order = (const LAS unsigned short*)(c.lds + OR_OFF); S.tokidx = (const LAS unsigned short*)(c.lds + TK_OFF);
        preload_tokens(c, S);
        pg8::EpiGateUp E{(unsigned char*)(ws + WS_HB)};
        pg8::gemm_phase<PT_ON(27), 0x7f>(c.lds, (const char*)(ws + WS_X1F8), DM / 2, S, E, &pt_acc); } PH_END(7) }
    SEAM(7);
    { PH_BEGIN(8) if (IN(8)) { const int NTR = (IN(7)) ? __builtin_amdgcn_readfirstlane(((const LAS int*)(c.lds + TB_OFF))[NE]) : build_tables(a, c);
        pg8::GroupSched<1> S; S.nunits = (NTR + 128) * 4; S.G = c.G; S.c = c.vcu; S.shift = 2; S.NTR = NTR; S.K = EH / 2;

        S.tile_e = (const LAS unsigned short*)(c.lds + TE_OFF); S.tbase = (const LAS int*)(c.lds + TB_OFF); S.cnt = (const LAS int*)(c.lds + CN_OFF);
        S.bins = (const int*)(ws + WS_BINS); S.Bt = (const char*)(ws + WS_WD); S.estride = (size_t)DM * EH; S.rowidx = nullptr; S.order = (const LAS unsigned short*)(c.lds + OR_OFF); S.tokidx = nullptr;
        pg8::EpiDown E{(bf16_t*)(ws + WS_Y), a.out, (const int*)(ws + WS_BINS), (const float*)(ws + WS_GATES)};
        pg8::gemm_phase<PT_ON(28), 0x7c>(c.lds, (const char*)(ws + WS_HB), EH / 2, S, E, &pt_acc); } PH_END(8) }
    SEAM(8);
    { PH_BEGIN(9) if (IN(9)) p9_combine(a, c); PH_END(9) }
    if (PROBE_T >= 0) {
        unsigned* pw = (unsigned*)(ws + WS_CTL) + CW_PROBE;
        if (c.tid == 0) { if (PROBE_MODE == 0) atomicMax(pw, (unsigned)pt_acc); else atomicAdd(pw, (unsigned)pt_acc); }
        xcd_barrier(bar);
        if (blockIdx.x == 0 && c.tid == 0) { unsigned v = __hip_atomic_load(pw, __ATOMIC_RELAXED, __HIP_MEMORY_SCOPE_AGENT); if (PROBE_MODE == 1) v /= (unsigned)c.G;
            const unsigned long long t0 = __builtin_amdgcn_s_memrealtime(); while (__builtin_amdgcn_s_memrealtime() - t0 < (unsigned long long)v * PROBE_MULT) __builtin_amdgcn_s_sleep(8); }
    }
#undef IN
#undef SEAM
}

#ifndef MK_N_LAUNCHES
#define MK_N_LAUNCHES 1
#endif
extern "C" void kernel_launch(void* const* d_in, const int* in_sizes, int n_in, void* d_out, int out_size, void* d_ws, size_t ws_size, hipStream_t stream) {
    static int grid = 0;
    if (grid == 0) {
        if (n_in != 20 || out_size != T * DM || ws_size < WS_END) { fprintf(stderr, "kernel_launch: unexpected shapes (n_in %d out %d ws %zu)\n", n_in, out_size, ws_size); grid = -1; return; }
        int dev = 0, cus = 0, per_cu = 0;
        (void)hipGetDevice(&dev); (void)hipDeviceGetAttribute(&cus, hipDeviceAttributeMultiprocessorCount, dev);
        if (hipFuncSetAttribute((const void*)mk_fwd, hipFuncAttributeMaxDynamicSharedMemorySize, LDS_BYTES) != hipSuccess) { fprintf(stderr, "kernel_launch: hipFuncSetAttribute failed\n"); grid = -1; return; }
        (void)hipOccupancyMaxActiveBlocksPerMultiprocessor(&per_cu, (const void*)mk_fwd, 512, LDS_BYTES);
        if (per_cu < 1) { fprintf(stderr, "kernel_launch: occupancy query says %d blocks per CU\n", per_cu); grid = -1; return; }
        grid = cus;
        if (grid != 256) fprintf(stderr, "kernel_launch: %d CUs (built for 256)\n", grid);
    }
    if (grid < 0) return;
    (void)hipMemsetAsync((char*)d_ws + WS_CTL, 0, CTL_ZERO_BYTES, stream);
    Args a{};
    const float** p = (const float**)&a;
    for (int i = 0; i < 20; ++i) p[i] = (const float*)d_in[i];
    a.out = (float*)d_out; a.ws = (unsigned char*)d_ws;
    const int nl = MK_N_LAUNCHES;
    for (int li = 0; li < nl; ++li) {
        a.ph_lo = (nl == 1) ? 0 : li; a.ph_hi = (nl == 1) ? NPHASE : li + 1; a.li = li;
        void* args[] = {&a};
        const hipError_t e = hipLaunchCooperativeKernel((void*)mk_fwd, dim3(grid), dim3(512), args, LDS_BYTES, stream);
        if (e != hipSuccess) { fprintf(stderr, "kernel_launch: cooperative launch failed: %s\n", hipGetErrorString(e)); break; }
    }
}
```
